# Optimizing an MI355X kernel written in HIP

```python
import math
import jax, jax.numpy as jnp
from jax import lax
import numpy as np

D_MODEL = 1024
BATCH = 4
SEQ = 8192
DEPTH = 1

MEM_LEN = 256
MLA_HEADS = 8
MLA_Q_RANK = 256
MLA_KV_RANK = 128
MLA_NOPE = 64
MLA_ROPE = 32
MLA_V = 64
ROPE_THETA = 10000.0
SB_HEADS = 8
SB_HEAD_DIM = 64
X_HEADS = 4
X_HEAD_DIM = 128
D_FF = -(-8 * D_MODEL // (3 * 256)) * 256
Q_BLOCK = 128
EPS = 1e-6
SB_WIDTH = SB_HEADS * SB_HEAD_DIM
IN_SPLITS = (MLA_Q_RANK, MLA_KV_RANK, MLA_ROPE, SB_WIDTH, SB_WIDTH, SB_WIDTH, D_MODEL, D_MODEL)
D_IN = MLA_Q_RANK + MLA_KV_RANK + MLA_ROPE + 3 * SB_WIDTH + 2 * D_MODEL

kernel_name = "hybrid_mla_stickbreaking_gated_block"


def rms_norm(x, g):
    xf = x.astype(jnp.float32)
    y = xf * lax.rsqrt(jnp.mean(xf * xf, axis=-1, keepdims=True) + EPS)
    return (y * g.astype(jnp.float32)).astype(x.dtype)


def rope_cos_sin(positions):
    inv_freq = ROPE_THETA ** (-jnp.arange(0, MLA_ROPE, 2, dtype=jnp.float32) / MLA_ROPE)
    ang = positions.astype(jnp.float32)[..., None] * inv_freq
    return jnp.cos(ang), jnp.sin(ang)


def apply_rope(x, cos, sin):
    half = x.shape[-1] // 2
    x1 = x[..., :half].astype(jnp.float32)
    x2 = x[..., half:].astype(jnp.float32)
    out = jnp.concatenate([x1 * cos - x2 * sin, x2 * cos + x1 * sin], axis=-1)
    return out.astype(x.dtype)


def mla_block(qb, blk, k, v):
    scale = 1.0 / math.sqrt(MLA_NOPE + MLA_ROPE)
    s = jnp.einsum('bqhd,bkhd->bhqk', qb, k).astype(jnp.float32) * scale
    q_pos = blk * Q_BLOCK + jnp.arange(Q_BLOCK)
    k_pos = jnp.arange(k.shape[1])
    mask = k_pos[None, :] <= q_pos[:, None]
    s = jnp.where(mask, s, jnp.finfo(jnp.float32).min)
    p = jax.nn.softmax(s, axis=-1).astype(v.dtype)
    return jnp.einsum('bhqk,bkhd->bqhd', p, v)


def stick_breaking_block(qb, blk, k, v):
    scale = 1.0 / math.sqrt(SB_HEAD_DIM)
    z = jnp.einsum('bqhd,bkhd->bhqk', qb, k).astype(jnp.float32) * scale
    q_pos = blk * Q_BLOCK + jnp.arange(Q_BLOCK)
    k_pos = jnp.arange(k.shape[1])
    mask = k_pos[None, :] < q_pos[:, None]
    log_beta = jax.nn.log_sigmoid(z)
    log_one_minus = jnp.where(mask, jax.nn.log_sigmoid(-z), 0.0)
    suffix = lax.cumsum(log_one_minus, axis=3, reverse=True) - log_one_minus
    a = jnp.where(mask, jnp.exp(log_beta + suffix), 0.0).astype(v.dtype)
    return jnp.einsum('bhqk,bkhd->bqhd', a, v)


def blocked_attend(block_fn, q, k, v):
    b, s, h, dq = q.shape
    dv = v.shape[-1]
    nb = s // Q_BLOCK
    qb = q.reshape(b, nb, Q_BLOCK, h, dq).transpose(1, 0, 2, 3, 4)
    out = lax.map(lambda a: block_fn(a[0], a[1], k, v), (qb, jnp.arange(nb)))
    return out.transpose(1, 0, 2, 3, 4).reshape(b, s, h * dv)


def setup_inputs(seed: int = 0) -> dict:
    key = jax.random.key(seed)
    ks = jax.random.split(key, 24)

    def w(k, shape, fan_in):
        return jax.random.normal(k, shape, jnp.float32) * (fan_in ** -0.5)

    def gain(k, shape):
        return 1.0 + 0.01 * jax.random.normal(k, shape, jnp.float32)

    L = DEPTH
    return {
        "x": jax.random.normal(ks[0], (BATCH, SEQ, D_MODEL), jnp.float32),
        "mem": jax.random.normal(ks[1], (BATCH, MEM_LEN, D_MODEL), jnp.float32),
        "positions": jnp.broadcast_to(jnp.arange(SEQ, dtype=jnp.int32)[None, :], (BATCH, SEQ)),
        "g_mix": gain(ks[2], (L, D_MODEL)),
        "w_in": w(ks[3], (L, D_MODEL, D_IN), D_MODEL),
        "b_gate": 0.01 * jax.random.normal(ks[4], (L, 2, D_MODEL), jnp.float32),
        "g_q_lat": gain(ks[5], (L, MLA_Q_RANK)),
        "w_uq": w(ks[6], (L, MLA_Q_RANK, MLA_HEADS * (MLA_NOPE + MLA_ROPE)), MLA_Q_RANK),
        "g_kv_lat": gain(ks[7], (L, MLA_KV_RANK)),
        "w_ukv": w(ks[8], (L, MLA_KV_RANK, MLA_HEADS * (MLA_NOPE + MLA_V)), MLA_KV_RANK),
        "w_a_proj": w(ks[9], (L, MLA_HEADS * MLA_V, D_MODEL), MLA_HEADS * MLA_V),
        "w_b_proj": w(ks[10], (L, SB_WIDTH, D_MODEL), SB_WIDTH),
        "w_o": w(ks[11], (L, D_MODEL, D_MODEL), D_MODEL),
        "g_x": gain(ks[12], (L, D_MODEL)),
        "g_mem": gain(ks[13], (L, D_MODEL)),
        "w_xq": w(ks[14], (L, D_MODEL, X_HEADS * X_HEAD_DIM), D_MODEL),
        "w_xkv": w(ks[15], (L, D_MODEL, 2 * X_HEADS * X_HEAD_DIM), D_MODEL),
        "w_xo": w(ks[16], (L, X_HEADS * X_HEAD_DIM, D_MODEL), X_HEADS * X_HEAD_DIM),
        "g_ffn": gain(ks[17], (L, D_MODEL)),
        "w_gate": w(ks[18], (L, D_MODEL, D_FF), D_MODEL),
        "w_up": w(ks[19], (L, D_MODEL, D_FF), D_MODEL),
        "w_down": w(ks[20], (L, D_FF, D_MODEL), D_FF),
        "g_final": gain(ks[21], (D_MODEL,)),
    }


def reference(x, mem, positions, g_mix, w_in, b_gate, g_q_lat, w_uq, g_kv_lat, w_ukv,
              w_a_proj, w_b_proj, w_o, g_x, g_mem, w_xq, w_xkv, w_xo,
              g_ffn, w_gate, w_up, w_down, g_final):
    b, s, _ = x.shape
    m_len = mem.shape[1]
    cos, sin = rope_cos_sin(positions)
    split_points = list(np.cumsum(IN_SPLITS)[:-1])

    for l in range(DEPTH):
        h = rms_norm(x, g_mix[l])
        proj = h @ w_in[l]
        c_q, c_kv, k_r, sb_q, sb_k, sb_v, gate_a, gate_b = jnp.split(proj, split_points, axis=-1)

        q = (rms_norm(c_q, g_q_lat[l]) @ w_uq[l]).reshape(b, s, MLA_HEADS, MLA_NOPE + MLA_ROPE)
        q_rope = apply_rope(q[..., MLA_NOPE:], cos[:, :, None, :], sin[:, :, None, :])
        q_a = jnp.concatenate([q[..., :MLA_NOPE], q_rope], axis=-1)
        kv = (rms_norm(c_kv, g_kv_lat[l]) @ w_ukv[l]).reshape(b, s, MLA_HEADS, MLA_NOPE + MLA_V)
        k_r = apply_rope(k_r, cos, sin)
        k_a = jnp.concatenate(
            [kv[..., :MLA_NOPE], jnp.broadcast_to(k_r[:, :, None, :], (b, s, MLA_HEADS, MLA_ROPE))], axis=-1)
        v_a = kv[..., MLA_NOPE:]
        o_a = blocked_attend(mla_block, q_a, k_a, v_a)

        o_b = blocked_attend(
            stick_breaking_block,
            sb_q.reshape(b, s, SB_HEADS, SB_HEAD_DIM),
            sb_k.reshape(b, s, SB_HEADS, SB_HEAD_DIM),
            sb_v.reshape(b, s, SB_HEADS, SB_HEAD_DIM))

        merged = (jax.nn.sigmoid(gate_a + b_gate[l, 0]) * (o_a @ w_a_proj[l])
                  + jax.nn.sigmoid(gate_b + b_gate[l, 1]) * (o_b @ w_b_proj[l]))
        x = x + merged @ w_o[l]

        hx = rms_norm(x, g_x[l])
        mn = rms_norm(mem, g_mem[l])
        xq = (hx @ w_xq[l]).reshape(b, s, X_HEADS, X_HEAD_DIM)
        xkv = (mn @ w_xkv[l]).reshape(b, m_len, 2, X_HEADS, X_HEAD_DIM)
        xs = jnp.einsum('bqhd,bkhd->bhqk', xq, xkv[:, :, 0]).astype(jnp.float32) / math.sqrt(X_HEAD_DIM)
        xp = jax.nn.softmax(xs, axis=-1).astype(x.dtype)
        xo = jnp.einsum('bhqk,bkhd->bqhd', xp, xkv[:, :, 1]).reshape(b, s, X_HEADS * X_HEAD_DIM)
        x = x + xo @ w_xo[l]

        hf = rms_norm(x, g_ffn[l])
        x = x + (jax.nn.silu(hf @ w_gate[l]) * (hf @ w_up[l])) @ w_down[l]

    return rms_norm(x, g_final)
```

```cpp
#include <hip/hip_runtime.h>
#include <hip/hip_cooperative_groups.h>
#include <cstdio>
#include <cstdint>
namespace cg = cooperative_groups;

#ifndef ONE_LAUNCH
#define ONE_LAUNCH 1
#endif

typedef unsigned short bf16_t;
typedef short bf16x8 __attribute__((ext_vector_type(8)));
typedef float f32x16 __attribute__((ext_vector_type(16)));
typedef float f32x4 __attribute__((ext_vector_type(4)));
typedef float f32x2 __attribute__((ext_vector_type(2)));
typedef unsigned u32x4 __attribute__((ext_vector_type(4)));
typedef unsigned u32x2 __attribute__((ext_vector_type(2)));
typedef __bf16 bf16x2_t __attribute__((ext_vector_type(2)));
#define DI __device__ __forceinline__
#define MFMA(a, b, c) __builtin_amdgcn_mfma_f32_32x32x16_bf16((a), (b), (c), 0, 0, 0)

constexpr int T = 32768, SEQ = 8192, NB = 4, DM = 1024, MEMT = 1024, MEML = 256;
constexpr int DFF = 2816;
constexpr float EPS = 1e-6f;
constexpr float LOG2E = 1.4426950408889634f;

constexpr size_t MB = 1024 * 1024;
constexpr size_t OFF_SSQ_Q = 0;
constexpr size_t OFF_SSQ_KV = OFF_SSQ_Q + T * 4;
constexpr size_t OFF_SSQ1 = OFF_SSQ_KV + T * 4;
constexpr size_t OFF_SSQ2 = OFF_SSQ1 + T * 4;
constexpr size_t OFF_SSQ3 = OFF_SSQ2 + T * 4;
constexpr size_t OFF_RSTD0 = OFF_SSQ3 + T * 4;
constexpr size_t OFF_CS = 1 * MB;
constexpr size_t OFF_WIN = 5 * MB;
constexpr size_t OFF_WUQ = OFF_WIN + 8 * MB;
constexpr size_t OFF_WUKV = OFF_WUQ + 768 * 256 * 2;
constexpr size_t OFF_WA = OFF_WUKV + 1024 * 128 * 2;
constexpr size_t OFF_WB = OFF_WA + 1 * MB;
constexpr size_t OFF_WO = OFF_WB + 1 * MB;
constexpr size_t OFF_WXQ = OFF_WO + 2 * MB;
constexpr size_t OFF_WXKV = OFF_WXQ + 1 * MB;
constexpr size_t OFF_WXO = OFF_WXKV + 2 * MB;
constexpr size_t OFF_WGU = OFF_WXO + 1 * MB;
constexpr size_t OFF_WD = OFF_WGU + 11 * MB;
constexpr size_t OFF_MNB = OFF_WD + 6 * MB;
constexpr size_t OFF_XK = OFF_MNB + 2 * MB;
constexpr size_t OFF_XVT = OFF_XK + 1 * MB;
constexpr size_t OFF_ACT = 48 * MB;
constexpr size_t OFF_XB = OFF_ACT;
constexpr size_t OFF_OA = OFF_XB;
constexpr size_t OFF_OB = OFF_XB + 32 * MB;
constexpr size_t OFF_CQ = OFF_XB + 64 * MB;
constexpr size_t OFF_CKV = OFF_CQ + 16 * MB;
constexpr size_t OFF_KA = OFF_CKV + 8 * MB;
constexpr size_t OFF_QA = OFF_KA + 48 * MB;
constexpr size_t OFF_VTA = OFF_QA + 48 * MB;
constexpr size_t OFF_SBQ = OFF_VTA + 32 * MB;
constexpr size_t OFF_SBK = OFF_SBQ + 32 * MB;
constexpr size_t OFF_VTB = OFF_SBK + 32 * MB;
constexpr size_t OFF_SIGA = OFF_VTB + 32 * MB;
constexpr size_t OFF_SIGB = OFF_SIGA + 64 * MB;
constexpr size_t WS_END = OFF_SIGB + 64 * MB;
constexpr size_t OFF_MERGED = OFF_KA;
constexpr size_t OFF_X1B = OFF_VTA;
constexpr size_t OFF_XQ = OFF_SBK;
constexpr size_t OFF_XO = OFF_VTB;
constexpr size_t OFF_X2B = OFF_SIGA;
constexpr size_t OFF_HID = OFF_KA;

struct Params {
    const float* x; const float* mem; const int* pos;
    const float* g_mix; const float* w_in; const float* b_gate; const float* g_q_lat; const float* w_uq;
    const float* g_kv_lat; const float* w_ukv; const float* w_a; const float* w_b; const float* w_o;
    const float* g_x; const float* g_mem; const float* w_xq; const float* w_xkv; const float* w_xo;
    const float* g_ffn; const float* w_gate; const float* w_up; const float* w_down; const float* g_final;
    float* out; char* ws;
};

DI unsigned pk2(float a, float b) { f32x2 v = {a, b}; bf16x2_t r = __builtin_convertvector(v, bf16x2_t); return __builtin_bit_cast(unsigned, r); }
DI bf16_t bf1(float a) { return (bf16_t)(pk2(a, 0.f) & 0xffffu); }
DI float ex2(float x) { return __builtin_amdgcn_exp2f(x); }
DI float lg2(float x) { return __builtin_amdgcn_logf(x); }
DI float shx32(float v) { return __shfl_xor(v, 32); }

DI void wt_tile(const float* __restrict__ src, int N, int sc, int k0, bf16_t* __restrict__ dst, int K, int drow0, const float* __restrict__ g, float scale, float* lds) {
    const int t = threadIdx.x;
    {
        const int nn = t & 31, kb = t >> 5;
#pragma unroll
        for (int i = 0; i < 8; ++i) {
            const int kk = kb + 8 * i;
            float v = 0.f;
            if (sc >= 0) { v = src[(size_t)(k0 + kk) * N + sc + nn] * scale; if (g) v *= g[k0 + kk]; }
            lds[kk * 33 + nn] = v;
        }
    }
    __syncthreads();
    {
        const int kk = t & 63, nb = t >> 6;
#pragma unroll
        for (int i = 0; i < 8; ++i) {
            const int nn = nb + 4 * i;
            dst[(size_t)(drow0 + nn) * K + k0 + kk] = bf1(lds[kk * 33 + nn]);
        }
    }
    __syncthreads();
}

constexpr float SBQ_SCALE = LOG2E * 0.125f;
constexpr float MLAQ_SCALE = LOG2E * 0.10206207261596577f;
constexpr float XQ_SCALE = LOG2E * 0.08838834764831845f;

DI void phase0(const Params& p, float* ldsf) {
    char* ws = p.ws;
    constexpr int J0 = 128 * 16;
    constexpr int J1 = J0 + 24 * 4;
    constexpr int J2 = J1 + 32 * 2;
    constexpr int J3 = J2 + 32 * 8;
    constexpr int J4 = J3 + 32 * 8;
    constexpr int J5 = J4 + 32 * 16;
    constexpr int J6 = J5 + 16 * 16;
    constexpr int J7 = J6 + 32 * 16;
    constexpr int J8 = J7 + 32 * 8;
    constexpr int J9 = J8 + 176 * 16;
    constexpr int J10 = J9 + 32 * 44;
    for (int tl = blockIdx.x; tl < J10; tl += gridDim.x) {
        if (tl < J0) { const int jn = tl >> 4, jk = tl & 15; const int d0 = jn * 32; int sc; float s = 1.f;
            if (d0 < 416) sc = d0; else if (d0 < 512) sc = -1; else { sc = d0 - 96; if (d0 < 1024) s = SBQ_SCALE; }
            wt_tile(p.w_in, 4000, sc, jk * 64, (bf16_t*)(ws + OFF_WIN), 1024, d0, p.g_mix, s, ldsf); }
        else if (tl < J1) { const int u = tl - J0; const int jn = u >> 2, jk = u & 3;
            wt_tile(p.w_uq, 768, jn * 32, jk * 64, (bf16_t*)(ws + OFF_WUQ), 256, jn * 32, p.g_q_lat, MLAQ_SCALE, ldsf); }
        else if (tl < J2) { const int u = tl - J1; const int jn = u >> 1, jk = u & 1;
            wt_tile(p.w_ukv, 1024, jn * 32, jk * 64, (bf16_t*)(ws + OFF_WUKV), 128, jn * 32, p.g_kv_lat, 1.f, ldsf); }
        else if (tl < J3) { const int u = tl - J2; const int jn = u >> 3, jk = u & 7;
            wt_tile(p.w_a, 1024, jn * 32, jk * 64, (bf16_t*)(ws + OFF_WA), 512, jn * 32, nullptr, 1.f, ldsf); }
        else if (tl < J4) { const int u = tl - J3; const int jn = u >> 3, jk = u & 7;
            wt_tile(p.w_b, 1024, jn * 32, jk * 64, (bf16_t*)(ws + OFF_WB), 512, jn * 32, nullptr, 1.f, ldsf); }
        else if (tl < J5) { const int u = tl - J4; const int jn = u >> 4, jk = u & 15;
            wt_tile(p.w_o, 1024, jn * 32, jk * 64, (bf16_t*)(ws + OFF_WO), 1024, jn * 32, nullptr, 1.f, ldsf); }
        else if (tl < J6) { const int u = tl - J5; const int jn = u >> 4, jk = u & 15;
            wt_tile(p.w_xq, 512, jn * 32, jk * 64, (bf16_t*)(ws + OFF_WXQ), 1024, jn * 32, p.g_x, XQ_SCALE, ldsf); }
        else if (tl < J7) { const int u = tl - J6; const int jn = u >> 4, jk = u & 15;
            wt_tile(p.w_xkv, 1024, jn * 32, jk * 64, (bf16_t*)(ws + OFF_WXKV), 1024, jn * 32, nullptr, 1.f, ldsf); }
        else if (tl < J8) { const int u = tl - J7; const int jn = u >> 3, jk = u & 7;
            wt_tile(p.w_xo, 1024, jn * 32, jk * 64, (bf16_t*)(ws + OFF_WXO), 512, jn * 32, nullptr, 1.f, ldsf); }
        else if (tl < J9) { const int u = tl - J8; const int jn = u >> 4, jk = u & 15;
            const float* src = (jn & 1) ? p.w_up : p.w_gate;
            wt_tile(src, DFF, (jn >> 1) * 32, jk * 64, (bf16_t*)(ws + OFF_WGU), 1024, jn * 32, p.g_ffn, 1.f, ldsf); }
        else { const int u = tl - J9; const int jn = u / 44, jk = u % 44;
            wt_tile(p.w_down, 1024, jn * 32, jk * 64, (bf16_t*)(ws + OFF_WD), DFF, jn * 32, nullptr, 1.f, ldsf); }
    }
    {
        float* z = (float*)(ws + OFF_SSQ_Q);
        for (int i = blockIdx.x * 256 + threadIdx.x; i < 5 * T; i += gridDim.x * 256) z[i] = 0.f;
    }
    const int lane = threadIdx.x & 63, w = threadIdx.x >> 6;
    for (int row = blockIdx.x * 4 + w; row < T + MEMT; row += gridDim.x * 4) {
        const bool ismem = row >= T;
        const float* src = ismem ? p.mem + (size_t)(row - T) * DM : p.x + (size_t)row * DM;
        f32x4 v[4]; float ss = 0.f;
#pragma unroll
        for (int i = 0; i < 4; ++i) { v[i] = *(const f32x4*)(src + i * 256 + lane * 4); ss += v[i][0] * v[i][0] + v[i][1] * v[i][1] + v[i][2] * v[i][2] + v[i][3] * v[i][3]; }
#pragma unroll
        for (int o = 32; o >= 1; o >>= 1) ss += __shfl_xor(ss, o);
        const float rstd = rsqrtf(ss * (1.0f / DM) + EPS);
        if (!ismem) {
            bf16_t* d = (bf16_t*)(ws + OFF_XB) + (size_t)row * DM;
#pragma unroll
            for (int i = 0; i < 4; ++i) { u32x2 o2; o2.x = pk2(v[i][0], v[i][1]); o2.y = pk2(v[i][2], v[i][3]); *(u32x2*)(d + i * 256 + lane * 4) = o2; }
            if (lane == 0) ((float*)(ws + OFF_RSTD0))[row] = rstd;
            if (lane < 16) {
                const float invf = exp2f(-(float)(2 * lane) * (13.287712379549449f / 32.0f));
                const float ang = (float)p.pos[row] * invf;
                const double a = (double)ang; const double kq = rint(a * 0.15915494309189535); const float r = (float)(a - kq * 6.283185307179586);
                f32x2 cs; cs.x = __cosf(r); cs.y = __sinf(r);
                ((f32x2*)(ws + OFF_CS))[(size_t)row * 16 + lane] = cs;
            }
        } else {
            bf16_t* d = (bf16_t*)(ws + OFF_MNB) + (size_t)(row - T) * DM;
#pragma unroll
            for (int i = 0; i < 4; ++i) { const f32x4 g = *(const f32x4*)(p.g_mem + i * 256 + lane * 4);
                u32x2 o2; o2.x = pk2(v[i][0] * rstd * g[0], v[i][1] * rstd * g[1]); o2.y = pk2(v[i][2] * rstd * g[2], v[i][3] * rstd * g[3]); *(u32x2*)(d + i * 256 + lane * 4) = o2; }
        }
    }
}

DI void gemm_main(const bf16_t* __restrict__ A, int lda, const bf16_t* __restrict__ Bt, int ldb, int K, int m0, int n0, f32x16 (&acc)[2][2], char* lds) {
    const int t = threadIdx.x, lane = t & 63, w = t >> 6, wm = w >> 1, wn = w & 1;
    const int lr = t >> 3, lc = t & 7;
    const bf16_t* ga = A + (size_t)(m0 + lr) * lda + lc * 8;
    const bf16_t* gb = Bt + (size_t)(n0 + lr) * ldb + lc * 8;
    const int soff = lr * 128 + ((lc ^ ((lr >> 1) & 7)) << 4);
    u32x4 ra[4], rb[4];
#pragma unroll
    for (int i = 0; i < 4; ++i) { ra[i] = *(const u32x4*)(ga + (size_t)i * 32 * lda); rb[i] = *(const u32x4*)(gb + (size_t)i * 32 * ldb); }
#pragma unroll
    for (int i = 0; i < 4; ++i) { *(u32x4*)(lds + soff + i * 4096) = ra[i]; *(u32x4*)(lds + 16384 + soff + i * 4096) = rb[i]; }
    __syncthreads();
    const int fr = lane & 31, fh = lane >> 5, fsw = (fr >> 1) & 7;
    const int xoff = (wm * 64 + fr) * 128, woff = 16384 + (wn * 64 + fr) * 128;
    const int nk = K >> 6;
    for (int kt = 0; kt < nk; ++kt) {
        const char* buf = lds + (kt & 1) * 32768;
        const bool more = kt + 1 < nk;
        if (more) {
            const int ko = (kt + 1) * 64;
#pragma unroll
            for (int i = 0; i < 4; ++i) { ra[i] = *(const u32x4*)(ga + (size_t)i * 32 * lda + ko); rb[i] = *(const u32x4*)(gb + (size_t)i * 32 * ldb + ko); }
        }
#pragma unroll
        for (int kk = 0; kk < 4; ++kk) {
            const int co = ((kk * 2 + fh) ^ fsw) << 4;
            bf16x8 xf[2], wf[2];
#pragma unroll
            for (int j = 0; j < 2; ++j) { xf[j] = *(const bf16x8*)(buf + xoff + j * 4096 + co); wf[j] = *(const bf16x8*)(buf + woff + j * 4096 + co); }
#pragma unroll
            for (int nt = 0; nt < 2; ++nt)
#pragma unroll
                for (int mt = 0; mt < 2; ++mt) acc[nt][mt] = MFMA(wf[nt], xf[mt], acc[nt][mt]);
        }
        if (more) {
            char* nb = lds + ((kt + 1) & 1) * 32768;
#pragma unroll
            for (int i = 0; i < 4; ++i) { *(u32x4*)(nb + soff + i * 4096) = ra[i]; *(u32x4*)(nb + 16384 + soff + i * 4096) = rb[i]; }
        }
        __syncthreads();
    }
}

DI void zero_acc(f32x16 (&acc)[2][2]) {
#pragma unroll
    for (int a = 0; a < 2; ++a)
#pragma unroll
        for (int b = 0; b < 2; ++b)
#pragma unroll
            for (int r = 0; r < 16; ++r) acc[a][b][r] = 0.f;
}
DI void st_bf4(bf16_t* d, float a, float b, float c, float e) { u32x2 o; o.x = pk2(a, b); o.y = pk2(c, e); *(u32x2*)d = o; }

DI void tile_mn(int tl, int ntn, int& mi, int& ni) { const int per = 16 * ntn; const int g = tl / per, r = tl - g * per; mi = g * 16 + (r & 15); ni = r >> 4; }

DI void phase1(const Params& p, char* lds) {
    char* ws = p.ws;
    const int t = threadIdx.x, lane = t & 63, w = t >> 6, wm = w >> 1, wn = w & 1, fr = lane & 31, fh = lane >> 5;
    const float* rstd0 = (const float*)(ws + OFF_RSTD0);
    constexpr int NT1 = 256 * 32, NTX = 8 * 8;
    for (int tl = blockIdx.x; tl < NT1 + NTX; tl += gridDim.x) {
        f32x16 acc[2][2]; zero_acc(acc);
        if (tl < NT1) {
            int mi, ni; tile_mn(tl, 32, mi, ni);
            const int m0 = mi * 128, n0 = ni * 128;
            gemm_main((const bf16_t*)(ws + OFF_XB), DM, (const bf16_t*)(ws + OFF_WIN), DM, DM, m0, n0, acc, lds);
#pragma unroll
            for (int mt = 0; mt < 2; ++mt) {
                const int tok = m0 + wm * 64 + mt * 32 + fr;
                const float rs = rstd0[tok];
                float ssq = 0.f;
#pragma unroll
                for (int nt = 0; nt < 2; ++nt) {
                    const int cb = n0 + wn * 64 + nt * 32 + fh * 4;
                    if (n0 < 384) {
                        bf16_t* d = (n0 < 256) ? (bf16_t*)(ws + OFF_CQ) + (size_t)tok * 256 + cb : (bf16_t*)(ws + OFF_CKV) + (size_t)tok * 128 + (cb - 256);
#pragma unroll
                        for (int rg = 0; rg < 4; ++rg) { const float a = acc[nt][mt][rg * 4] * rs, b = acc[nt][mt][rg * 4 + 1] * rs, c = acc[nt][mt][rg * 4 + 2] * rs, e = acc[nt][mt][rg * 4 + 3] * rs;
                            ssq += a * a + b * b + c * c + e * e; st_bf4(d + rg * 8, a, b, c, e); }
                    } else if (n0 == 384) {
                        if (wn == 0 && nt == 0) {
                            const f32x2* cs = (const f32x2*)(ws + OFF_CS) + (size_t)tok * 16;
                            bf16_t* d = (bf16_t*)(ws + OFF_KA) + (size_t)tok * 768 + 64;
#pragma unroll
                            for (int rg = 0; rg < 2; ++rg) {
                                float lo[4], hi[4];
#pragma unroll
                                for (int j = 0; j < 4; ++j) { const f32x2 c = cs[rg * 8 + fh * 4 + j]; const float x1 = acc[nt][mt][rg * 4 + j] * rs, x2 = acc[nt][mt][8 + rg * 4 + j] * rs;
                                    lo[j] = x1 * c.x - x2 * c.y; hi[j] = x2 * c.x + x1 * c.y; }
#pragma unroll
                                for (int h = 0; h < 8; ++h) { st_bf4(d + h * 96 + rg * 8 + fh * 4, lo[0], lo[1], lo[2], lo[3]); st_bf4(d + h * 96 + 16 + rg * 8 + fh * 4, hi[0], hi[1], hi[2], hi[3]); }
                            }
                        }
                    } else if (n0 < 1536) {
                        bf16_t* d = (n0 < 1024) ? (bf16_t*)(ws + OFF_SBQ) + (size_t)tok * 512 + (cb - 512) : (bf16_t*)(ws + OFF_SBK) + (size_t)tok * 512 + (cb - 1024);
#pragma unroll
                        for (int rg = 0; rg < 4; ++rg) st_bf4(d + rg * 8, acc[nt][mt][rg * 4] * rs, acc[nt][mt][rg * 4 + 1] * rs, acc[nt][mt][rg * 4 + 2] * rs, acc[nt][mt][rg * 4 + 3] * rs);
                    } else if (n0 < 2048) {
                        const int b = tok >> 13, s = tok & 8191;
                        bf16_t* d = (bf16_t*)(ws + OFF_VTB) + ((size_t)b * 512 + (cb - 1536)) * SEQ + s;
#pragma unroll
                        for (int r = 0; r < 16; ++r) d[(size_t)((r >> 2) * 8 + (r & 3)) * SEQ] = bf1(acc[nt][mt][r] * rs);
                    } else {
                        const int gi = n0 >= 3072;
                        const int c0 = cb - (gi ? 3072 : 2048);
                        bf16_t* d = (bf16_t*)(ws + (gi ? OFF_SIGB : OFF_SIGA)) + (size_t)tok * DM + c0;
                        const float* bg = p.b_gate + gi * DM + c0;
#pragma unroll
                        for (int rg = 0; rg < 4; ++rg) { const f32x4 bb = *(const f32x4*)(bg + rg * 8); float o[4];
#pragma unroll
                            for (int j = 0; j < 4; ++j) { const float z = acc[nt][mt][rg * 4 + j] * rs + bb[j]; o[j] = __builtin_amdgcn_rcpf(1.f + ex2(-z * LOG2E)); }
                            st_bf4(d + rg * 8, o[0], o[1], o[2], o[3]); }
                    }
                }
                if (n0 < 384) { ssq += shx32(ssq); if (fh == 0) atomicAdd((float*)(ws + (n0 < 256 ? OFF_SSQ_Q : OFF_SSQ_KV)) + tok, ssq); }
            }
        } else {
            const int u = tl - NT1; const int m0 = (u & 7) * 128, n0 = (u >> 3) * 128;
            gemm_main((const bf16_t*)(ws + OFF_MNB), DM, (const bf16_t*)(ws + OFF_WXKV), DM, DM, m0, n0, acc, lds);
#pragma unroll
            for (int mt = 0; mt < 2; ++mt) {
                const int tok = m0 + wm * 64 + mt * 32 + fr;
#pragma unroll
                for (int nt = 0; nt < 2; ++nt) {
                    const int cb = n0 + wn * 64 + nt * 32 + fh * 4;
                    if (n0 < 512) { bf16_t* d = (bf16_t*)(ws + OFF_XK) + (size_t)tok * 512 + cb;
#pragma unroll
                        for (int rg = 0; rg < 4; ++rg) st_bf4(d + rg * 8, acc[nt][mt][rg * 4], acc[nt][mt][rg * 4 + 1], acc[nt][mt][rg * 4 + 2], acc[nt][mt][rg * 4 + 3]);
                    } else { const int b = tok >> 8, m = tok & 255;
                        bf16_t* d = (bf16_t*)(ws + OFF_XVT) + ((size_t)b * 512 + (cb - 512)) * MEML + m;
#pragma unroll
                        for (int r = 0; r < 16; ++r) d[(size_t)((r >> 2) * 8 + (r & 3)) * MEML] = bf1(acc[nt][mt][r]);
                    }
                }
            }
        }
    }
}

DI void phase2(const Params& p, char* lds) {
    char* ws = p.ws;
    const int t = threadIdx.x, lane = t & 63, w = t >> 6, wm = w >> 1, wn = w & 1, fr = lane & 31, fh = lane >> 5;
    constexpr int NTQ = 256 * 6, NTKV = 256 * 8;
    for (int tl = blockIdx.x; tl < NTQ + NTKV; tl += gridDim.x) {
        f32x16 acc[2][2]; zero_acc(acc);
        if (tl < NTQ) {
            const int mi = tl / 6, ni = tl - mi * 6; const int m0 = mi * 128, n0 = ni * 128;
            gemm_main((const bf16_t*)(ws + OFF_CQ), 256, (const bf16_t*)(ws + OFF_WUQ), 256, 256, m0, n0, acc, lds);
#pragma unroll
            for (int mt = 0; mt < 2; ++mt) {
                const int tok = m0 + wm * 64 + mt * 32 + fr;
                const float rs = rsqrtf(((const float*)(ws + OFF_SSQ_Q))[tok] * (1.0f / 256.0f) + EPS);
                const f32x2* cs = (const f32x2*)(ws + OFF_CS) + (size_t)tok * 16;
#pragma unroll
                for (int nt = 0; nt < 2; ++nt) {
                    const int c32 = n0 + wn * 64 + nt * 32;
                    bf16_t* d = (bf16_t*)(ws + OFF_QA) + (size_t)tok * 768 + c32 + fh * 4;
                    if (((c32 >> 5) % 3) == 2) {
#pragma unroll
                        for (int rg = 0; rg < 2; ++rg) { float lo[4], hi[4];
#pragma unroll
                            for (int j = 0; j < 4; ++j) { const f32x2 c = cs[rg * 8 + fh * 4 + j]; const float x1 = acc[nt][mt][rg * 4 + j] * rs, x2 = acc[nt][mt][8 + rg * 4 + j] * rs;
                                lo[j] = x1 * c.x - x2 * c.y; hi[j] = x2 * c.x + x1 * c.y; }
                            st_bf4(d + rg * 8, lo[0], lo[1], lo[2], lo[3]); st_bf4(d + 16 + rg * 8, hi[0], hi[1], hi[2], hi[3]); }
                    } else {
#pragma unroll
                        for (int rg = 0; rg < 4; ++rg) st_bf4(d + rg * 8, acc[nt][mt][rg * 4] * rs, acc[nt][mt][rg * 4 + 1] * rs, acc[nt][mt][rg * 4 + 2] * rs, acc[nt][mt][rg * 4 + 3] * rs);
                    }
                }
            }
        } else {
            const int u = tl - NTQ; const int mi = u >> 3, h = u & 7; const int m0 = mi * 128, n0 = h * 128;
            gemm_main((const bf16_t*)(ws + OFF_CKV), 128, (const bf16_t*)(ws + OFF_WUKV), 128, 128, m0, n0, acc, lds);
#pragma unroll
            for (int mt = 0; mt < 2; ++mt) {
                const int tok = m0 + wm * 64 + mt * 32 + fr;
                const float rs = rsqrtf(((const float*)(ws + OFF_SSQ_KV))[tok] * (1.0f / 128.0f) + EPS);
#pragma unroll
                for (int nt = 0; nt < 2; ++nt) {
                    if (wn == 0) {
                        bf16_t* d = (bf16_t*)(ws + OFF_KA) + (size_t)tok * 768 + h * 96 + nt * 32 + fh * 4;
#pragma unroll
                        for (int rg = 0; rg < 4; ++rg) st_bf4(d + rg * 8, acc[nt][mt][rg * 4] * rs, acc[nt][mt][rg * 4 + 1] * rs, acc[nt][mt][rg * 4 + 2] * rs, acc[nt][mt][rg * 4 + 3] * rs);
                    } else {
                        const int b = tok >> 13, s = tok & 8191;
                        bf16_t* d = (bf16_t*)(ws + OFF_VTA) + ((size_t)(b * 8 + h) * 64 + nt * 32 + fh * 4) * SEQ + s;
#pragma unroll
                        for (int r = 0; r < 16; ++r) d[(size_t)((r >> 2) * 8 + (r & 3)) * SEQ] = bf1(acc[nt][mt][r] * rs);
                    }
                }
            }
        }
    }
}

template <int DQK> DI int ksw(int row, int c) { return DQK == 64 ? (c ^ ((row >> 1) & 7)) : DQK == 96 ? (c ^ ((row >> 2) & 3)) : (c ^ (row & 15)); }

template <int DQK, int DV, int MODE>
DI void attn_block(const bf16_t* __restrict__ Q, int ldq, const bf16_t* __restrict__ Kp, int ldk, const bf16_t* __restrict__ Vt, int ldv,
                   bf16_t* __restrict__ O, int ldo, int q0, int ntiles, char* lds) {
    constexpr int NCK = DQK / 8, KB = 64 * DQK * 2, VB = DV * 128, STG = KB + VB, NKL = NCK / 4, NVL = DV / 32, NKK = DQK / 16, NDT = DV / 32;
    const int t = threadIdx.x, lane = t & 63, w = t >> 6, fr = lane & 31, fh = lane >> 5;
    const int qrow = q0 + w * 32 + fr;
    const int qlo = q0 + w * 32, qhi = qlo + 31;
    unsigned* flags = (unsigned*)(lds + 2 * STG);
    bf16x8 qf[NKK];
#pragma unroll
    for (int kk = 0; kk < NKK; ++kk) qf[kk] = *(const bf16x8*)(Q + (size_t)qrow * ldq + kk * 16 + fh * 8);
    f32x16 o[NDT];
#pragma unroll
    for (int d = 0; d < NDT; ++d)
#pragma unroll
        for (int r = 0; r < 16; ++r) o[d][r] = 0.f;
    float m_run = -1e30f, l_run = 0.f;
    u32x4 rk[NKL], rv[NVL];
    auto gload = [&](int kt) {
        const int key0 = kt * 64;
#pragma unroll
        for (int i = 0; i < NKL; ++i) { const int id = t + 256 * i; const int row = id / NCK, c = id - row * NCK; rk[i] = *(const u32x4*)(Kp + (size_t)(key0 + row) * ldk + c * 8); }
#pragma unroll
        for (int i = 0; i < NVL; ++i) { const int id = t + 256 * i; const int row = id >> 3, c = id & 7; rv[i] = *(const u32x4*)(Vt + (size_t)row * ldv + key0 + c * 8); }
    };
    auto sstore = [&](char* buf) {
#pragma unroll
        for (int i = 0; i < NKL; ++i) { const int id = t + 256 * i; const int row = id / NCK, c = id - row * NCK; *(u32x4*)(buf + row * (DQK * 2) + (ksw<DQK>(row, c) << 4)) = rk[i]; }
#pragma unroll
        for (int i = 0; i < NVL; ++i) { const int id = t + 256 * i; const int row = id >> 3, c = id & 7; const int g2 = (c >> 1) * 2, a = c & 1, sw = (row >> 1) & 7;
            char* rb_ = buf + KB + row * 128 + a * 8;
            u32x2 lo2, hi2; lo2.x = rv[i].x; lo2.y = rv[i].y; hi2.x = rv[i].z; hi2.y = rv[i].w;
            *(u32x2*)(rb_ + ((g2 ^ sw) << 4)) = lo2; *(u32x2*)(rb_ + (((g2 + 1) ^ sw) << 4)) = hi2; }
    };
    auto tile_of = [&](int it) { return MODE == 1 ? (ntiles - 1 - it) : it; };
    gload(tile_of(0)); sstore(lds); __syncthreads();
    for (int it = 0; it < ntiles; ++it) {
        const int kt = tile_of(it), key0 = kt * 64;
        const char* buf = lds + (it & 1) * STG;
        const bool more = it + 1 < ntiles;
        if (more && MODE != 2) gload(tile_of(it + 1));
        bool active;
        if (MODE == 0) active = key0 <= qhi; else if (MODE == 1) active = key0 < qhi; else active = true;
        if (active) {
            f32x16 s[2];
#pragma unroll
            for (int mt = 0; mt < 2; ++mt)
#pragma unroll
                for (int r = 0; r < 16; ++r) s[mt][r] = 0.f;
#pragma unroll
            for (int kk = 0; kk < NKK; ++kk)
#pragma unroll
                for (int mt = 0; mt < 2; ++mt) { const int row = mt * 32 + fr; const bf16x8 kf = *(const bf16x8*)(buf + row * (DQK * 2) + (ksw<DQK>(row, kk * 2 + fh) << 4)); s[mt] = MFMA(kf, qf[kk], s[mt]); }
            bf16x8 pf[4];
            if (MODE != 1) {
                if (MODE == 0 && key0 + 63 > qlo) {
#pragma unroll
                    for (int mt = 0; mt < 2; ++mt)
#pragma unroll
                        for (int r = 0; r < 16; ++r) { const int key = key0 + mt * 32 + (r >> 2) * 8 + fh * 4 + (r & 3); if (key > qrow) s[mt][r] = -1e30f; }
                }
                float mx = s[0][0];
#pragma unroll
                for (int mt = 0; mt < 2; ++mt)
#pragma unroll
                    for (int r = 0; r < 16; ++r) mx = fmaxf(mx, s[mt][r]);
                mx = fmaxf(mx, shx32(mx));
                const float mnew = fmaxf(m_run, mx); const float alpha = ex2(m_run - mnew); m_run = mnew;
                float sum = 0.f;
#pragma unroll
                for (int mt = 0; mt < 2; ++mt)
#pragma unroll
                    for (int r = 0; r < 16; ++r) { const float pv = ex2(s[mt][r] - mnew); s[mt][r] = pv; sum += pv; }
                l_run = l_run * alpha + sum;
#pragma unroll
                for (int d = 0; d < NDT; ++d)
#pragma unroll
                    for (int r = 0; r < 16; ++r) o[d][r] *= alpha;
            } else {
                const bool diag = key0 + 63 >= qlo;
                float G[8];
#pragma unroll
                for (int mt = 0; mt < 2; ++mt)
#pragma unroll
                    for (int rg = 0; rg < 4; ++rg) {
                        float g = 0.f;
#pragma unroll
                        for (int j = 3; j >= 0; --j) { const int r = rg * 4 + j; const float z = s[mt][r];
                            const float wv = lg2(1.f + ex2(-fabsf(z)));
                            float nlom = fmaxf(z, 0.f) + wv; float nl = nlom - z;
                            if (diag) { const int key = key0 + mt * 32 + rg * 8 + fh * 4 + j; if (key >= qrow) { nlom = 0.f; nl = 1e30f; } }
                            s[mt][r] = nl + g; g += nlom; }
                        G[mt * 4 + rg] = g;
                    }
                float base[8]; float run = l_run;
#pragma unroll
                for (int oc = 7; oc >= 0; --oc) { const float gp = shx32(G[oc]); base[oc] = run + (fh == 0 ? gp : 0.f); run += G[oc] + gp; }
                l_run = run;
#pragma unroll
                for (int mt = 0; mt < 2; ++mt)
#pragma unroll
                    for (int r = 0; r < 16; ++r) s[mt][r] = ex2(-(s[mt][r] + base[mt * 4 + (r >> 2)]));
            }
#pragma unroll
            for (int s4 = 0; s4 < 4; ++s4) { u32x4 pk; const int mt = s4 >> 1, rb = (s4 & 1) * 8;
                pk.x = pk2(s[mt][rb], s[mt][rb + 1]); pk.y = pk2(s[mt][rb + 2], s[mt][rb + 3]); pk.z = pk2(s[mt][rb + 4], s[mt][rb + 5]); pk.w = pk2(s[mt][rb + 6], s[mt][rb + 7]);
                pf[s4] = __builtin_bit_cast(bf16x8, pk); }
#pragma unroll
            for (int s4 = 0; s4 < 4; ++s4)
#pragma unroll
                for (int d = 0; d < NDT; ++d) { const int row = d * 32 + fr; const bf16x8 vf = *(const bf16x8*)(buf + KB + row * 128 + (((s4 * 2 + fh) ^ ((row >> 1) & 7)) << 4)); o[d] = MFMA(vf, pf[s4], o[d]); }
        }
        if (more) { if (MODE == 2) gload(tile_of(it + 1)); sstore(lds + ((it + 1) & 1) * STG); }
        if (MODE == 1) {
            const bool fin = __all(l_run > 152.f) != 0;
            if (lane == 0) flags[(it & 1) * 4 + w] = fin ? 1u : 0u;
            __syncthreads();
            const unsigned* f = flags + (it & 1) * 4;
            if ((f[0] & f[1] & f[2] & f[3]) != 0u) break;
        } else {
            __syncthreads();
        }
    }
    float inv = 1.f;
    if (MODE != 1) { const float lt = l_run + shx32(l_run); inv = 1.f / lt; }
#pragma unroll
    for (int d = 0; d < NDT; ++d)
#pragma unroll
        for (int rg = 0; rg < 4; ++rg) st_bf4(O + (size_t)qrow * ldo + d * 32 + rg * 8 + fh * 4, o[d][rg * 4] * inv, o[d][rg * 4 + 1] * inv, o[d][rg * 4 + 2] * inv, o[d][rg * 4 + 3] * inv);
}

DI void phase3(const Params& p, char* lds) {
    char* ws = p.ws;
    constexpr int NMLA = 32 * 32, NSB = 32 * 64;
    for (int u = blockIdx.x; u < NMLA + NSB; u += gridDim.x) {
        if (u < NMLA) {
            const int xcd = u & 7, v = u >> 3; const int pr = v & 31, bh = (v >> 5) * 8 + xcd; const int b = bh >> 3, h = bh & 7;
            const bf16_t* Q = (const bf16_t*)(ws + OFF_QA) + (size_t)b * SEQ * 768 + h * 96;
            const bf16_t* Kp = (const bf16_t*)(ws + OFF_KA) + (size_t)b * SEQ * 768 + h * 96;
            const bf16_t* Vt = (const bf16_t*)(ws + OFF_VTA) + (size_t)(b * 8 + h) * 64 * SEQ;
            bf16_t* O = (bf16_t*)(ws + OFF_OA) + (size_t)b * SEQ * 512 + h * 64;
#pragma unroll 1
            for (int half = 0; half < 2; ++half) { const int qb = half ? pr : 63 - pr;
                attn_block<96, 64, 0>(Q, 768, Kp, 768, Vt, SEQ, O, 512, qb * 128, 2 * qb + 2, lds); }
        } else {
            const int v = u - NMLA; const int qb = v & 63, bh = v >> 6; const int b = bh >> 3, h = bh & 7;
            const bf16_t* Q = (const bf16_t*)(ws + OFF_SBQ) + (size_t)b * SEQ * 512 + h * 64;
            const bf16_t* Kp = (const bf16_t*)(ws + OFF_SBK) + (size_t)b * SEQ * 512 + h * 64;
            const bf16_t* Vt = (const bf16_t*)(ws + OFF_VTB) + (size_t)(b * 8 + h) * 64 * SEQ;
            bf16_t* O = (bf16_t*)(ws + OFF_OB) + (size_t)b * SEQ * 512 + h * 64;
            attn_block<64, 64, 1>(Q, 512, Kp, 512, Vt, SEQ, O, 512, qb * 128, 2 * qb + 2, lds);
        }
    }
}

DI void phase4(const Params& p, char* lds) {
    char* ws = p.ws;
    const int t = threadIdx.x, lane = t & 63, w = t >> 6, wm = w >> 1, wn = w & 1, fr = lane & 31, fh = lane >> 5;
    for (int tl = blockIdx.x; tl < 256 * 8; tl += gridDim.x) {
        int mi, ni; tile_mn(tl, 8, mi, ni); const int m0 = mi * 128, n0 = ni * 128;
        f32x16 acc[2][2], acc2[2][2]; zero_acc(acc); zero_acc(acc2);
        gemm_main((const bf16_t*)(ws + OFF_OA), 512, (const bf16_t*)(ws + OFF_WA), 512, 512, m0, n0, acc, lds);
        gemm_main((const bf16_t*)(ws + OFF_OB), 512, (const bf16_t*)(ws + OFF_WB), 512, 512, m0, n0, acc2, lds);
#pragma unroll
        for (int mt = 0; mt < 2; ++mt) {
            const int tok = m0 + wm * 64 + mt * 32 + fr;
#pragma unroll
            for (int nt = 0; nt < 2; ++nt) {
                const size_t off = (size_t)tok * DM + n0 + wn * 64 + nt * 32 + fh * 4;
#pragma unroll
                for (int rg = 0; rg < 4; ++rg) {
                    const u32x2 sa = *(const u32x2*)((const bf16_t*)(ws + OFF_SIGA) + off + rg * 8), sb = *(const u32x2*)((const bf16_t*)(ws + OFF_SIGB) + off + rg * 8);
                    const float a0 = __uint_as_float(sa.x << 16), a1 = __uint_as_float(sa.x & 0xffff0000u), a2 = __uint_as_float(sa.y << 16), a3 = __uint_as_float(sa.y & 0xffff0000u);
                    const float b0 = __uint_as_float(sb.x << 16), b1 = __uint_as_float(sb.x & 0xffff0000u), b2 = __uint_as_float(sb.y << 16), b3 = __uint_as_float(sb.y & 0xffff0000u);
                    st_bf4((bf16_t*)(ws + OFF_MERGED) + off + rg * 8, a0 * acc[nt][mt][rg * 4] + b0 * acc2[nt][mt][rg * 4], a1 * acc[nt][mt][rg * 4 + 1] + b1 * acc2[nt][mt][rg * 4 + 1],
                           a2 * acc[nt][mt][rg * 4 + 2] + b2 * acc2[nt][mt][rg * 4 + 2], a3 * acc[nt][mt][rg * 4 + 3] + b3 * acc2[nt][mt][rg * 4 + 3]);
                }
            }
        }
    }
}

DI void phase_res(const bf16_t* A, int K, const bf16_t* Bt, const float* res, float* out, bf16_t* outb, float* ssqp, char* lds) {
    const int t = threadIdx.x, lane = t & 63, w = t >> 6, wm = w >> 1, wn = w & 1, fr = lane & 31, fh = lane >> 5;
    for (int tl = blockIdx.x; tl < 256 * 8; tl += gridDim.x) {
        int mi, ni; tile_mn(tl, 8, mi, ni); const int m0 = mi * 128, n0 = ni * 128;
        f32x16 acc[2][2]; zero_acc(acc);
        gemm_main(A, K, Bt, K, K, m0, n0, acc, lds);
#pragma unroll
        for (int mt = 0; mt < 2; ++mt) {
            const int tok = m0 + wm * 64 + mt * 32 + fr; float ssq = 0.f;
#pragma unroll
            for (int nt = 0; nt < 2; ++nt) {
                const size_t off = (size_t)tok * DM + n0 + wn * 64 + nt * 32 + fh * 4;
#pragma unroll
                for (int rg = 0; rg < 4; ++rg) {
                    f32x4 r = *(const f32x4*)(res + off + rg * 8);
                    r[0] += acc[nt][mt][rg * 4]; r[1] += acc[nt][mt][rg * 4 + 1]; r[2] += acc[nt][mt][rg * 4 + 2]; r[3] += acc[nt][mt][rg * 4 + 3];
                    ssq += r[0] * r[0] + r[1] * r[1] + r[2] * r[2] + r[3] * r[3];
                    *(f32x4*)(out + off + rg * 8) = r;
                    if (outb) st_bf4(outb + off + rg * 8, r[0], r[1], r[2], r[3]);
                }
            }
            ssq += shx32(ssq); if (fh == 0) atomicAdd(ssqp + tok, ssq);
        }
    }
}

DI void phase6(const Params& p, char* lds) {
    char* ws = p.ws;
    const int t = threadIdx.x, lane = t & 63, w = t >> 6, wm = w >> 1, wn = w & 1, fr = lane & 31, fh = lane >> 5;
    for (int tl = blockIdx.x; tl < 256 * 4; tl += gridDim.x) {
        int mi, ni; tile_mn(tl, 4, mi, ni); const int m0 = mi * 128, n0 = ni * 128;
        f32x16 acc[2][2]; zero_acc(acc);
        gemm_main((const bf16_t*)(ws + OFF_X1B), DM, (const bf16_t*)(ws + OFF_WXQ), DM, DM, m0, n0, acc, lds);
#pragma unroll
        for (int mt = 0; mt < 2; ++mt) {
            const int tok = m0 + wm * 64 + mt * 32 + fr;
            const float rs = rsqrtf(((const float*)(ws + OFF_SSQ1))[tok] * (1.0f / DM) + EPS);
#pragma unroll
            for (int nt = 0; nt < 2; ++nt) { bf16_t* d = (bf16_t*)(ws + OFF_XQ) + (size_t)tok * 512 + n0 + wn * 64 + nt * 32 + fh * 4;
#pragma unroll
                for (int rg = 0; rg < 4; ++rg) st_bf4(d + rg * 8, acc[nt][mt][rg * 4] * rs, acc[nt][mt][rg * 4 + 1] * rs, acc[nt][mt][rg * 4 + 2] * rs, acc[nt][mt][rg * 4 + 3] * rs); }
        }
    }
}

DI void phase7(const Params& p, char* lds) {
    char* ws = p.ws;
    for (int u = blockIdx.x; u < 4 * 4 * 64; u += gridDim.x) {
        const int qb = u & 63, bh = u >> 6; const int b = bh >> 2, h = bh & 3;
        const bf16_t* Q = (const bf16_t*)(ws + OFF_XQ) + (size_t)b * SEQ * 512 + h * 128;
        const bf16_t* Kp = (const bf16_t*)(ws + OFF_XK) + (size_t)b * MEML * 512 + h * 128;
        const bf16_t* Vt = (const bf16_t*)(ws + OFF_XVT) + (size_t)(b * 4 + h) * 128 * MEML;
        bf16_t* O = (bf16_t*)(ws + OFF_XO) + (size_t)b * SEQ * 512 + h * 128;
        attn_block<128, 128, 2>(Q, 512, Kp, 512, Vt, MEML, O, 512, qb * 128, 4, lds);
    }
}

DI void phase9(const Params& p, char* lds) {
    char* ws = p.ws;
    const int t = threadIdx.x, lane = t & 63, w = t >> 6, wm = w >> 1, wn = w & 1, fr = lane & 31, fh = lane >> 5;
    for (int tl = blockIdx.x; tl < 256 * 44; tl += gridDim.x) {
        int mi, ni; tile_mn(tl, 44, mi, ni); const int m0 = mi * 128, n0 = ni * 128;
        f32x16 acc[2][2]; zero_acc(acc);
        gemm_main((const bf16_t*)(ws + OFF_X2B), DM, (const bf16_t*)(ws + OFF_WGU), DM, DM, m0, n0, acc, lds);
#pragma unroll
        for (int mt = 0; mt < 2; ++mt) {
            const int tok = m0 + wm * 64 + mt * 32 + fr;
            const float rs = rsqrtf(((const float*)(ws + OFF_SSQ2))[tok] * (1.0f / DM) + EPS);
            bf16_t* d = (bf16_t*)(ws + OFF_HID) + (size_t)tok * DFF + ni * 64 + wn * 32 + fh * 4;
#pragma unroll
            for (int rg = 0; rg < 4; ++rg) { float o4[4];
#pragma unroll
                for (int j = 0; j < 4; ++j) { const float g = acc[0][mt][rg * 4 + j] * rs, uu = acc[1][mt][rg * 4 + j] * rs; o4[j] = g * __builtin_amdgcn_rcpf(1.f + ex2(-g * LOG2E)) * uu; }
                st_bf4(d + rg * 8, o4[0], o4[1], o4[2], o4[3]); }
        }
    }
}

DI void phase11(const Params& p) {
    const float* ssq3 = (const float*)(p.ws + OFF_SSQ3);
    for (size_t i = (size_t)blockIdx.x * 256 + threadIdx.x; i < (size_t)T * DM / 4; i += (size_t)gridDim.x * 256) {
        const int tok = (int)(i >> 8), c = (int)(i & 255) * 4;
        const float rs = rsqrtf(ssq3[tok] * (1.0f / DM) + EPS);
        f32x4 v = *(f32x4*)(p.out + i * 4); const f32x4 g = *(const f32x4*)(p.g_final + c);
        v[0] *= rs * g[0]; v[1] *= rs * g[1]; v[2] *= rs * g[2]; v[3] *= rs * g[3];
        *(f32x4*)(p.out + i * 4) = v;
    }
}

constexpr int NPHASE = 12;
__global__ void __launch_bounds__(256, 2) mega(Params p, int ph_lo, int ph_hi, int coop) {
    __shared__ __attribute__((aligned(16))) char lds[65536 + 64];
    char* ws = p.ws;
#define PH(n, call) if (ph_lo <= n && n < ph_hi) { call; } if (coop && n + 1 < NPHASE) cg::this_grid().sync();
    PH(0, phase0(p, (float*)lds))
    PH(1, phase1(p, lds))
    PH(2, phase2(p, lds))
    PH(3, phase3(p, lds))
    PH(4, phase4(p, lds))
    PH(5, phase_res((const bf16_t*)(ws + OFF_MERGED), DM, (const bf16_t*)(ws + OFF_WO), p.x, p.out, (bf16_t*)(ws + OFF_X1B), (float*)(ws + OFF_SSQ1), lds))
    PH(6, phase6(p, lds))
    PH(7, phase7(p, lds))
    PH(8, phase_res((const bf16_t*)(ws + OFF_XO), 512, (const bf16_t*)(ws + OFF_WXO), p.out, p.out, (bf16_t*)(ws + OFF_X2B), (float*)(ws + OFF_SSQ2), lds))
    PH(9, phase9(p, lds))
    PH(10, phase_res((const bf16_t*)(ws + OFF_HID), DFF, (const bf16_t*)(ws + OFF_WD), p.out, p.out, nullptr, (float*)(ws + OFF_SSQ3), lds))
    PH(11, phase11(p))
}

extern "C" void kernel_launch(void* const* d_in, const int* in_sizes, int n_in, void* d_out, int out_size, void* d_ws, size_t ws_size, hipStream_t stream) {
    static int grid_blocks = 0;
    if (!grid_blocks) {
        int dev = 0, cus = 0, per_cu = 0;
        hipGetDevice(&dev);
        hipDeviceGetAttribute(&cus, hipDeviceAttributeMultiprocessorCount, dev);
        hipOccupancyMaxActiveBlocksPerMultiprocessor(&per_cu, mega, 256, 0);
        if (per_cu > 2) per_cu = 2;
        if (per_cu < 1) per_cu = 1;
        grid_blocks = cus * per_cu;
    }
    Params p{};
    p.x = (const float*)d_in[0]; p.mem = (const float*)d_in[1]; p.pos = (const int*)d_in[2];
    p.g_mix = (const float*)d_in[3]; p.w_in = (const float*)d_in[4]; p.b_gate = (const float*)d_in[5]; p.g_q_lat = (const float*)d_in[6]; p.w_uq = (const float*)d_in[7];
    p.g_kv_lat = (const float*)d_in[8]; p.w_ukv = (const float*)d_in[9]; p.w_a = (const float*)d_in[10]; p.w_b = (const float*)d_in[11]; p.w_o = (const float*)d_in[12];
    p.g_x = (const float*)d_in[13]; p.g_mem = (const float*)d_in[14]; p.w_xq = (const float*)d_in[15]; p.w_xkv = (const float*)d_in[16]; p.w_xo = (const float*)d_in[17];
    p.g_ffn = (const float*)d_in[18]; p.w_gate = (const float*)d_in[19]; p.w_up = (const float*)d_in[20]; p.w_down = (const float*)d_in[21]; p.g_final = (const float*)d_in[22];
    p.out = (float*)d_out; p.ws = (char*)d_ws;
#if ONE_LAUNCH
    int lo = 0, hi = NPHASE, coop = 1;
    void* args[] = {&p, &lo, &hi, &coop};
    hipError_t e = hipLaunchCooperativeKernel((void*)mega, dim3(grid_blocks), dim3(256), args, 0, stream);
    if (e != hipSuccess) fprintf(stderr, "cooperative launch failed: %s (grid %d)\n", hipGetErrorString(e), grid_blocks);
#else
    for (int ph = 0; ph < NPHASE; ++ph) mega<<<dim3(grid_blocks), dim3(256), 0, stream>>>(p, ph, ph + 1, 0);
#endif
}
```

```cpp
#include <hip/hip_runtime.h>
#include <hip/hip_cooperative_groups.h>
#include <cstdio>
#include <cstdint>
namespace cg = cooperative_groups;

#ifndef ONE_LAUNCH
#define ONE_LAUNCH 1
#endif

typedef unsigned short bf16_t;
typedef short bf16x8 __attribute__((ext_vector_type(8)));
typedef float f32x16 __attribute__((ext_vector_type(16)));
typedef float f32x4 __attribute__((ext_vector_type(4)));
typedef float f32x2 __attribute__((ext_vector_type(2)));
typedef unsigned u32x4 __attribute__((ext_vector_type(4)));
typedef unsigned u32x2 __attribute__((ext_vector_type(2)));
typedef __bf16 bf16x2_t __attribute__((ext_vector_type(2)));
#define DI __device__ __forceinline__
#define MFMA(a, b, c) __builtin_amdgcn_mfma_f32_32x32x16_bf16((a), (b), (c), 0, 0, 0)

constexpr int T = 32768, SEQ = 8192, NB = 4, DM = 1024, MEMT = 1024, MEML = 256;
constexpr int DFF = 2816;
constexpr float EPS = 1e-6f;
constexpr float LOG2E = 1.4426950408889634f;

constexpr size_t MB = 1024 * 1024;
constexpr size_t OFF_SSQ_Q = 0;
constexpr size_t OFF_SSQ_KV = OFF_SSQ_Q + T * 4;
constexpr size_t OFF_SSQ1 = OFF_SSQ_KV + T * 4;
constexpr size_t OFF_SSQ2 = OFF_SSQ1 + T * 4;
constexpr size_t OFF_SSQ3 = OFF_SSQ2 + T * 4;
constexpr size_t OFF_RSTD0 = OFF_SSQ3 + T * 4;
constexpr size_t OFF_BAR = 832 * 1024;
constexpr size_t OFF_CS = 1 * MB;
constexpr size_t OFF_WIN = 5 * MB;
constexpr size_t OFF_WUQ = OFF_WIN + 8 * MB;
constexpr size_t OFF_WUKV = OFF_WUQ + 768 * 256 * 2;
constexpr size_t OFF_WA = OFF_WUKV + 1024 * 128 * 2;
constexpr size_t OFF_WB = OFF_WA + 1 * MB;
constexpr size_t OFF_WO = OFF_WB + 1 * MB;
constexpr size_t OFF_WXQ = OFF_WO + 2 * MB;
constexpr size_t OFF_WXKV = OFF_WXQ + 1 * MB;
constexpr size_t OFF_WXO = OFF_WXKV + 2 * MB;
constexpr size_t OFF_WGU = OFF_WXO + 1 * MB;
constexpr size_t OFF_WD = OFF_WGU + 11 * MB;
constexpr size_t OFF_MNB = OFF_WD + 6 * MB;
constexpr size_t OFF_XK = OFF_MNB + 2 * MB;
constexpr size_t OFF_XVT = OFF_XK + 1 * MB;
constexpr size_t OFF_ACT = 48 * MB;
constexpr size_t OFF_XB = OFF_ACT;
constexpr size_t OFF_OA = OFF_XB;
constexpr size_t OFF_OB = OFF_XB + 32 * MB;
constexpr size_t OFF_CQ = OFF_XB + 64 * MB;
constexpr size_t OFF_CKV = OFF_CQ + 16 * MB;
constexpr size_t OFF_KA = OFF_CKV + 8 * MB;
constexpr size_t OFF_QA = OFF_KA + 48 * MB;
constexpr size_t OFF_VTA = OFF_QA + 48 * MB;
constexpr size_t OFF_SBQ = OFF_VTA + 32 * MB;
constexpr size_t OFF_SBK = OFF_SBQ + 32 * MB;
constexpr size_t OFF_VTB = OFF_SBK + 32 * MB;
constexpr size_t OFF_SIGA = OFF_VTB + 32 * MB;
constexpr size_t OFF_SIGB = OFF_SIGA + 64 * MB;
constexpr size_t WS_END = OFF_SIGB + 64 * MB;
constexpr size_t OFF_MERGED = OFF_KA;
constexpr size_t OFF_X1B = OFF_VTA;
constexpr size_t OFF_XQ = OFF_SBK;
constexpr size_t OFF_XO = OFF_VTB;
constexpr size_t OFF_X2B = OFF_SIGA;
constexpr size_t OFF_HID = OFF_KA;

struct Params {
    const float* x; const float* mem; const int* pos;
    const float* g_mix; const float* w_in; const float* b_gate; const float* g_q_lat; const float* w_uq;
    const float* g_kv_lat; const float* w_ukv; const float* w_a; const float* w_b; const float* w_o;
    const float* g_x; const float* g_mem; const float* w_xq; const float* w_xkv; const float* w_xo;
    const float* g_ffn; const float* w_gate; const float* w_up; const float* w_down; const float* g_final;
    float* out; char* ws;
};

DI unsigned pk2(float a, float b) { f32x2 v = {a, b}; bf16x2_t r = __builtin_convertvector(v, bf16x2_t); return __builtin_bit_cast(unsigned, r); }
DI bf16_t bf1(float a) { return (bf16_t)(pk2(a, 0.f) & 0xffffu); }
DI float ex2(float x) { return __builtin_amdgcn_exp2f(x); }
DI float lg2(float x) { return __builtin_amdgcn_logf(x); }
DI float shx32(float v) { return __shfl_xor(v, 32); }

DI void wt_tile(const float* __restrict__ src, int N, int sc, int k0, bf16_t* __restrict__ dst, int K, int drow0, const float* __restrict__ g, float scale, float* lds) {
    const int t = threadIdx.x;
    {
        const int nn = t & 31, kb = t >> 5;
#pragma unroll
        for (int i = 0; i < 8; ++i) {
            const int kk = kb + 8 * i;
            float v = 0.f;
            if (sc >= 0) { v = src[(size_t)(k0 + kk) * N + sc + nn] * scale; if (g) v *= g[k0 + kk]; }
            lds[kk * 33 + nn] = v;
        }
    }
    __syncthreads();
    {
        const int kk = t & 63, nb = t >> 6;
#pragma unroll
        for (int i = 0; i < 8; ++i) {
            const int nn = nb + 4 * i;
            dst[(size_t)(drow0 + nn) * K + k0 + kk] = bf1(lds[kk * 33 + nn]);
        }
    }
    __syncthreads();
}

constexpr float SBQ_SCALE = LOG2E * 0.125f;
constexpr float MLAQ_SCALE = LOG2E * 0.10206207261596577f;
constexpr float XQ_SCALE = LOG2E * 0.08838834764831845f;

DI void phase0(const Params& p, float* ldsf) {
    char* ws = p.ws;
    constexpr int J0 = 128 * 16;
    constexpr int J1 = J0 + 24 * 4;
    constexpr int J2 = J1 + 32 * 2;
    constexpr int J3 = J2 + 32 * 8;
    constexpr int J4 = J3 + 32 * 8;
    constexpr int J5 = J4 + 32 * 16;
    constexpr int J6 = J5 + 16 * 16;
    constexpr int J7 = J6 + 32 * 16;
    constexpr int J8 = J7 + 32 * 8;
    constexpr int J9 = J8 + 176 * 16;
    constexpr int J10 = J9 + 32 * 44;
    for (int tl = blockIdx.x; tl < J10; tl += gridDim.x) {
        if (tl < J0) { const int jn = tl >> 4, jk = tl & 15; const int d0 = jn * 32; int sc; float s = 1.f;
            if (d0 < 416) sc = d0; else if (d0 < 512) sc = -1; else { sc = d0 - 96; if (d0 < 1024) s = SBQ_SCALE; }
            wt_tile(p.w_in, 4000, sc, jk * 64, (bf16_t*)(ws + OFF_WIN), 1024, d0, p.g_mix, s, ldsf); }
        else if (tl < J1) { const int u = tl - J0; const int jn = u >> 2, jk = u & 3;
            wt_tile(p.w_uq, 768, jn * 32, jk * 64, (bf16_t*)(ws + OFF_WUQ), 256, jn * 32, p.g_q_lat, MLAQ_SCALE, ldsf); }
        else if (tl < J2) { const int u = tl - J1; const int jn = u >> 1, jk = u & 1;
            wt_tile(p.w_ukv, 1024, jn * 32, jk * 64, (bf16_t*)(ws + OFF_WUKV), 128, jn * 32, p.g_kv_lat, 1.f, ldsf); }
        else if (tl < J3) { const int u = tl - J2; const int jn = u >> 3, jk = u & 7;
            wt_tile(p.w_a, 1024, jn * 32, jk * 64, (bf16_t*)(ws + OFF_WA), 512, jn * 32, nullptr, 1.f, ldsf); }
        else if (tl < J4) { const int u = tl - J3; const int jn = u >> 3, jk = u & 7;
            wt_tile(p.w_b, 1024, jn * 32, jk * 64, (bf16_t*)(ws + OFF_WB), 512, jn * 32, nullptr, 1.f, ldsf); }
        else if (tl < J5) { const int u = tl - J4; const int jn = u >> 4, jk = u & 15;
            wt_tile(p.w_o, 1024, jn * 32, jk * 64, (bf16_t*)(ws + OFF_WO), 1024, jn * 32, nullptr, 1.f, ldsf); }
        else if (tl < J6) { const int u = tl - J5; const int jn = u >> 4, jk = u & 15;
            wt_tile(p.w_xq, 512, jn * 32, jk * 64, (bf16_t*)(ws + OFF_WXQ), 1024, jn * 32, p.g_x, XQ_SCALE, ldsf); }
        else if (tl < J7) { const int u = tl - J6; const int jn = u >> 4, jk = u & 15;
            wt_tile(p.w_xkv, 1024, jn * 32, jk * 64, (bf16_t*)(ws + OFF_WXKV), 1024, jn * 32, nullptr, 1.f, ldsf); }
        else if (tl < J8) { const int u = tl - J7; const int jn = u >> 3, jk = u & 7;
            wt_tile(p.w_xo, 1024, jn * 32, jk * 64, (bf16_t*)(ws + OFF_WXO), 512, jn * 32, nullptr, 1.f, ldsf); }
        else if (tl < J9) { const int u = tl - J8; const int jn = u >> 4, jk = u & 15;
            const float* src = (jn & 1) ? p.w_up : p.w_gate;
            wt_tile(src, DFF, (jn >> 1) * 32, jk * 64, (bf16_t*)(ws + OFF_WGU), 1024, jn * 32, p.g_ffn, 1.f, ldsf); }
        else { const int u = tl - J9; const int jn = u / 44, jk = u % 44;
            wt_tile(p.w_down, 1024, jn * 32, jk * 64, (bf16_t*)(ws + OFF_WD), DFF, jn * 32, nullptr, 1.f, ldsf); }
    }
    {
        float* z = (float*)(ws + OFF_SSQ_Q);
        for (int i = blockIdx.x * 256 + threadIdx.x; i < 5 * T; i += gridDim.x * 256) z[i] = 0.f;
    }
    const int lane = threadIdx.x & 63, w = threadIdx.x >> 6;
    for (int row = blockIdx.x * 4 + w; row < T + MEMT; row += gridDim.x * 4) {
        const bool ismem = row >= T;
        const float* src = ismem ? p.mem + (size_t)(row - T) * DM : p.x + (size_t)row * DM;
        f32x4 v[4]; float ss = 0.f;
#pragma unroll
        for (int i = 0; i < 4; ++i) { v[i] = *(const f32x4*)(src + i * 256 + lane * 4); ss += v[i][0] * v[i][0] + v[i][1] * v[i][1] + v[i][2] * v[i][2] + v[i][3] * v[i][3]; }
#pragma unroll
        for (int o = 32; o >= 1; o >>= 1) ss += __shfl_xor(ss, o);
        const float rstd = rsqrtf(ss * (1.0f / DM) + EPS);
        if (!ismem) {
            bf16_t* d = (bf16_t*)(ws + OFF_XB) + (size_t)row * DM;
#pragma unroll
            for (int i = 0; i < 4; ++i) { u32x2 o2; o2.x = pk2(v[i][0], v[i][1]); o2.y = pk2(v[i][2], v[i][3]); *(u32x2*)(d + i * 256 + lane * 4) = o2; }
            if (lane == 0) ((float*)(ws + OFF_RSTD0))[row] = rstd;
            if (lane < 16) {
                const float invf = exp2f(-(float)(2 * lane) * (13.287712379549449f / 32.0f));
                const float ang = (float)p.pos[row] * invf;
                const double a = (double)ang; const double kq = rint(a * 0.15915494309189535); const float r = (float)(a - kq * 6.283185307179586);
                f32x2 cs; cs.x = __cosf(r); cs.y = __sinf(r);
                ((f32x2*)(ws + OFF_CS))[(size_t)row * 16 + lane] = cs;
            }
        } else {
            bf16_t* d = (bf16_t*)(ws + OFF_MNB) + (size_t)(row - T) * DM;
#pragma unroll
            for (int i = 0; i < 4; ++i) { const f32x4 g = *(const f32x4*)(p.g_mem + i * 256 + lane * 4);
                u32x2 o2; o2.x = pk2(v[i][0] * rstd * g[0], v[i][1] * rstd * g[1]); o2.y = pk2(v[i][2] * rstd * g[2], v[i][3] * rstd * g[3]); *(u32x2*)(d + i * 256 + lane * 4) = o2; }
        }
    }
}

DI void gemm_main(const bf16_t* __restrict__ A, int lda, const bf16_t* __restrict__ Bt, int ldb, int K, int m0, int n0, f32x16 (&acc)[2][2], char* lds) {
    const int t = threadIdx.x, lane = t & 63, w = t >> 6, wm = w >> 1, wn = w & 1;
    const int lr = t >> 3, lc = t & 7;
    const bf16_t* ga = A + (size_t)(m0 + lr) * lda + lc * 8;
    const bf16_t* gb = Bt + (size_t)(n0 + lr) * ldb + lc * 8;
    const int soff = lr * 128 + ((lc ^ ((lr >> 1) & 7)) << 4);
    u32x4 ra[4], rb[4];
#pragma unroll
    for (int i = 0; i < 4; ++i) { ra[i] = *(const u32x4*)(ga + (size_t)i * 32 * lda); rb[i] = *(const u32x4*)(gb + (size_t)i * 32 * ldb); }
#pragma unroll
    for (int i = 0; i < 4; ++i) { *(u32x4*)(lds + soff + i * 4096) = ra[i]; *(u32x4*)(lds + 16384 + soff + i * 4096) = rb[i]; }
    __syncthreads();
    const int fr = lane & 31, fh = lane >> 5, fsw = (fr >> 1) & 7;
    const int xoff = (wm * 64 + fr) * 128, woff = 16384 + (wn * 64 + fr) * 128;
    const int nk = K >> 6;
    for (int kt = 0; kt < nk; ++kt) {
        const char* buf = lds + (kt & 1) * 32768;
        const bool more = kt + 1 < nk;
        if (more) {
            const int ko = (kt + 1) * 64;
#pragma unroll
            for (int i = 0; i < 4; ++i) { ra[i] = *(const u32x4*)(ga + (size_t)i * 32 * lda + ko); rb[i] = *(const u32x4*)(gb + (size_t)i * 32 * ldb + ko); }
        }
#pragma unroll
        for (int kk = 0; kk < 4; ++kk) {
            const int co = ((kk * 2 + fh) ^ fsw) << 4;
            bf16x8 xf[2], wf[2];
#pragma unroll
            for (int j = 0; j < 2; ++j) { xf[j] = *(const bf16x8*)(buf + xoff + j * 4096 + co); wf[j] = *(const bf16x8*)(buf + woff + j * 4096 + co); }
#pragma unroll
            for (int nt = 0; nt < 2; ++nt)
#pragma unroll
                for (int mt = 0; mt < 2; ++mt) acc[nt][mt] = MFMA(wf[nt], xf[mt], acc[nt][mt]);
        }
        if (more) {
            char* nb = lds + ((kt + 1) & 1) * 32768;
#pragma unroll
            for (int i = 0; i < 4; ++i) { *(u32x4*)(nb + soff + i * 4096) = ra[i]; *(u32x4*)(nb + 16384 + soff + i * 4096) = rb[i]; }
        }
        __syncthreads();
    }
}

DI void zero_acc(f32x16 (&acc)[2][2]) {
#pragma unroll
    for (int a = 0; a < 2; ++a)
#pragma unroll
        for (int b = 0; b < 2; ++b)
#pragma unroll
            for (int r = 0; r < 16; ++r) acc[a][b][r] = 0.f;
}
DI void st_bf4(bf16_t* d, float a, float b, float c, float e) { u32x2 o; o.x = pk2(a, b); o.y = pk2(c, e); *(u32x2*)d = o; }

DI void tile_mn(int tl, int ntn, int& mi, int& ni) { const int per = 16 * ntn; const int g = tl / per, r = tl - g * per; mi = g * 16 + (r & 15); ni = r >> 4; }

DI void phase1(const Params& p, char* lds) {
    char* ws = p.ws;
    const int t = threadIdx.x, lane = t & 63, w = t >> 6, wm = w >> 1, wn = w & 1, fr = lane & 31, fh = lane >> 5;
    const float* rstd0 = (const float*)(ws + OFF_RSTD0);
    constexpr int NT1 = 256 * 32, NTX = 8 * 8;
    for (int tl = blockIdx.x; tl < NT1 + NTX; tl += gridDim.x) {
        f32x16 acc[2][2]; zero_acc(acc);
        if (tl < NT1) {
            int mi, ni; tile_mn(tl, 32, mi, ni);
            const int m0 = mi * 128, n0 = ni * 128;
            gemm_main((const bf16_t*)(ws + OFF_XB), DM, (const bf16_t*)(ws + OFF_WIN), DM, DM, m0, n0, acc, lds);
#pragma unroll
            for (int mt = 0; mt < 2; ++mt) {
                const int tok = m0 + wm * 64 + mt * 32 + fr;
                const float rs = rstd0[tok];
                float ssq = 0.f;
#pragma unroll
                for (int nt = 0; nt < 2; ++nt) {
                    const int cb = n0 + wn * 64 + nt * 32 + fh * 4;
                    if (n0 < 384) {
                        bf16_t* d = (n0 < 256) ? (bf16_t*)(ws + OFF_CQ) + (size_t)tok * 256 + cb : (bf16_t*)(ws + OFF_CKV) + (size_t)tok * 128 + (cb - 256);
#pragma unroll
                        for (int rg = 0; rg < 4; ++rg) { const float a = acc[nt][mt][rg * 4] * rs, b = acc[nt][mt][rg * 4 + 1] * rs, c = acc[nt][mt][rg * 4 + 2] * rs, e = acc[nt][mt][rg * 4 + 3] * rs;
                            ssq += a * a + b * b + c * c + e * e; st_bf4(d + rg * 8, a, b, c, e); }
                    } else if (n0 == 384) {
                        if (wn == 0 && nt == 0) {
                            const f32x2* cs = (const f32x2*)(ws + OFF_CS) + (size_t)tok * 16;
                            bf16_t* d = (bf16_t*)(ws + OFF_KA) + (size_t)tok * 768 + 64;
#pragma unroll
                            for (int rg = 0; rg < 2; ++rg) {
                                float lo[4], hi[4];
#pragma unroll
                                for (int j = 0; j < 4; ++j) { const f32x2 c = cs[rg * 8 + fh * 4 + j]; const float x1 = acc[nt][mt][rg * 4 + j] * rs, x2 = acc[nt][mt][8 + rg * 4 + j] * rs;
                                    lo[j] = x1 * c.x - x2 * c.y; hi[j] = x2 * c.x + x1 * c.y; }
#pragma unroll
                                for (int h = 0; h < 8; ++h) { st_bf4(d + h * 96 + rg * 8 + fh * 4, lo[0], lo[1], lo[2], lo[3]); st_bf4(d + h * 96 + 16 + rg * 8 + fh * 4, hi[0], hi[1], hi[2], hi[3]); }
                            }
                        }
                    } else if (n0 < 1536) {
                        bf16_t* d = (n0 < 1024) ? (bf16_t*)(ws + OFF_SBQ) + (size_t)tok * 512 + (cb - 512) : (bf16_t*)(ws + OFF_SBK) + (size_t)tok * 512 + (cb - 1024);
#pragma unroll
                        for (int rg = 0; rg < 4; ++rg) st_bf4(d + rg * 8, acc[nt][mt][rg * 4] * rs, acc[nt][mt][rg * 4 + 1] * rs, acc[nt][mt][rg * 4 + 2] * rs, acc[nt][mt][rg * 4 + 3] * rs);
                    } else if (n0 < 2048) {
                        const int b = tok >> 13, s = tok & 8191;
                        bf16_t* d = (bf16_t*)(ws + OFF_VTB) + ((size_t)b * 512 + (cb - 1536)) * SEQ + s;
#pragma unroll
                        for (int r = 0; r < 16; ++r) d[(size_t)((r >> 2) * 8 + (r & 3)) * SEQ] = bf1(acc[nt][mt][r] * rs);
                    } else {
                        const int gi = n0 >= 3072;
                        const int c0 = cb - (gi ? 3072 : 2048);
                        bf16_t* d = (bf16_t*)(ws + (gi ? OFF_SIGB : OFF_SIGA)) + (size_t)tok * DM + c0;
                        const float* bg = p.b_gate + gi * DM + c0;
#pragma unroll
                        for (int rg = 0; rg < 4; ++rg) { const f32x4 bb = *(const f32x4*)(bg + rg * 8); float o[4];
#pragma unroll
                            for (int j = 0; j < 4; ++j) { const float z = acc[nt][mt][rg * 4 + j] * rs + bb[j]; o[j] = __builtin_amdgcn_rcpf(1.f + ex2(-z * LOG2E)); }
                            st_bf4(d + rg * 8, o[0], o[1], o[2], o[3]); }
                    }
                }
                if (n0 < 384) { ssq += shx32(ssq); if (fh == 0) atomicAdd((float*)(ws + (n0 < 256 ? OFF_SSQ_Q : OFF_SSQ_KV)) + tok, ssq); }
            }
        } else {
            const int u = tl - NT1; const int m0 = (u & 7) * 128, n0 = (u >> 3) * 128;
            gemm_main((const bf16_t*)(ws + OFF_MNB), DM, (const bf16_t*)(ws + OFF_WXKV), DM, DM, m0, n0, acc, lds);
#pragma unroll
            for (int mt = 0; mt < 2; ++mt) {
                const int tok = m0 + wm * 64 + mt * 32 + fr;
#pragma unroll
                for (int nt = 0; nt < 2; ++nt) {
                    const int cb = n0 + wn * 64 + nt * 32 + fh * 4;
                    if (n0 < 512) { bf16_t* d = (bf16_t*)(ws + OFF_XK) + (size_t)tok * 512 + cb;
#pragma unroll
                        for (int rg = 0; rg < 4; ++rg) st_bf4(d + rg * 8, acc[nt][mt][rg * 4], acc[nt][mt][rg * 4 + 1], acc[nt][mt][rg * 4 + 2], acc[nt][mt][rg * 4 + 3]);
                    } else { const int b = tok >> 8, m = tok & 255;
                        bf16_t* d = (bf16_t*)(ws + OFF_XVT) + ((size_t)b * 512 + (cb - 512)) * MEML + m;
#pragma unroll
                        for (int r = 0; r < 16; ++r) d[(size_t)((r >> 2) * 8 + (r & 3)) * MEML] = bf1(acc[nt][mt][r]);
                    }
                }
            }
        }
    }
}

DI void phase2(const Params& p, char* lds) {
    char* ws = p.ws;
    const int t = threadIdx.x, lane = t & 63, w = t >> 6, wm = w >> 1, wn = w & 1, fr = lane & 31, fh = lane >> 5;
    constexpr int NTQ = 256 * 6, NTKV = 256 * 8;
    for (int tl = blockIdx.x; tl < NTQ + NTKV; tl += gridDim.x) {
        f32x16 acc[2][2]; zero_acc(acc);
        if (tl < NTQ) {
            const int mi = tl / 6, ni = tl - mi * 6; const int m0 = mi * 128, n0 = ni * 128;
            gemm_main((const bf16_t*)(ws + OFF_CQ), 256, (const bf16_t*)(ws + OFF_WUQ), 256, 256, m0, n0, acc, lds);
#pragma unroll
            for (int mt = 0; mt < 2; ++mt) {
                const int tok = m0 + wm * 64 + mt * 32 + fr;
                const float rs = rsqrtf(((const float*)(ws + OFF_SSQ_Q))[tok] * (1.0f / 256.0f) + EPS);
                const f32x2* cs = (const f32x2*)(ws + OFF_CS) + (size_t)tok * 16;
#pragma unroll
                for (int nt = 0; nt < 2; ++nt) {
                    const int c32 = n0 + wn * 64 + nt * 32;
                    bf16_t* d = (bf16_t*)(ws + OFF_QA) + (size_t)tok * 768 + c32 + fh * 4;
                    if (((c32 >> 5) % 3) == 2) {
#pragma unroll
                        for (int rg = 0; rg < 2; ++rg) { float lo[4], hi[4];
#pragma unroll
                            for (int j = 0; j < 4; ++j) { const f32x2 c = cs[rg * 8 + fh * 4 + j]; const float x1 = acc[nt][mt][rg * 4 + j] * rs, x2 = acc[nt][mt][8 + rg * 4 + j] * rs;
                                lo[j] = x1 * c.x - x2 * c.y; hi[j] = x2 * c.x + x1 * c.y; }
                            st_bf4(d + rg * 8, lo[0], lo[1], lo[2], lo[3]); st_bf4(d + 16 + rg * 8, hi[0], hi[1], hi[2], hi[3]); }
                    } else {
#pragma unroll
                        for (int rg = 0; rg < 4; ++rg) st_bf4(d + rg * 8, acc[nt][mt][rg * 4] * rs, acc[nt][mt][rg * 4 + 1] * rs, acc[nt][mt][rg * 4 + 2] * rs, acc[nt][mt][rg * 4 + 3] * rs);
                    }
                }
            }
        } else {
            const int u = tl - NTQ; const int mi = u >> 3, h = u & 7; const int m0 = mi * 128, n0 = h * 128;
            gemm_main((const bf16_t*)(ws + OFF_CKV), 128, (const bf16_t*)(ws + OFF_WUKV), 128, 128, m0, n0, acc, lds);
#pragma unroll
            for (int mt = 0; mt < 2; ++mt) {
                const int tok = m0 + wm * 64 + mt * 32 + fr;
                const float rs = rsqrtf(((const float*)(ws + OFF_SSQ_KV))[tok] * (1.0f / 128.0f) + EPS);
#pragma unroll
                for (int nt = 0; nt < 2; ++nt) {
                    if (wn == 0) {
                        bf16_t* d = (bf16_t*)(ws + OFF_KA) + (size_t)tok * 768 + h * 96 + nt * 32 + fh * 4;
#pragma unroll
                        for (int rg = 0; rg < 4; ++rg) st_bf4(d + rg * 8, acc[nt][mt][rg * 4] * rs, acc[nt][mt][rg * 4 + 1] * rs, acc[nt][mt][rg * 4 + 2] * rs, acc[nt][mt][rg * 4 + 3] * rs);
                    } else {
                        const int b = tok >> 13, s = tok & 8191;
                        bf16_t* d = (bf16_t*)(ws + OFF_VTA) + ((size_t)(b * 8 + h) * 64 + nt * 32 + fh * 4) * SEQ + s;
#pragma unroll
                        for (int r = 0; r < 16; ++r) d[(size_t)((r >> 2) * 8 + (r & 3)) * SEQ] = bf1(acc[nt][mt][r] * rs);
                    }
                }
            }
        }
    }
}

template <int DQK> DI int ksw(int row, int c) { return DQK == 64 ? (c ^ ((row >> 1) & 7)) : DQK == 96 ? (c ^ ((row >> 2) & 3)) : (c ^ (row & 15)); }

template <int DQK, int DV, int MODE>
DI void attn_block(const bf16_t* __restrict__ Q, int ldq, const bf16_t* __restrict__ Kp, int ldk, const bf16_t* __restrict__ Vt, int ldv,
                   bf16_t* __restrict__ O, int ldo, int q0, int ntiles, char* lds) {
    constexpr int NCK = DQK / 8, KB = 64 * DQK * 2, VB = DV * 128, STG = KB + VB, NKL = NCK / 4, NVL = DV / 32, NKK = DQK / 16, NDT = DV / 32;
    const int t = threadIdx.x, lane = t & 63, w = t >> 6, fr = lane & 31, fh = lane >> 5;
    const int qrow = q0 + w * 32 + fr;
    const int qlo = q0 + w * 32, qhi = qlo + 31;
    unsigned* flags = (unsigned*)(lds + 2 * STG);
    bf16x8 qf[NKK];
#pragma unroll
    for (int kk = 0; kk < NKK; ++kk) qf[kk] = *(const bf16x8*)(Q + (size_t)qrow * ldq + kk * 16 + fh * 8);
    f32x16 o[NDT];
#pragma unroll
    for (int d = 0; d < NDT; ++d)
#pragma unroll
        for (int r = 0; r < 16; ++r) o[d][r] = 0.f;
    float m_run = -1e30f, l_run = 0.f;
    u32x4 rk[NKL], rv[NVL];
    auto gload = [&](int kt) {
        const int key0 = kt * 64;
#pragma unroll
        for (int i = 0; i < NKL; ++i) { const int id = t + 256 * i; const int row = id / NCK, c = id - row * NCK; rk[i] = *(const u32x4*)(Kp + (size_t)(key0 + row) * ldk + c * 8); }
#pragma unroll
        for (int i = 0; i < NVL; ++i) { const int id = t + 256 * i; const int row = id >> 3, c = id & 7; rv[i] = *(const u32x4*)(Vt + (size_t)row * ldv + key0 + c * 8); }
    };
    auto sstore = [&](char* buf) {
#pragma unroll
        for (int i = 0; i < NKL; ++i) { const int id = t + 256 * i; const int row = id / NCK, c = id - row * NCK; *(u32x4*)(buf + row * (DQK * 2) + (ksw<DQK>(row, c) << 4)) = rk[i]; }
#pragma unroll
        for (int i = 0; i < NVL; ++i) { const int id = t + 256 * i; const int row = id >> 3, c = id & 7; const int g2 = (c >> 1) * 2, a = c & 1, sw = (row >> 1) & 7;
            char* rb_ = buf + KB + row * 128 + a * 8;
            u32x2 lo2, hi2; lo2.x = rv[i].x; lo2.y = rv[i].y; hi2.x = rv[i].z; hi2.y = rv[i].w;
            *(u32x2*)(rb_ + ((g2 ^ sw) << 4)) = lo2; *(u32x2*)(rb_ + (((g2 + 1) ^ sw) << 4)) = hi2; }
    };
    auto tile_of = [&](int it) { return MODE == 1 ? (ntiles - 1 - it) : it; };
    gload(tile_of(0)); sstore(lds); __syncthreads();
    for (int it = 0; it < ntiles; ++it) {
        const int kt = tile_of(it), key0 = kt * 64;
        const char* buf = lds + (it & 1) * STG;
        const bool more = it + 1 < ntiles;
        if (more && MODE != 2) gload(tile_of(it + 1));
        bool active;
        if (MODE == 0) active = key0 <= qhi; else if (MODE == 1) active = key0 < qhi; else active = true;
        if (active) {
            f32x16 s[2];
#pragma unroll
            for (int mt = 0; mt < 2; ++mt)
#pragma unroll
                for (int r = 0; r < 16; ++r) s[mt][r] = 0.f;
#pragma unroll
            for (int kk = 0; kk < NKK; ++kk)
#pragma unroll
                for (int mt = 0; mt < 2; ++mt) { const int row = mt * 32 + fr; const bf16x8 kf = *(const bf16x8*)(buf + row * (DQK * 2) + (ksw<DQK>(row, kk * 2 + fh) << 4)); s[mt] = MFMA(kf, qf[kk], s[mt]); }
            bf16x8 pf[4];
            if (MODE != 1) {
                if (MODE == 0 && key0 + 63 > qlo) {
#pragma unroll
                    for (int mt = 0; mt < 2; ++mt)
#pragma unroll
                        for (int r = 0; r < 16; ++r) { const int key = key0 + mt * 32 + (r >> 2) * 8 + fh * 4 + (r & 3); if (key > qrow) s[mt][r] = -1e30f; }
                }
                float mx = s[0][0];
#pragma unroll
                for (int mt = 0; mt < 2; ++mt)
#pragma unroll
                    for (int r = 0; r < 16; ++r) mx = fmaxf(mx, s[mt][r]);
                mx = fmaxf(mx, shx32(mx));
                const float mnew = fmaxf(m_run, mx); const float alpha = ex2(m_run - mnew); m_run = mnew;
                float sum = 0.f;
#pragma unroll
                for (int mt = 0; mt < 2; ++mt)
#pragma unroll
                    for (int r = 0; r < 16; ++r) { const float pv = ex2(s[mt][r] - mnew); s[mt][r] = pv; sum += pv; }
                l_run = l_run * alpha + sum;
#pragma unroll
                for (int d = 0; d < NDT; ++d)
#pragma unroll
                    for (int r = 0; r < 16; ++r) o[d][r] *= alpha;
            } else {
                const bool diag = key0 + 63 >= qlo;
                float G[8];
#pragma unroll
                for (int mt = 0; mt < 2; ++mt)
#pragma unroll
                    for (int rg = 0; rg < 4; ++rg) {
                        float g = 0.f;
#pragma unroll
                        for (int j = 3; j >= 0; --j) { const int r = rg * 4 + j; const float z = s[mt][r];
                            const float wv = lg2(1.f + ex2(-fabsf(z)));
                            float nlom = fmaxf(z, 0.f) + wv; float nl = nlom - z;
                            if (diag) { const int key = key0 + mt * 32 + rg * 8 + fh * 4 + j; if (key >= qrow) { nlom = 0.f; nl = 1e30f; } }
                            s[mt][r] = nl + g; g += nlom; }
                        G[mt * 4 + rg] = g;
                    }
                float base[8]; float run = l_run;
#pragma unroll
                for (int oc = 7; oc >= 0; --oc) { const float gp = shx32(G[oc]); base[oc] = run + (fh == 0 ? gp : 0.f); run += G[oc] + gp; }
                l_run = run;
#pragma unroll
                for (int mt = 0; mt < 2; ++mt)
#pragma unroll
                    for (int r = 0; r < 16; ++r) s[mt][r] = ex2(-(s[mt][r] + base[mt * 4 + (r >> 2)]));
            }
#pragma unroll
            for (int s4 = 0; s4 < 4; ++s4) { u32x4 pk; const int mt = s4 >> 1, rb = (s4 & 1) * 8;
                pk.x = pk2(s[mt][rb], s[mt][rb + 1]); pk.y = pk2(s[mt][rb + 2], s[mt][rb + 3]); pk.z = pk2(s[mt][rb + 4], s[mt][rb + 5]); pk.w = pk2(s[mt][rb + 6], s[mt][rb + 7]);
                pf[s4] = __builtin_bit_cast(bf16x8, pk); }
#pragma unroll
            for (int s4 = 0; s4 < 4; ++s4)
#pragma unroll
                for (int d = 0; d < NDT; ++d) { const int row = d * 32 + fr; const bf16x8 vf = *(const bf16x8*)(buf + KB + row * 128 + (((s4 * 2 + fh) ^ ((row >> 1) & 7)) << 4)); o[d] = MFMA(vf, pf[s4], o[d]); }
        }
        if (more) { if (MODE == 2) gload(tile_of(it + 1)); sstore(lds + ((it + 1) & 1) * STG); }
        if (MODE == 1) {
            const bool fin = __all(l_run > 152.f) != 0;
            if (lane == 0) flags[(it & 1) * 4 + w] = fin ? 1u : 0u;
            __syncthreads();
            const unsigned* f = flags + (it & 1) * 4;
            if ((f[0] & f[1] & f[2] & f[3]) != 0u) break;
        } else {
            __syncthreads();
        }
    }
    float inv = 1.f;
    if (MODE != 1) { const float lt = l_run + shx32(l_run); inv = 1.f / lt; }
#pragma unroll
    for (int d = 0; d < NDT; ++d)
#pragma unroll
        for (int rg = 0; rg < 4; ++rg) st_bf4(O + (size_t)qrow * ldo + d * 32 + rg * 8 + fh * 4, o[d][rg * 4] * inv, o[d][rg * 4 + 1] * inv, o[d][rg * 4 + 2] * inv, o[d][rg * 4 + 3] * inv);
}

DI void phase3(const Params& p, char* lds) {
    char* ws = p.ws;
    constexpr int NMLA = 32 * 32, NSB = 32 * 64;
    for (int u = blockIdx.x; u < NMLA + NSB; u += gridDim.x) {
        if (u < NMLA) {
            const int xcd = u & 7, v = u >> 3; const int pr = v & 31, bh = (v >> 5) * 8 + xcd; const int b = bh >> 3, h = bh & 7;
            const bf16_t* Q = (const bf16_t*)(ws + OFF_QA) + (size_t)b * SEQ * 768 + h * 96;
            const bf16_t* Kp = (const bf16_t*)(ws + OFF_KA) + (size_t)b * SEQ * 768 + h * 96;
            const bf16_t* Vt = (const bf16_t*)(ws + OFF_VTA) + (size_t)(b * 8 + h) * 64 * SEQ;
            bf16_t* O = (bf16_t*)(ws + OFF_OA) + (size_t)b * SEQ * 512 + h * 64;
#pragma unroll 1
            for (int half = 0; half < 2; ++half) { const int qb = half ? pr : 63 - pr;
                attn_block<96, 64, 0>(Q, 768, Kp, 768, Vt, SEQ, O, 512, qb * 128, 2 * qb + 2, lds); }
        } else {
            const int v = u - NMLA; const int qb = v & 63, bh = v >> 6; const int b = bh >> 3, h = bh & 7;
            const bf16_t* Q = (const bf16_t*)(ws + OFF_SBQ) + (size_t)b * SEQ * 512 + h * 64;
            const bf16_t* Kp = (const bf16_t*)(ws + OFF_SBK) + (size_t)b * SEQ * 512 + h * 64;
            const bf16_t* Vt = (const bf16_t*)(ws + OFF_VTB) + (size_t)(b * 8 + h) * 64 * SEQ;
            bf16_t* O = (bf16_t*)(ws + OFF_OB) + (size_t)b * SEQ * 512 + h * 64;
            attn_block<64, 64, 1>(Q, 512, Kp, 512, Vt, SEQ, O, 512, qb * 128, 2 * qb + 2, lds);
        }
    }
}

DI void phase4(const Params& p, char* lds) {
    char* ws = p.ws;
    const int t = threadIdx.x, lane = t & 63, w = t >> 6, wm = w >> 1, wn = w & 1, fr = lane & 31, fh = lane >> 5;
    for (int tl = blockIdx.x; tl < 256 * 8; tl += gridDim.x) {
        int mi, ni; tile_mn(tl, 8, mi, ni); const int m0 = mi * 128, n0 = ni * 128;
        f32x16 acc[2][2], acc2[2][2]; zero_acc(acc); zero_acc(acc2);
        gemm_main((const bf16_t*)(ws + OFF_OA), 512, (const bf16_t*)(ws + OFF_WA), 512, 512, m0, n0, acc, lds);
        gemm_main((const bf16_t*)(ws + OFF_OB), 512, (const bf16_t*)(ws + OFF_WB), 512, 512, m0, n0, acc2, lds);
#pragma unroll
        for (int mt = 0; mt < 2; ++mt) {
            const int tok = m0 + wm * 64 + mt * 32 + fr;
#pragma unroll
            for (int nt = 0; nt < 2; ++nt) {
                const size_t off = (size_t)tok * DM + n0 + wn * 64 + nt * 32 + fh * 4;
#pragma unroll
                for (int rg = 0; rg < 4; ++rg) {
                    const u32x2 sa = *(const u32x2*)((const bf16_t*)(ws + OFF_SIGA) + off + rg * 8), sb = *(const u32x2*)((const bf16_t*)(ws + OFF_SIGB) + off + rg * 8);
                    const float a0 = __uint_as_float(sa.x << 16), a1 = __uint_as_float(sa.x & 0xffff0000u), a2 = __uint_as_float(sa.y << 16), a3 = __uint_as_float(sa.y & 0xffff0000u);
                    const float b0 = __uint_as_float(sb.x << 16), b1 = __uint_as_float(sb.x & 0xffff0000u), b2 = __uint_as_float(sb.y << 16), b3 = __uint_as_float(sb.y & 0xffff0000u);
                    st_bf4((bf16_t*)(ws + OFF_MERGED) + off + rg * 8, a0 * acc[nt][mt][rg * 4] + b0 * acc2[nt][mt][rg * 4], a1 * acc[nt][mt][rg * 4 + 1] + b1 * acc2[nt][mt][rg * 4 + 1],
                           a2 * acc[nt][mt][rg * 4 + 2] + b2 * acc2[nt][mt][rg * 4 + 2], a3 * acc[nt][mt][rg * 4 + 3] + b3 * acc2[nt][mt][rg * 4 + 3]);
                }
            }
        }
    }
}

DI void phase_res(const bf16_t* A, int K, const bf16_t* Bt, const float* res, float* out, bf16_t* outb, float* ssqp, char* lds) {
    const int t = threadIdx.x, lane = t & 63, w = t >> 6, wm = w >> 1, wn = w & 1, fr = lane & 31, fh = lane >> 5;
    for (int tl = blockIdx.x; tl < 256 * 8; tl += gridDim.x) {
        int mi, ni; tile_mn(tl, 8, mi, ni); const int m0 = mi * 128, n0 = ni * 128;
        f32x16 acc[2][2]; zero_acc(acc);
        gemm_main(A, K, Bt, K, K, m0, n0, acc, lds);
#pragma unroll
        for (int mt = 0; mt < 2; ++mt) {
            const int tok = m0 + wm * 64 + mt * 32 + fr; float ssq = 0.f;
#pragma unroll
            for (int nt = 0; nt < 2; ++nt) {
                const size_t off = (size_t)tok * DM + n0 + wn * 64 + nt * 32 + fh * 4;
#pragma unroll
                for (int rg = 0; rg < 4; ++rg) {
                    f32x4 r = *(const f32x4*)(res + off + rg * 8);
                    r[0] += acc[nt][mt][rg * 4]; r[1] += acc[nt][mt][rg * 4 + 1]; r[2] += acc[nt][mt][rg * 4 + 2]; r[3] += acc[nt][mt][rg * 4 + 3];
                    ssq += r[0] * r[0] + r[1] * r[1] + r[2] * r[2] + r[3] * r[3];
                    *(f32x4*)(out + off + rg * 8) = r;
                    if (outb) st_bf4(outb + off + rg * 8, r[0], r[1], r[2], r[3]);
                }
            }
            ssq += shx32(ssq); if (fh == 0) atomicAdd(ssqp + tok, ssq);
        }
    }
}

DI void phase6(const Params& p, char* lds) {
    char* ws = p.ws;
    const int t = threadIdx.x, lane = t & 63, w = t >> 6, wm = w >> 1, wn = w & 1, fr = lane & 31, fh = lane >> 5;
    for (int tl = blockIdx.x; tl < 256 * 4; tl += gridDim.x) {
        int mi, ni; tile_mn(tl, 4, mi, ni); const int m0 = mi * 128, n0 = ni * 128;
        f32x16 acc[2][2]; zero_acc(acc);
        gemm_main((const bf16_t*)(ws + OFF_X1B), DM, (const bf16_t*)(ws + OFF_WXQ), DM, DM, m0, n0, acc, lds);
#pragma unroll
        for (int mt = 0; mt < 2; ++mt) {
            const int tok = m0 + wm * 64 + mt * 32 + fr;
            const float rs = rsqrtf(((const float*)(ws + OFF_SSQ1))[tok] * (1.0f / DM) + EPS);
#pragma unroll
            for (int nt = 0; nt < 2; ++nt) { bf16_t* d = (bf16_t*)(ws + OFF_XQ) + (size_t)tok * 512 + n0 + wn * 64 + nt * 32 + fh * 4;
#pragma unroll
                for (int rg = 0; rg < 4; ++rg) st_bf4(d + rg * 8, acc[nt][mt][rg * 4] * rs, acc[nt][mt][rg * 4 + 1] * rs, acc[nt][mt][rg * 4 + 2] * rs, acc[nt][mt][rg * 4 + 3] * rs); }
        }
    }
}

DI void phase7(const Params& p, char* lds) {
    char* ws = p.ws;
    for (int u = blockIdx.x; u < 4 * 4 * 64; u += gridDim.x) {
        const int qb = u & 63, bh = u >> 6; const int b = bh >> 2, h = bh & 3;
        const bf16_t* Q = (const bf16_t*)(ws + OFF_XQ) + (size_t)b * SEQ * 512 + h * 128;
        const bf16_t* Kp = (const bf16_t*)(ws + OFF_XK) + (size_t)b * MEML * 512 + h * 128;
        const bf16_t* Vt = (const bf16_t*)(ws + OFF_XVT) + (size_t)(b * 4 + h) * 128 * MEML;
        bf16_t* O = (bf16_t*)(ws + OFF_XO) + (size_t)b * SEQ * 512 + h * 128;
        attn_block<128, 128, 2>(Q, 512, Kp, 512, Vt, MEML, O, 512, qb * 128, 4, lds);
    }
}

DI void phase9(const Params& p, char* lds) {
    char* ws = p.ws;
    const int t = threadIdx.x, lane = t & 63, w = t >> 6, wm = w >> 1, wn = w & 1, fr = lane & 31, fh = lane >> 5;
    for (int tl = blockIdx.x; tl < 256 * 44; tl += gridDim.x) {
        int mi, ni; tile_mn(tl, 44, mi, ni); const int m0 = mi * 128, n0 = ni * 128;
        f32x16 acc[2][2]; zero_acc(acc);
        gemm_main((const bf16_t*)(ws + OFF_X2B), DM, (const bf16_t*)(ws + OFF_WGU), DM, DM, m0, n0, acc, lds);
#pragma unroll
        for (int mt = 0; mt < 2; ++mt) {
            const int tok = m0 + wm * 64 + mt * 32 + fr;
            const float rs = rsqrtf(((const float*)(ws + OFF_SSQ2))[tok] * (1.0f / DM) + EPS);
            bf16_t* d = (bf16_t*)(ws + OFF_HID) + (size_t)tok * DFF + ni * 64 + wn * 32 + fh * 4;
#pragma unroll
            for (int rg = 0; rg < 4; ++rg) { float o4[4];
#pragma unroll
                for (int j = 0; j < 4; ++j) { const float g = acc[0][mt][rg * 4 + j] * rs, uu = acc[1][mt][rg * 4 + j] * rs; o4[j] = g * __builtin_amdgcn_rcpf(1.f + ex2(-g * LOG2E)) * uu; }
                st_bf4(d + rg * 8, o4[0], o4[1], o4[2], o4[3]); }
        }
    }
}

DI void phase11(const Params& p) {
    const float* ssq3 = (const float*)(p.ws + OFF_SSQ3);
    for (size_t i = (size_t)blockIdx.x * 256 + threadIdx.x; i < (size_t)T * DM / 4; i += (size_t)gridDim.x * 256) {
        const int tok = (int)(i >> 8), c = (int)(i & 255) * 4;
        const float rs = rsqrtf(ssq3[tok] * (1.0f / DM) + EPS);
        f32x4 v = *(f32x4*)(p.out + i * 4); const f32x4 g = *(const f32x4*)(p.g_final + c);
        v[0] *= rs * g[0]; v[1] *= rs * g[1]; v[2] *= rs * g[2]; v[3] *= rs * g[3];
        *(f32x4*)(p.out + i * 4) = v;
    }
}


#define XB_TMO      128
#define XB_XCNT(j)  (256  + 64 * (j))
#define XB_XSUB(j)  (1280 + 64 * (j))
#define XB_XGEN(j)  (2304 + 64 * (j))
#define XB_TOP      3328
#define XB_TOPGEN   3392
#define XCD_BAR_WORDS 3456
#define XB_SPIN_CAP (1u << 22)
#define LAS __attribute__((address_space(3)))
DI unsigned xb_ld(unsigned* p) { return __hip_atomic_load(p, __ATOMIC_RELAXED, __HIP_MEMORY_SCOPE_AGENT); }
DI unsigned xb_add(unsigned* p, unsigned v) { return __hip_atomic_fetch_add(p, v, __ATOMIC_RELAXED, __HIP_MEMORY_SCOPE_AGENT); }
DI unsigned xb_xcc_id() { return (unsigned)__builtin_amdgcn_s_getreg((3 << 11) | 20) & 0xFu; }
#define XB_SPIN(cond, bar) do { unsigned _sp = 0; while (cond) { __builtin_amdgcn_s_sleep(1); \
    if ((++_sp & 255u) == 0u) { if (xb_ld(&(bar)[XB_TMO])) break; if (_sp > XB_SPIN_CAP) { atomicAdd(&(bar)[XB_TMO], 1u); break; } } } } while (0)
struct XcdBarrier { unsigned* bar; unsigned x; volatile LAS unsigned* st; };
DI XcdBarrier xcd_barrier_post(unsigned* bar, volatile LAS unsigned* st) {
    XcdBarrier b; b.bar = bar; b.x = xb_xcc_id(); b.st = st;
    if (threadIdx.x == 0) (void)xb_add(&bar[XB_XCNT(b.x)], 1u);
    return b;
}
DI void xcd_barrier_complete(unsigned* bar, unsigned x, unsigned& nloc, unsigned& nx) {
    const unsigned G = gridDim.x * gridDim.y * gridDim.z;
    unsigned sum, cnt, mine, sp = 0u;
    for (;;) {
        sum = 0u; cnt = 0u; mine = 0u;
#pragma unroll
        for (unsigned j = 0; j < 16; ++j) { const unsigned c = xb_ld(&bar[XB_XCNT(j)]); sum += c; cnt += (c > 0u) ? 1u : 0u; mine = (j == x) ? c : mine; }
        if (sum == G) break;
        __builtin_amdgcn_s_sleep(1);
        if ((++sp & 255u) == 0u) { if (xb_ld(&bar[XB_TMO])) break; if (sp > XB_SPIN_CAP) { atomicAdd(&bar[XB_TMO], 1u); break; } }
    }
    nloc = mine > 0u ? mine : 1u; nx = cnt > 0u ? cnt : 1u;
}
DI void xcd_barrier(const XcdBarrier& b) {
    asm volatile("s_waitcnt vmcnt(0)" ::: "memory");
    __syncthreads();
    if (threadIdx.x == 0) {
        unsigned* bar = b.bar;
        __builtin_amdgcn_s_waitcnt(0);
        unsigned nloc = b.st[0], nx = b.st[1];
        if (nloc == 0u) { xcd_barrier_complete(bar, b.x, nloc, nx); b.st[0] = nloc; b.st[1] = nx; }
        const unsigned old = xb_add(&bar[XB_XSUB(b.x)], 1u);
        const unsigned gen = old / nloc;
        if (old + 1u == (gen + 1u) * nloc) {
            __builtin_amdgcn_fence(__ATOMIC_RELEASE, "agent");
            asm volatile("s_waitcnt vmcnt(0)" ::: "memory");
            const unsigned og = xb_add(&bar[XB_TOP], 1u);
            const unsigned tg = og / nx;
            if (og + 1u == (tg + 1u) * nx) xb_add(&bar[XB_TOPGEN], 1u);
            else XB_SPIN(xb_ld(&bar[XB_TOPGEN]) == tg, bar);
            __builtin_amdgcn_fence(__ATOMIC_ACQUIRE, "agent");
            xb_add(&bar[XB_XGEN(b.x)], 1u);
            asm volatile("s_waitcnt vmcnt(0)" ::: "memory");
        } else {
            XB_SPIN(xb_ld(&bar[XB_XGEN(b.x)]) == gen, bar);
            __builtin_amdgcn_fence(__ATOMIC_ACQUIRE, "agent");
            asm volatile("s_waitcnt vmcnt(0)" ::: "memory");
        }
    }
    __syncthreads();
}

constexpr int NPHASE = 12;
__global__ void __launch_bounds__(256, 2) mega(Params p, int ph_lo, int ph_hi, int coop) {
    __shared__ __attribute__((aligned(16))) char lds[65536 + 64];
    __shared__ uint4 xb_words;
    char* ws = p.ws;
    if (threadIdx.x == 0) xb_words = make_uint4(0u, 0u, 0u, 0u);
    __syncthreads();
    XcdBarrier xb; xb.bar = (unsigned*)(ws + OFF_BAR); xb.x = 0; xb.st = (volatile LAS unsigned*)&xb_words;
    if (coop) xb = xcd_barrier_post((unsigned*)(ws + OFF_BAR), (volatile LAS unsigned*)&xb_words);
    if (coop == 2) cg::this_grid().sync();
#define PH(n, call) if (ph_lo <= n && n < ph_hi) { call; } if (coop && n + 1 < NPHASE) xcd_barrier(xb);
    PH(0, phase0(p, (float*)lds))
    PH(1, phase1(p, lds))
    PH(2, phase2(p, lds))
    PH(3, phase3(p, lds))
    PH(4, phase4(p, lds))
    PH(5, phase_res((const bf16_t*)(ws + OFF_MERGED), DM, (const bf16_t*)(ws + OFF_WO), p.x, p.out, (bf16_t*)(ws + OFF_X1B), (float*)(ws + OFF_SSQ1), lds))
    PH(6, phase6(p, lds))
    PH(7, phase7(p, lds))
    PH(8, phase_res((const bf16_t*)(ws + OFF_XO), 512, (const bf16_t*)(ws + OFF_WXO), p.out, p.out, (bf16_t*)(ws + OFF_X2B), (float*)(ws + OFF_SSQ2), lds))
    PH(9, phase9(p, lds))
    PH(10, phase_res((const bf16_t*)(ws + OFF_HID), DFF, (const bf16_t*)(ws + OFF_WD), p.out, p.out, nullptr, (float*)(ws + OFF_SSQ3), lds))
    PH(11, phase11(p))
}

extern "C" void kernel_launch(void* const* d_in, const int* in_sizes, int n_in, void* d_out, int out_size, void* d_ws, size_t ws_size, hipStream_t stream) {
    static int grid_blocks = 0;
    if (!grid_blocks) {
        int dev = 0, cus = 0, per_cu = 0;
        hipGetDevice(&dev);
        hipDeviceGetAttribute(&cus, hipDeviceAttributeMultiprocessorCount, dev);
        hipOccupancyMaxActiveBlocksPerMultiprocessor(&per_cu, mega, 256, 0);
        if (per_cu > 2) per_cu = 2;
        if (per_cu < 1) per_cu = 1;
        grid_blocks = cus * per_cu;
    }
    Params p{};
    p.x = (const float*)d_in[0]; p.mem = (const float*)d_in[1]; p.pos = (const int*)d_in[2];
    p.g_mix = (const float*)d_in[3]; p.w_in = (const float*)d_in[4]; p.b_gate = (const float*)d_in[5]; p.g_q_lat = (const float*)d_in[6]; p.w_uq = (const float*)d_in[7];
    p.g_kv_lat = (const float*)d_in[8]; p.w_ukv = (const float*)d_in[9]; p.w_a = (const float*)d_in[10]; p.w_b = (const float*)d_in[11]; p.w_o = (const float*)d_in[12];
    p.g_x = (const float*)d_in[13]; p.g_mem = (const float*)d_in[14]; p.w_xq = (const float*)d_in[15]; p.w_xkv = (const float*)d_in[16]; p.w_xo = (const float*)d_in[17];
    p.g_ffn = (const float*)d_in[18]; p.w_gate = (const float*)d_in[19]; p.w_up = (const float*)d_in[20]; p.w_down = (const float*)d_in[21]; p.g_final = (const float*)d_in[22];
    p.out = (float*)d_out; p.ws = (char*)d_ws;
#if ONE_LAUNCH
    int lo = 0, hi = NPHASE, coop = 1;
    hipMemsetAsync((char*)d_ws + OFF_BAR, 0, XCD_BAR_WORDS * sizeof(unsigned), stream);
    void* args[] = {&p, &lo, &hi, &coop};
    hipError_t e = hipLaunchCooperativeKernel((void*)mega, dim3(grid_blocks), dim3(256), args, 0, stream);
    if (e != hipSuccess) fprintf(stderr, "cooperative launch failed: %s (grid %d)\n", hipGetErrorString(e), grid_blocks);
#else
    for (int ph = 0; ph < NPHASE; ++ph) mega<<<dim3(grid_blocks), dim3(256), 0, stream>>>(p, ph, ph + 1, 0);
#endif
}
```

```cpp
#include <hip/hip_runtime.h>
#include <hip/hip_cooperative_groups.h>
#include <cstdio>
#include <cstdint>
namespace cg = cooperative_groups;

#ifndef ONE_LAUNCH
#define ONE_LAUNCH 1
#endif

namespace pg8 {
#define PG8_LAS __attribute__((address_space(3)))
typedef unsigned short bf16_t;
typedef short bf16x8 __attribute__((ext_vector_type(8)));
typedef float f32x4 __attribute__((ext_vector_type(4)));
typedef unsigned u32x4 __attribute__((ext_vector_type(4)));
constexpr int BM = 256, BK = 64, HALF = 128, HTB = HALF * BK * 2  , STAGE_BYTES = 8 * HTB, NXCD = 8, WGM = 8;

__host__ __device__ __forceinline__ int lds_byte(int r, int c) { const int st = (r >> 4) * 2 + (c >> 5), rr = r & 15, cc = c & 31, ob = rr * 64 + cc * 2; return st * 1024 + (ob ^ (((ob >> 9) & 1) << 5)); }
__host__ __device__ __forceinline__ void stage_rc(int b, int& R, int& C) { const int st = b / 1024, sb = b % 1024, swz = sb ^ (((sb >> 9) & 1) << 5); R = (st >> 1) * 16 + swz / 64; C = (st & 1) * 32 + (swz % 64) / 2; }
__host__ __device__ __forceinline__ int perm32(int rho) { const int n = rho >> 4, i = rho & 15; return 8 * (i >> 2) + 4 * n + (i & 3); }

struct Unit { int pm, pn; };
struct Gemm { const bf16_t* A; const bf16_t* Bt; int M, N, K; };

struct StaticOrder {
    int nM, nN, nwg, G, c;
    __host__ __device__ void init(int M, int N, int G_, int c_) { nM = M / BM; nN = N / BM; nwg = nM * nN; G = G_; c = c_; }
    __host__ __device__ bool next(int i, Unit& u) const {
        const long L = (long)i * G + c; if (L >= nwg) return false;
        int wgid = (int)L; { const int q = nwg / NXCD, r = nwg % NXCD, xcd = wgid % NXCD, off = wgid / NXCD; wgid = (xcd < r ? xcd * (q + 1) : r * (q + 1) + (xcd - r) * q) + off; }
        const int nig = WGM * nN, gid = wgid / nig, fm = gid * WGM, gsz = (nM - fm) < WGM ? (nM - fm) : WGM;
        u.pm = fm + ((wgid % nig) % gsz); u.pn = (wgid % nig) / gsz; return true;
    }
    __device__ __forceinline__ void a_ready(const Unit&) const {}
    __device__ __forceinline__ void done(const Unit&) const {}
};


template <class Epi, class Sched, bool ALIGN_EPI = false, bool SP2 = false>
__device__ __forceinline__ void gemm_phase(PG8_LAS unsigned char* lds, const Gemm g, const Sched& S, const Epi& E, const int tid_in) {
    int tid_ = tid_in; asm volatile("" : "+v"(tid_));
    const int tid = tid_, wid = __builtin_amdgcn_readfirstlane(tid >> 6), lane = tid & 63, wr = wid >> 2, wc = wid & 3, fr = lane & 15, fq = lane >> 4;
    const int K = g.K, nt = K / BK;
    unsigned voffA[2], voffB[2];
#pragma unroll
    for (int i = 0; i < 2; ++i) { int R, C; stage_rc(tid * 16 + i * 8192, R, C); const int Rb = Epi::PERM ? ((R & ~31) + perm32(R & 31)) : R;
        voffA[i] = (unsigned)(R * K + C) * 2u; voffB[i] = (unsigned)(Rb * K + C) * 2u; }
    const size_t kstep = (size_t)(BK * 2);
    const size_t hstep = (size_t)HALF * K * 2;
    const size_t tstep = 2 * hstep;
    const unsigned ldsw = (unsigned)wid * 1024u;
    const int aoff = lds_byte(wr * 64 + fr, fq * 8), boff = lds_byte(wc * 32 + fr, fq * 8);
#define PG8_SA(b, h) (((b) * 2 + (h)) * HTB)
#define PG8_SB(b, h) ((4 + (b) * 2 + (h)) * HTB)
#define PG8_STAGE(bufoff, gbase, voff) do { _Pragma("unroll") for (int _i = 0; _i < 2; ++_i) \
        __builtin_amdgcn_global_load_lds((const unsigned*)((const char*)(gbase) + (voff)[_i]), (PG8_LAS unsigned*)(lds + (bufoff) + ldsw + _i * 8192), 16, 0, 0); } while (0)
#define PG8_LDA(dst, b, h) do { _Pragma("unroll") for (int m = 0; m < 4; ++m) _Pragma("unroll") for (int k = 0; k < 2; ++k) dst[m][k] = *(const PG8_LAS bf16x8*)(lds + PG8_SA(b, h) + aoff + m * 2048 + k * 1024); } while (0)
#define PG8_LDB(dst, b, h) do { _Pragma("unroll") for (int n = 0; n < 2; ++n) _Pragma("unroll") for (int k = 0; k < 2; ++k) dst[n][k] = *(const PG8_LAS bf16x8*)(lds + PG8_SB(b, h) + boff + n * 2048 + k * 1024); } while (0)
#define PG8_MMA(ai, bj, At, Bt) do { __builtin_amdgcn_s_setprio(1); _Pragma("unroll") for (int m = 0; m < 4; ++m) _Pragma("unroll") for (int n = 0; n < 2; ++n) _Pragma("unroll") for (int k = 0; k < 2; ++k) \
        acc[ai][bj][m][n] = __builtin_amdgcn_mfma_f32_16x16x32_bf16(Bt[n][k], At[m][k], acc[ai][bj][m][n], 0, 0, 0); __builtin_amdgcn_s_setprio(0); } while (0)
#define PG8_WAIT_V(n) asm volatile("s_waitcnt vmcnt(" #n ")" ::: "memory")
#define PG8_WAIT_L(n) asm volatile("s_waitcnt lgkmcnt(" #n ")" ::: "memory")
#define PG8_BAR __builtin_amdgcn_s_barrier()
#define PG8_SCHED __builtin_amdgcn_sched_barrier(0)
    Unit cur, nxt; int ui = 0;
    if (!S.next(0, cur)) return;
    f32x4 acc[2][2][4][2];
#pragma unroll
    for (int a = 0; a < 2; ++a)
#pragma unroll
        for (int b = 0; b < 2; ++b)
#pragma unroll
            for (int m = 0; m < 4; ++m)
#pragma unroll
                for (int n = 0; n < 2; ++n) acc[a][b][m][n] = (f32x4){0.f, 0.f, 0.f, 0.f};
    bf16x8 At[4][2], B0[2][2], B1[2][2];
    const char* cA = (const char*)g.A + (size_t)cur.pm * tstep; const char* cB = (const char*)g.Bt + (size_t)cur.pn * tstep;
    S.a_ready(cur);
    if constexpr (SP2) {
        PG8_STAGE(PG8_SB(0, 0), cB, voffB); PG8_STAGE(PG8_SB(0, 1), cB + hstep, voffB); PG8_STAGE(PG8_SA(0, 0), cA, voffA); PG8_STAGE(PG8_SA(0, 1), cA + hstep, voffA);
        if (wr == 1) PG8_BAR;
        PG8_WAIT_V(2); PG8_BAR;
        PG8_STAGE(PG8_SB(1, 0), cB + kstep, voffB); PG8_STAGE(PG8_SA(1, 0), cA + kstep, voffA); PG8_STAGE(PG8_SB(1, 1), cB + hstep + kstep, voffB);
        PG8_WAIT_V(6); PG8_BAR;
    } else {
        PG8_STAGE(PG8_SB(0, 0), cB, voffB); PG8_STAGE(PG8_SA(0, 0), cA, voffA); PG8_STAGE(PG8_SB(0, 1), cB + hstep, voffB); PG8_STAGE(PG8_SA(0, 1), cA + hstep, voffA);
        if (wr == 1) PG8_BAR;
        PG8_WAIT_V(4); PG8_BAR;
        PG8_STAGE(PG8_SB(1, 0), cB + kstep, voffB); PG8_STAGE(PG8_SA(1, 0), cA + kstep, voffA); PG8_STAGE(PG8_SB(1, 1), cB + hstep + kstep, voffB);
        PG8_WAIT_V(6); PG8_BAR;
    }
    for (;;) {
        const bool has_next = S.next(ui + 1, nxt);
        const char* nA = has_next ? (const char*)g.A + (size_t)nxt.pm * tstep : cA; const char* nB = has_next ? (const char*)g.Bt + (size_t)nxt.pn * tstep : cB;
        for (int t = 0; t < nt; t += 2) {
            const bool last = (t == nt - 2);
            const char* a1 = cA + (size_t)(t + 1) * kstep;
            const char* a2 = last ? nA : cA + (size_t)(t + 2) * kstep; const char* b2 = last ? nB : cB + (size_t)(t + 2) * kstep;
            const char* a3 = a2 + kstep; const char* b3 = b2 + kstep;
            if (last && has_next) S.a_ready(nxt);
            if constexpr (SP2) {
            PG8_LDB(B0, 0, 0); PG8_LDB(B1, 0, 1); PG8_SCHED; PG8_LDA(At, 0, 0); PG8_STAGE(PG8_SA(1, 1), a1 + hstep, voffA);
            PG8_WAIT_V(8); PG8_WAIT_L(0); PG8_BAR; PG8_MMA(0, 0, At, B0); PG8_MMA(0, 1, At, B1); PG8_BAR; PG8_SCHED;
            PG8_LDA(At, 0, 1); PG8_STAGE(PG8_SB(0, 0), b2, voffB); PG8_STAGE(PG8_SB(0, 1), b2 + hstep, voffB); PG8_STAGE(PG8_SA(0, 0), a2, voffA);
            PG8_WAIT_V(8); PG8_WAIT_L(0); PG8_BAR; PG8_MMA(1, 0, At, B0); PG8_MMA(1, 1, At, B1); PG8_BAR; PG8_SCHED;
            PG8_LDB(B0, 1, 0); PG8_LDB(B1, 1, 1); PG8_SCHED; PG8_LDA(At, 1, 0); PG8_STAGE(PG8_SA(0, 1), a2 + hstep, voffA);
            PG8_WAIT_V(8); PG8_WAIT_L(0); PG8_BAR; PG8_MMA(0, 0, At, B0); PG8_MMA(0, 1, At, B1); PG8_BAR; PG8_SCHED;
            PG8_LDA(At, 1, 1); PG8_STAGE(PG8_SB(1, 0), b3, voffB); PG8_STAGE(PG8_SB(1, 1), b3 + hstep, voffB); PG8_STAGE(PG8_SA(1, 0), a3, voffA);
            PG8_WAIT_V(8); PG8_WAIT_L(0); PG8_BAR; PG8_MMA(1, 0, At, B0); PG8_MMA(1, 1, At, B1); PG8_BAR; PG8_SCHED;
            } else {
            PG8_LDB(B0, 0, 0); PG8_SCHED; PG8_LDA(At, 0, 0); PG8_STAGE(PG8_SA(1, 1), a1 + hstep, voffA);
            PG8_WAIT_L(8); PG8_BAR; PG8_WAIT_L(0); PG8_MMA(0, 0, At, B0); PG8_BAR; PG8_SCHED;
            PG8_LDB(B1, 0, 1); PG8_STAGE(PG8_SB(0, 0), b2, voffB);
            PG8_BAR; PG8_WAIT_L(0); PG8_MMA(0, 1, At, B1); PG8_BAR;
            PG8_LDA(At, 0, 1); PG8_STAGE(PG8_SA(0, 0), a2, voffA);
            PG8_BAR; PG8_WAIT_L(0); PG8_MMA(1, 0, At, B0); PG8_BAR; PG8_SCHED;
            PG8_STAGE(PG8_SB(0, 1), b2 + hstep, voffB);
            PG8_WAIT_V(6); PG8_BAR; PG8_MMA(1, 1, At, B1); PG8_BAR;
            PG8_LDB(B0, 1, 0); PG8_SCHED; PG8_LDA(At, 1, 0); PG8_STAGE(PG8_SA(0, 1), a2 + hstep, voffA);
            PG8_WAIT_L(8); PG8_BAR; PG8_WAIT_L(0); PG8_MMA(0, 0, At, B0); PG8_BAR; PG8_SCHED;
            PG8_LDB(B1, 1, 1); PG8_STAGE(PG8_SB(1, 0), b3, voffB);
            PG8_BAR; PG8_WAIT_L(0); PG8_MMA(0, 1, At, B1); PG8_BAR;
            PG8_LDA(At, 1, 1); PG8_STAGE(PG8_SA(1, 0), a3, voffA);
            PG8_BAR; PG8_WAIT_L(0); PG8_MMA(1, 0, At, B0); PG8_BAR; PG8_SCHED;
            PG8_STAGE(PG8_SB(1, 1), b3 + hstep, voffB);
            PG8_WAIT_V(6); PG8_BAR; PG8_MMA(1, 1, At, B1); PG8_BAR;
            }
        }
        if constexpr (ALIGN_EPI) { if (wr == 0) PG8_BAR; }
        if constexpr (!Epi::AFTER_DRAIN) { E(acc, cur, wr, wc, fr, fq); S.done(cur); }
        if (!has_next) break;
#pragma unroll
        for (int a = 0; a < 2; ++a)
#pragma unroll
            for (int b = 0; b < 2; ++b)
#pragma unroll
                for (int m = 0; m < 4; ++m)
#pragma unroll
                    for (int n = 0; n < 2; ++n) acc[a][b][m][n] = (f32x4){0.f, 0.f, 0.f, 0.f};
        cur = nxt; cA = nA; cB = nB; ++ui;
        if constexpr (ALIGN_EPI) { if (wr == 1) PG8_BAR; }
    }
    PG8_WAIT_V(0);
    if constexpr (!ALIGN_EPI) { if (wr == 0) PG8_BAR; }
    PG8_BAR;
    if constexpr (Epi::AFTER_DRAIN) { E.fused(acc, cur, wr, wc, fr, fq, lds, wid, lane); S.done(cur); }
#undef PG8_SA
#undef PG8_SB
#undef PG8_STAGE
#undef PG8_LDA
#undef PG8_LDB
#undef PG8_MMA
#undef PG8_WAIT_V
#undef PG8_WAIT_L
#undef PG8_BAR
#undef PG8_SCHED
}
}


typedef unsigned short bf16_t;
typedef short bf16x8 __attribute__((ext_vector_type(8)));
typedef float f32x16 __attribute__((ext_vector_type(16)));
typedef float f32x4 __attribute__((ext_vector_type(4)));
typedef float f32x2 __attribute__((ext_vector_type(2)));
typedef unsigned u32x4 __attribute__((ext_vector_type(4)));
typedef unsigned u32x2 __attribute__((ext_vector_type(2)));
typedef __bf16 bf16x2_t __attribute__((ext_vector_type(2)));
#define DI __device__ __forceinline__
#define LAS __attribute__((address_space(3)))
#define MFMA(a, b, c) __builtin_amdgcn_mfma_f32_32x32x16_bf16((a), (b), (c), 0, 0, 0)
using pg8::Unit;

constexpr int T = 32768, SEQ = 8192, NB = 4, DM = 1024, MEMT = 1024, MEML = 256;
constexpr int DFF = 2816;
constexpr int NTHR = 512, NWV = 8;
constexpr float EPS = 1e-6f;
constexpr float LOG2E = 1.4426950408889634f;
constexpr int LDS_BYTES = 147456;
constexpr int LDS_XB = 131072 + 1024;

constexpr size_t MB = 1024 * 1024;
constexpr size_t OFF_SSQ_Q = 0;
constexpr size_t OFF_SSQ_KV = OFF_SSQ_Q + T * 4;
constexpr size_t OFF_SSQ1 = OFF_SSQ_KV + T * 4;
constexpr size_t OFF_SSQ2 = OFF_SSQ1 + T * 4;
constexpr size_t OFF_SSQ3 = OFF_SSQ2 + T * 4;
constexpr size_t OFF_RSTD0 = OFF_SSQ3 + T * 4;
constexpr size_t OFF_BAR = 832 * 1024;
constexpr size_t OFF_CS = 1 * MB;
constexpr size_t OFF_WIN = 5 * MB;
constexpr size_t OFF_WV = OFF_WIN + 7 * MB;
constexpr size_t OFF_WUQ = OFF_WV + 1 * MB;
constexpr size_t OFF_WUK = OFF_WUQ + 768 * 256 * 2;
constexpr size_t OFF_WUV = OFF_WUK + 512 * 256 * 2;
constexpr size_t OFF_WA = OFF_WUV + 512 * 256 * 2;
constexpr size_t OFF_WB = OFF_WA + 1 * MB;
constexpr size_t OFF_WO = OFF_WB + 1 * MB;
constexpr size_t OFF_WXQ = OFF_WO + 2 * MB;
constexpr size_t OFF_WXKV = OFF_WXQ + 1 * MB;
constexpr size_t OFF_WXO = OFF_WXKV + 2 * MB;
constexpr size_t OFF_WGU = OFF_WXO + 1 * MB;
constexpr size_t OFF_WD = OFF_WGU + 11 * MB;
constexpr size_t OFF_MNB = OFF_WD + 6 * MB;
constexpr size_t OFF_XK = OFF_MNB + 2 * MB;
constexpr size_t OFF_XVT = OFF_XK + 1 * MB;
constexpr size_t OFF_ACT = 48 * MB;
static_assert(OFF_XVT + 1 * MB <= OFF_ACT, "ws map");
constexpr size_t OFF_XB = OFF_ACT;
constexpr size_t OFF_OA = OFF_XB;
constexpr size_t OFF_OB = OFF_XB + 32 * MB;
constexpr size_t OFF_CQ = OFF_XB + 64 * MB;
constexpr size_t OFF_CKV = OFF_CQ + 16 * MB;
constexpr size_t OFF_KA = OFF_CKV + 16 * MB;
constexpr size_t OFF_QA = OFF_KA + 48 * MB;
constexpr size_t OFF_VTA = OFF_QA + 48 * MB;
constexpr size_t OFF_SBQ = OFF_VTA + 32 * MB;
constexpr size_t OFF_SBK = OFF_SBQ + 32 * MB;
constexpr size_t OFF_VTB = OFF_SBK + 32 * MB;
constexpr size_t OFF_SIGA = OFF_VTB + 32 * MB;
constexpr size_t OFF_SIGB = OFF_SIGA + 64 * MB;
constexpr size_t WS_END = OFF_SIGB + 64 * MB;
static_assert(WS_END <= 512 * MB, "ws map");
constexpr size_t OFF_MERGED = OFF_KA;
constexpr size_t OFF_X1B = OFF_VTA;
constexpr size_t OFF_XQ = OFF_SBK;
constexpr size_t OFF_XO = OFF_VTB;
constexpr size_t OFF_X2B = OFF_SIGA;
constexpr size_t OFF_HID = OFF_KA;

struct Params {
    const float* x; const float* mem; const int* pos;
    const float* g_mix; const float* w_in; const float* b_gate; const float* g_q_lat; const float* w_uq;
    const float* g_kv_lat; const float* w_ukv; const float* w_a; const float* w_b; const float* w_o;
    const float* g_x; const float* g_mem; const float* w_xq; const float* w_xkv; const float* w_xo;
    const float* g_ffn; const float* w_gate; const float* w_up; const float* w_down; const float* g_final;
    float* out; char* ws;
};

DI unsigned pk2(float a, float b) { f32x2 v = {a, b}; bf16x2_t r = __builtin_convertvector(v, bf16x2_t); return __builtin_bit_cast(unsigned, r); }
DI bf16_t bf1(float a) { return (bf16_t)(pk2(a, 0.f) & 0xffffu); }
DI float ex2(float x) { return __builtin_amdgcn_exp2f(x); }
DI float lg2(float x) { return __builtin_amdgcn_logf(x); }
DI float shx32(float v) { return __shfl_xor(v, 32); }
DI int lane_id_fresh() { int l; asm volatile("v_mbcnt_lo_u32_b32 %0, -1, 0\n\tv_mbcnt_hi_u32_b32 %0, -1, %0" : "=v"(l)); return l; }
DI float bflo(unsigned u) { return __uint_as_float(u << 16); }
DI float bfhi(unsigned u) { return __uint_as_float(u & 0xffff0000u); }
DI void st_bf4(bf16_t* d, float a, float b, float c, float e) { u32x2 o; o.x = pk2(a, b); o.y = pk2(c, e); *(u32x2*)d = o; }
DI void st_bf8(bf16_t* d, const f32x4& a, const f32x4& b) { u32x4 o; o.x = pk2(a[0], a[1]); o.y = pk2(a[2], a[3]); o.z = pk2(b[0], b[1]); o.w = pk2(b[2], b[3]); *(u32x4*)d = o; }

DI void wt_tile(bool valid, int t, const float* __restrict__ src, int N, int sc, int k0, bf16_t* __restrict__ dst, int K, int drow0, const float* __restrict__ g, float scale, float* lds) {
    if (valid) {
        const int nn = t & 31, kb = t >> 5;
#pragma unroll
        for (int i = 0; i < 8; ++i) {
            const int kk = kb + 8 * i;
            float v = 0.f;
            if (sc >= 0) { v = src[(size_t)(k0 + kk) * N + sc + nn] * scale; if (g) v *= g[k0 + kk]; }
            lds[kk * 33 + nn] = v;
        }
    }
    __syncthreads();
    if (valid) {
        const int kk = t & 63, nb = t >> 6;
#pragma unroll
        for (int i = 0; i < 8; ++i) {
            const int nn = nb + 4 * i;
            dst[(size_t)(drow0 + nn) * K + k0 + kk] = bf1(lds[kk * 33 + nn]);
        }
    }
    __syncthreads();
}

constexpr float SBQ_SCALE = LOG2E * 0.125f;
constexpr float MLAQ_SCALE = LOG2E * 0.10206207261596577f;
constexpr float XQ_SCALE = LOG2E * 0.08838834764831845f;

DI void phase0(const Params& p, char* ldsc, const int tid) {
    char* ws = p.ws;
    const int half = tid >> 8, t = tid & 255;
    float* ldsf = (float*)ldsc + half * (64 * 33 + 16);
    constexpr int J0 = 112 * 16;
    constexpr int J1 = J0 + 16 * 16;
    constexpr int J2 = J1 + 24 * 4;
    constexpr int J3 = J2 + 16 * 4;
    constexpr int J4 = J3 + 16 * 4;
    constexpr int J5 = J4 + 32 * 8;
    constexpr int J6 = J5 + 32 * 8;
    constexpr int J7 = J6 + 32 * 16;
    constexpr int J8 = J7 + 16 * 16;
    constexpr int J9 = J8 + 32 * 16;
    constexpr int J10 = J9 + 32 * 8;
    constexpr int J11 = J10 + 176 * 16;
    constexpr int J12 = J11 + 32 * 44;
    for (int tl0 = blockIdx.x * 2; tl0 < J12; tl0 += gridDim.x * 2) {
        const int tl = tl0 + half; const bool valid = tl < J12;
        if (tl < J0) { const int jn = tl >> 4, jk = tl & 15; const int d0 = jn * 32; int sc; float s = 1.f;
            if (d0 < 416) sc = d0; else if (d0 < 512) sc = -1; else if (d0 < 1536) { sc = d0 - 96; if (d0 < 1024) s = SBQ_SCALE; } else sc = d0 + 416;
            wt_tile(valid, t, p.w_in, 4000, sc, jk * 64, (bf16_t*)(ws + OFF_WIN), 1024, d0, p.g_mix, s, ldsf); }
        else if (tl < J1) { const int u = tl - J0; const int jn = u >> 4, jk = u & 15;
            wt_tile(valid, t, p.w_in, 4000, 1440 + jn * 32, jk * 64, (bf16_t*)(ws + OFF_WV), 1024, jn * 32, p.g_mix, 1.f, ldsf); }
        else if (tl < J2) { const int u = tl - J1; const int jn = u >> 2, jk = u & 3;
            wt_tile(valid, t, p.w_uq, 768, jn * 32, jk * 64, (bf16_t*)(ws + OFF_WUQ), 256, jn * 32, p.g_q_lat, MLAQ_SCALE, ldsf); }
        else if (tl < J3) { const int u = tl - J2; const int jn = u >> 2, jk = u & 3; const int d0 = jn * 32;
            wt_tile(valid, t, p.w_ukv, 1024, jk < 2 ? (d0 >> 6) * 128 + (d0 & 63) : -1, jk * 64, (bf16_t*)(ws + OFF_WUK), 256, d0, p.g_kv_lat, 1.f, ldsf); }
        else if (tl < J4) { const int u = tl - J3; const int jn = u >> 2, jk = u & 3; const int d0 = jn * 32;
            wt_tile(valid, t, p.w_ukv, 1024, jk < 2 ? (d0 >> 6) * 128 + 64 + (d0 & 63) : -1, jk * 64, (bf16_t*)(ws + OFF_WUV), 256, d0, p.g_kv_lat, 1.f, ldsf); }
        else if (tl < J5) { const int u = tl - J4; const int jn = u >> 3, jk = u & 7;
            wt_tile(valid, t, p.w_a, 1024, jn * 32, jk * 64, (bf16_t*)(ws + OFF_WA), 512, jn * 32, nullptr, 1.f, ldsf); }
        else if (tl < J6) { const int u = tl - J5; const int jn = u >> 3, jk = u & 7;
            wt_tile(valid, t, p.w_b, 1024, jn * 32, jk * 64, (bf16_t*)(ws + OFF_WB), 512, jn * 32, nullptr, 1.f, ldsf); }
        else if (tl < J7) { const int u = tl - J6; const int jn = u >> 4, jk = u & 15;
            wt_tile(valid, t, p.w_o, 1024, jn * 32, jk * 64, (bf16_t*)(ws + OFF_WO), 1024, jn * 32, nullptr, 1.f, ldsf); }
        else if (tl < J8) { const int u = tl - J7; const int jn = u >> 4, jk = u & 15;
            wt_tile(valid, t, p.w_xq, 512, jn * 32, jk * 64, (bf16_t*)(ws + OFF_WXQ), 1024, jn * 32, p.g_x, XQ_SCALE, ldsf); }
        else if (tl < J9) { const int u = tl - J8; const int jn = u >> 4, jk = u & 15;
            wt_tile(valid, t, p.w_xkv, 1024, jn * 32, jk * 64, (bf16_t*)(ws + OFF_WXKV), 1024, jn * 32, nullptr, 1.f, ldsf); }
        else if (tl < J10) { const int u = tl - J9; const int jn = u >> 3, jk = u & 7;
            wt_tile(valid, t, p.w_xo, 1024, jn * 32, jk * 64, (bf16_t*)(ws + OFF_WXO), 512, jn * 32, nullptr, 1.f, ldsf); }
        else if (tl < J11) { const int u = tl - J10; const int jn = u >> 4, jk = u & 15; const int d0 = jn * 32; const int rem = d0 & 255;
            const float* src = (rem >= 128) ? p.w_up : p.w_gate;
            wt_tile(valid, t, src, DFF, (d0 >> 8) * 128 + (rem & 127), jk * 64, (bf16_t*)(ws + OFF_WGU), 1024, d0, p.g_ffn, 1.f, ldsf); }
        else { const int u = tl - J11; const int jn = u / 44, jk = u % 44;
            wt_tile(valid, t, p.w_down, 1024, jn * 32, jk * 64, (bf16_t*)(ws + OFF_WD), DFF, jn * 32, nullptr, 1.f, ldsf); }
    }
    {
        float* z = (float*)(ws + OFF_SSQ_Q);
        for (int i = blockIdx.x * NTHR + tid; i < 5 * T; i += gridDim.x * NTHR) z[i] = 0.f;
    }
    const int lane = tid & 63, w = tid >> 6;
    for (int row = blockIdx.x * NWV + w; row < T + MEMT; row += gridDim.x * NWV) {
        const bool ismem = row >= T;
        const float* src = ismem ? p.mem + (size_t)(row - T) * DM : p.x + (size_t)row * DM;
        f32x4 v[4]; float ss = 0.f;
#pragma unroll
        for (int i = 0; i < 4; ++i) { v[i] = *(const f32x4*)(src + i * 256 + lane * 4); ss += v[i][0] * v[i][0] + v[i][1] * v[i][1] + v[i][2] * v[i][2] + v[i][3] * v[i][3]; }
#pragma unroll
        for (int o = 32; o >= 1; o >>= 1) ss += __shfl_xor(ss, o);
        const float rstd = rsqrtf(ss * (1.0f / DM) + EPS);
        if (!ismem) {
            bf16_t* d = (bf16_t*)(ws + OFF_XB) + (size_t)row * DM;
#pragma unroll
            for (int i = 0; i < 4; ++i) st_bf4(d + i * 256 + lane * 4, v[i][0], v[i][1], v[i][2], v[i][3]);
            if (lane == 0) ((float*)(ws + OFF_RSTD0))[row] = rstd;
            if (lane < 16) {
                const float invf = exp2f(-(float)(2 * lane) * (13.287712379549449f / 32.0f));
                const float ang = (float)p.pos[row] * invf;
                const double a = (double)ang; const double kq = rint(a * 0.15915494309189535); const float r = (float)(a - kq * 6.283185307179586);
                f32x2 cs; cs.x = __cosf(r); cs.y = __sinf(r);
                ((f32x2*)(ws + OFF_CS))[(size_t)row * 16 + lane] = cs;
            }
        } else {
            bf16_t* d = (bf16_t*)(ws + OFF_MNB) + (size_t)(row - T) * DM;
#pragma unroll
            for (int i = 0; i < 4; ++i) { const f32x4 g = *(const f32x4*)(p.g_mem + i * 256 + lane * 4);
                st_bf4(d + i * 256 + lane * 4, v[i][0] * rstd * g[0], v[i][1] * rstd * g[1], v[i][2] * rstd * g[2], v[i][3] * rstd * g[3]); }
        }
    }
}

typedef f32x4 Acc[2][2][4][2];
DI float sq4(const f32x4& v) { return v[0] * v[0] + v[1] * v[1] + v[2] * v[2] + v[3] * v[3]; }
DI float red_fq(float s) { s += __shfl_xor(s, 16); s += __shfl_xor(s, 32); return s; }
DI float sigm(float z) { return __builtin_amdgcn_rcpf(1.f + ex2(-z * LOG2E)); }

struct Epi1 {
    static constexpr bool PERM = false, AFTER_DRAIN = false;
    char* ws; const float* b_gate;
    DI void operator()(const Acc& acc, const Unit& u, int wr, int wc, int fr, int fq) const {
        const int pn = u.pn;
        const float* rstd0 = (const float*)(ws + OFF_RSTD0);
#pragma unroll
        for (int ai = 0; ai < 2; ++ai)
#pragma unroll
            for (int m = 0; m < 4; ++m) {
                const int tok = u.pm * 256 + ai * 128 + wr * 64 + m * 16 + fr;
                const float rs = rstd0[tok];
                if (pn <= 1) {
                    bf16_t* d = (bf16_t*)(ws + (pn == 0 ? OFF_CQ : OFF_CKV)) + (size_t)tok * 256 + wc * 32 + fq * 4;
                    float ssq = 0.f;
#pragma unroll
                    for (int bj = 0; bj < 2; ++bj)
#pragma unroll
                        for (int n = 0; n < 2; ++n) { const f32x4 v = acc[ai][bj][m][n] * rs; if (pn == 0 || bj == 0) ssq += sq4(v); st_bf4(d + bj * 128 + n * 16, v[0], v[1], v[2], v[3]); }
                    ssq = red_fq(ssq);
                    if (fq == 0) atomicAdd((float*)(ws + (pn == 0 ? OFF_SSQ_Q : OFF_SSQ_KV)) + tok, ssq);
                    if (pn == 1 && wc == 0) {
                        const f32x4 c01 = *(const f32x4*)(ws + OFF_CS + ((size_t)tok * 16 + fq * 4) * 8), c23 = *(const f32x4*)(ws + OFF_CS + ((size_t)tok * 16 + fq * 4 + 2) * 8);
                        const f32x4 x1 = acc[ai][1][m][0] * rs, x2 = acc[ai][1][m][1] * rs;
                        const float cs_[4] = {c01[0], c01[2], c23[0], c23[2]}, sn_[4] = {c01[1], c01[3], c23[1], c23[3]};
                        float lo[4], hi[4];
#pragma unroll
                        for (int j = 0; j < 4; ++j) { lo[j] = x1[j] * cs_[j] - x2[j] * sn_[j]; hi[j] = x2[j] * cs_[j] + x1[j] * sn_[j]; }
                        bf16_t* k = (bf16_t*)(ws + OFF_KA) + (size_t)tok * 768 + 64 + fq * 4;
#pragma unroll
                        for (int h = 0; h < 8; ++h) { st_bf4(k + h * 96, lo[0], lo[1], lo[2], lo[3]); st_bf4(k + h * 96 + 16, hi[0], hi[1], hi[2], hi[3]); }
                    }
                } else if (pn < 6) {
                    bf16_t* d = (bf16_t*)(ws + (pn < 4 ? OFF_SBQ : OFF_SBK)) + (size_t)tok * 512 + ((pn & 1) * 256) + wc * 32 + fq * 4;
#pragma unroll
                    for (int bj = 0; bj < 2; ++bj)
#pragma unroll
                        for (int n = 0; n < 2; ++n) { const f32x4 v = acc[ai][bj][m][n] * rs; st_bf4(d + bj * 128 + n * 16, v[0], v[1], v[2], v[3]); }
                } else {
                    const int gi = pn >= 10; const int c0 = (pn - (gi ? 10 : 6)) * 256 + wc * 32 + fq * 4;
                    bf16_t* d = (bf16_t*)(ws + (gi ? OFF_SIGB : OFF_SIGA)) + (size_t)tok * DM + c0;
                    const float* bg = b_gate + gi * DM + c0;
#pragma unroll
                    for (int bj = 0; bj < 2; ++bj)
#pragma unroll
                        for (int n = 0; n < 2; ++n) { const f32x4 bb = *(const f32x4*)(bg + bj * 128 + n * 16); const f32x4 v = acc[ai][bj][m][n] * rs + bb;
                            st_bf4(d + bj * 128 + n * 16, sigm(v[0]), sigm(v[1]), sigm(v[2]), sigm(v[3])); }
                }
            }
    }
};

template <int SMODE>
struct EpiVt {
    static constexpr bool PERM = true, AFTER_DRAIN = false;
    bf16_t* out; int ldo; const float* sc;
    DI void operator()(const Acc& acc, const Unit& u, int wr, int wc, int fr, int fq) const {
#pragma unroll
        for (int bj = 0; bj < 2; ++bj) {
            const int col = u.pn * 256 + bj * 128 + wc * 32 + fq * 8;
#pragma unroll
            for (int ai = 0; ai < 2; ++ai)
#pragma unroll
                for (int m = 0; m < 4; ++m) { const int row = u.pm * 256 + ai * 128 + wr * 64 + m * 16 + fr;
                    f32x4 a = acc[ai][bj][m][0], b = acc[ai][bj][m][1];
                    if (SMODE >= 1) { f32x4 s0 = *(const f32x4*)(sc + col), s1 = *(const f32x4*)(sc + col + 4);
                        if (SMODE == 2) {
#pragma unroll
                            for (int j = 0; j < 4; ++j) { s0[j] = rsqrtf(s0[j] * (1.0f / 128.0f) + EPS); s1[j] = rsqrtf(s1[j] * (1.0f / 128.0f) + EPS); }
                        }
                        a *= s0; b *= s1; }
                    st_bf8(out + (size_t)row * ldo + col, a, b); }
        }
    }
};

struct Epi2q {
    static constexpr bool PERM = false, AFTER_DRAIN = false;
    char* ws;
    DI void operator()(const Acc& acc, const Unit& u, int wr, int wc, int fr, int fq) const {
#pragma unroll
        for (int ai = 0; ai < 2; ++ai)
#pragma unroll
            for (int m = 0; m < 4; ++m) {
                const int tok = u.pm * 256 + ai * 128 + wr * 64 + m * 16 + fr;
                const float rs = rsqrtf(((const float*)(ws + OFF_SSQ_Q))[tok] * (1.0f / 256.0f) + EPS);
#pragma unroll
                for (int bj = 0; bj < 2; ++bj) {
                    const int cg0 = u.pn * 256 + bj * 128 + wc * 32;
                    bf16_t* d = (bf16_t*)(ws + OFF_QA) + (size_t)tok * 768 + cg0 + fq * 4;
                    const f32x4 x1 = acc[ai][bj][m][0] * rs, x2 = acc[ai][bj][m][1] * rs;
                    if (((cg0 >> 5) % 3) == 2) {
                        const f32x4 c01 = *(const f32x4*)(ws + OFF_CS + ((size_t)tok * 16 + fq * 4) * 8), c23 = *(const f32x4*)(ws + OFF_CS + ((size_t)tok * 16 + fq * 4 + 2) * 8);
                        const float cs_[4] = {c01[0], c01[2], c23[0], c23[2]}, sn_[4] = {c01[1], c01[3], c23[1], c23[3]};
                        float lo[4], hi[4];
#pragma unroll
                        for (int j = 0; j < 4; ++j) { lo[j] = x1[j] * cs_[j] - x2[j] * sn_[j]; hi[j] = x2[j] * cs_[j] + x1[j] * sn_[j]; }
                        st_bf4(d, lo[0], lo[1], lo[2], lo[3]); st_bf4(d + 16, hi[0], hi[1], hi[2], hi[3]);
                    } else { st_bf4(d, x1[0], x1[1], x1[2], x1[3]); st_bf4(d + 16, x2[0], x2[1], x2[2], x2[3]); }
                }
            }
    }
};

template <int RMODE  , bool KA  >
struct EpiBf {
    static constexpr bool PERM = true, AFTER_DRAIN = false;
    bf16_t* out; int ldo; const float* ssq;
    DI void operator()(const Acc& acc, const Unit& u, int wr, int wc, int fr, int fq) const {
#pragma unroll
        for (int ai = 0; ai < 2; ++ai)
#pragma unroll
            for (int m = 0; m < 4; ++m) {
                const int tok = u.pm * 256 + ai * 128 + wr * 64 + m * 16 + fr;
                float rs = 1.f;
                if (RMODE == 1) rs = rsqrtf(ssq[tok] * (1.0f / 1024.0f) + EPS);
                if (RMODE == 2) rs = rsqrtf(ssq[tok] * (1.0f / 128.0f) + EPS);
#pragma unroll
                for (int bj = 0; bj < 2; ++bj) { int col = u.pn * 256 + bj * 128 + wc * 32 + fq * 8; if (KA) col = (col >> 6) * 96 + (col & 63);
                    st_bf8(out + (size_t)tok * ldo + col, acc[ai][bj][m][0] * rs, acc[ai][bj][m][1] * rs); }
            }
    }
};

template <int STEP>
struct Epi4 {
    static constexpr bool PERM = true, AFTER_DRAIN = false;
    const bf16_t* sig; float* ta; bf16_t* merged;
    DI void operator()(const Acc& acc, const Unit& u, int wr, int wc, int fr, int fq) const {
#pragma unroll
        for (int ai = 0; ai < 2; ++ai)
#pragma unroll
            for (int m = 0; m < 4; ++m) {
                const int tok = u.pm * 256 + ai * 128 + wr * 64 + m * 16 + fr;
#pragma unroll
                for (int bj = 0; bj < 2; ++bj) { const size_t off = (size_t)tok * DM + u.pn * 256 + bj * 128 + wc * 32 + fq * 8;
                    const u32x4 sg = *(const u32x4*)(sig + off);
                    f32x4 a = acc[ai][bj][m][0], b = acc[ai][bj][m][1];
                    a[0] *= bflo(sg.x); a[1] *= bfhi(sg.x); a[2] *= bflo(sg.y); a[3] *= bfhi(sg.y); b[0] *= bflo(sg.z); b[1] *= bfhi(sg.z); b[2] *= bflo(sg.w); b[3] *= bfhi(sg.w);
                    if (STEP == 0) { *(f32x4*)(ta + off) = a; *(f32x4*)(ta + off + 4) = b; }
                    else { a += *(const f32x4*)(ta + off); b += *(const f32x4*)(ta + off + 4); st_bf8(merged + off, a, b); } }
            }
    }
};

struct EpiRes {
    static constexpr bool PERM = true, AFTER_DRAIN = false;
    const float* res; float* out; bf16_t* outb; float* ssq;
    DI void operator()(const Acc& acc, const Unit& u, int wr, int wc, int fr, int fq) const {
#pragma unroll
        for (int ai = 0; ai < 2; ++ai)
#pragma unroll
            for (int m = 0; m < 4; ++m) {
                const int tok = u.pm * 256 + ai * 128 + wr * 64 + m * 16 + fr; float s = 0.f;
#pragma unroll
                for (int bj = 0; bj < 2; ++bj) { const size_t off = (size_t)tok * DM + u.pn * 256 + bj * 128 + wc * 32 + fq * 8;
                    const f32x4 a = *(const f32x4*)(res + off) + acc[ai][bj][m][0], b = *(const f32x4*)(res + off + 4) + acc[ai][bj][m][1];
                    s += sq4(a) + sq4(b);
                    *(f32x4*)(out + off) = a; *(f32x4*)(out + off + 4) = b;
                    if (outb) st_bf8(outb + off, a, b); }
                s = red_fq(s);
                if (fq == 0) atomicAdd(ssq + tok, s);
            }
    }
};

struct Epi9 {
    static constexpr bool PERM = true, AFTER_DRAIN = false;
    bf16_t* hid; const float* ssq;
    DI void operator()(const Acc& acc, const Unit& u, int wr, int wc, int fr, int fq) const {
#pragma unroll
        for (int ai = 0; ai < 2; ++ai)
#pragma unroll
            for (int m = 0; m < 4; ++m) {
                const int tok = u.pm * 256 + ai * 128 + wr * 64 + m * 16 + fr;
                const float rs = rsqrtf(ssq[tok] * (1.0f / 1024.0f) + EPS);
                f32x4 o[2];
#pragma unroll
                for (int n = 0; n < 2; ++n)
#pragma unroll
                    for (int j = 0; j < 4; ++j) { const float g = acc[ai][0][m][n][j] * rs, uu = acc[ai][1][m][n][j] * rs; o[n][j] = g * sigm(g) * uu; }
                st_bf8(hid + (size_t)tok * DFF + u.pn * 128 + wc * 32 + fq * 8, o[0], o[1]);
            }
    }
};

template <class Epi>
DI void run_gemm(LAS unsigned char* L, const int tid, const bf16_t* A, const bf16_t* Bt, int M, int N, int K, const Epi& E) {
    pg8::Gemm g{A, Bt, M, N, K}; pg8::StaticOrder S; S.init(M, N, (int)gridDim.x, (int)blockIdx.x);
    pg8::gemm_phase<Epi, pg8::StaticOrder, true, true>(L, g, S, E, tid);
}

template <int DQK> DI int ksw(int row, int c) { return DQK == 64 ? (c ^ ((row >> 1) & 7)) : DQK == 96 ? (c ^ ((row >> 2) & 3)) : (c ^ (row & 15)); }

template <int DQK, int DV, int MODE>
DI void attn_block(const bf16_t* __restrict__ Q, int ldq, const bf16_t* __restrict__ Kp, int ldk, const bf16_t* __restrict__ Vt, int ldv,
                   bf16_t* __restrict__ O, int ldo, int q0, int ntiles, char* lds, const int tid) {
    constexpr int NCK = DQK / 8, KB = 64 * DQK * 2, VB = DV * 128, STG = KB + VB, NKC = 64 * NCK, NKL = (NKC + NTHR - 1) / NTHR, NVL = DV * 8 / NTHR, NKK = DQK / 16, NDT = DV / 32;
    const int t = tid, lane = t & 63, w = t >> 6, fr = lane & 31, fh = lane >> 5;
    const int qrow = q0 + w * 32 + fr;
    const int qlo = q0 + w * 32, qhi = qlo + 31;
    unsigned* flags = (unsigned*)(lds + 2 * STG);
    bf16x8 qf[NKK];
#pragma unroll
    for (int kk = 0; kk < NKK; ++kk) qf[kk] = *(const bf16x8*)(Q + (size_t)qrow * ldq + kk * 16 + fh * 8);
    f32x16 o[NDT];
#pragma unroll
    for (int d = 0; d < NDT; ++d)
#pragma unroll
        for (int r = 0; r < 16; ++r) o[d][r] = 0.f;
    float m_run = -1e30f, l_run = 0.f;
    u32x4 rk[NKL], rv[NVL];
    auto gload = [&](int kt) {
        const int key0 = kt * 64;
#pragma unroll
        for (int i = 0; i < NKL; ++i) { const int id = t + NTHR * i; if (NKC % NTHR == 0 || id < NKC) { const int row = id / NCK, c = id - row * NCK; rk[i] = *(const u32x4*)(Kp + (size_t)(key0 + row) * ldk + c * 8); } }
#pragma unroll
        for (int i = 0; i < NVL; ++i) { const int id = t + NTHR * i; const int row = id >> 3, c = id & 7; rv[i] = *(const u32x4*)(Vt + (size_t)row * ldv + key0 + c * 8); }
    };
    auto sstore = [&](char* buf) {
#pragma unroll
        for (int i = 0; i < NKL; ++i) { const int id = t + NTHR * i; if (NKC % NTHR == 0 || id < NKC) { const int row = id / NCK, c = id - row * NCK; *(u32x4*)(buf + row * (DQK * 2) + (ksw<DQK>(row, c) << 4)) = rk[i]; } }
#pragma unroll
        for (int i = 0; i < NVL; ++i) { const int id = t + NTHR * i; const int row = id >> 3, c = id & 7; const int g2 = (c >> 1) * 2, a = c & 1, sw = (row >> 1) & 7;
            char* rb_ = buf + KB + row * 128 + a * 8;
            u32x2 lo2, hi2; lo2.x = rv[i].x; lo2.y = rv[i].y; hi2.x = rv[i].z; hi2.y = rv[i].w;
            *(u32x2*)(rb_ + ((g2 ^ sw) << 4)) = lo2; *(u32x2*)(rb_ + (((g2 + 1) ^ sw) << 4)) = hi2; }
    };
    auto tile_of = [&](int it) { return MODE == 1 ? (ntiles - 1 - it) : it; };
    gload(tile_of(0)); sstore(lds); __syncthreads();
    for (int it = 0; it < ntiles; ++it) {
        const int kt = tile_of(it), key0 = kt * 64;
        const char* buf = lds + (it & 1) * STG;
        const bool more = it + 1 < ntiles;
        if (more && MODE != 2) gload(tile_of(it + 1));
        bool active;
        if (MODE == 0) active = key0 <= qhi; else if (MODE == 1) active = key0 < qhi; else active = true;
        if (active) {
            f32x16 s[2];
#pragma unroll
            for (int mt = 0; mt < 2; ++mt)
#pragma unroll
                for (int r = 0; r < 16; ++r) s[mt][r] = 0.f;
#pragma unroll
            for (int kk = 0; kk < NKK; ++kk)
#pragma unroll
                for (int mt = 0; mt < 2; ++mt) { const int row = mt * 32 + fr; const bf16x8 kf = *(const bf16x8*)(buf + row * (DQK * 2) + (ksw<DQK>(row, kk * 2 + fh) << 4)); s[mt] = MFMA(kf, qf[kk], s[mt]); }
            bf16x8 pf[4];
            if (MODE != 1) {
                if (MODE == 0 && key0 + 63 > qlo) {
#pragma unroll
                    for (int mt = 0; mt < 2; ++mt)
#pragma unroll
                        for (int r = 0; r < 16; ++r) { const int key = key0 + mt * 32 + (r >> 2) * 8 + fh * 4 + (r & 3); if (key > qrow) s[mt][r] = -1e30f; }
                }
                float mx = s[0][0];
#pragma unroll
                for (int mt = 0; mt < 2; ++mt)
#pragma unroll
                    for (int r = 0; r < 16; ++r) mx = fmaxf(mx, s[mt][r]);
                mx = fmaxf(mx, shx32(mx));
                const float mnew = fmaxf(m_run, mx); const float alpha = ex2(m_run - mnew); m_run = mnew;
                float sum = 0.f;
#pragma unroll
                for (int mt = 0; mt < 2; ++mt)
#pragma unroll
                    for (int r = 0; r < 16; ++r) { const float pv = ex2(s[mt][r] - mnew); s[mt][r] = pv; sum += pv; }
                l_run = l_run * alpha + sum;
#pragma unroll
                for (int d = 0; d < NDT; ++d)
#pragma unroll
                    for (int r = 0; r < 16; ++r) o[d][r] *= alpha;
            } else {
                const bool diag = key0 + 63 >= qlo;
                float G[8];
#pragma unroll
                for (int mt = 0; mt < 2; ++mt)
#pragma unroll
                    for (int rg = 0; rg < 4; ++rg) {
                        float g = 0.f;
#pragma unroll
                        for (int j = 3; j >= 0; --j) { const int r = rg * 4 + j; const float z = s[mt][r];
                            const float wv = lg2(1.f + ex2(-fabsf(z)));
                            float nlom = fmaxf(z, 0.f) + wv; float nl = nlom - z;
                            if (diag) { const int key = key0 + mt * 32 + rg * 8 + fh * 4 + j; if (key >= qrow) { nlom = 0.f; nl = 1e30f; } }
                            s[mt][r] = nl + g; g += nlom; }
                        G[mt * 4 + rg] = g;
                    }
                float base[8]; float run = l_run;
#pragma unroll
                for (int oc = 7; oc >= 0; --oc) { const float gp = shx32(G[oc]); base[oc] = run + (fh == 0 ? gp : 0.f); run += G[oc] + gp; }
                l_run = run;
#pragma unroll
                for (int mt = 0; mt < 2; ++mt)
#pragma unroll
                    for (int r = 0; r < 16; ++r) s[mt][r] = ex2(-(s[mt][r] + base[mt * 4 + (r >> 2)]));
            }
#pragma unroll
            for (int s4 = 0; s4 < 4; ++s4) { u32x4 pk; const int mt = s4 >> 1, rb = (s4 & 1) * 8;
                pk.x = pk2(s[mt][rb], s[mt][rb + 1]); pk.y = pk2(s[mt][rb + 2], s[mt][rb + 3]); pk.z = pk2(s[mt][rb + 4], s[mt][rb + 5]); pk.w = pk2(s[mt][rb + 6], s[mt][rb + 7]);
                pf[s4] = __builtin_bit_cast(bf16x8, pk); }
#pragma unroll
            for (int s4 = 0; s4 < 4; ++s4)
#pragma unroll
                for (int d = 0; d < NDT; ++d) { const int row = d * 32 + fr; const bf16x8 vf = *(const bf16x8*)(buf + KB + row * 128 + (((s4 * 2 + fh) ^ ((row >> 1) & 7)) << 4)); o[d] = MFMA(vf, pf[s4], o[d]); }
        }
        if (more) { if (MODE == 2) gload(tile_of(it + 1)); sstore(lds + ((it + 1) & 1) * STG); }
        if (MODE == 1) {
            const bool fin = __all(l_run > 152.f) != 0;
            if (lane == 0) flags[(it & 1) * NWV + w] = fin ? 1u : 0u;
            __syncthreads();
            const unsigned* f = flags + (it & 1) * NWV;
            if ((f[0] & f[1] & f[2] & f[3] & f[4] & f[5] & f[6] & f[7]) != 0u) break;
        } else {
            __syncthreads();
        }
    }
    float inv = 1.f;
    if (MODE != 1) { const float lt = l_run + shx32(l_run); inv = 1.f / lt; }
#pragma unroll
    for (int d = 0; d < NDT; ++d)
#pragma unroll
        for (int rg = 0; rg < 4; ++rg) st_bf4(O + (size_t)qrow * ldo + d * 32 + rg * 8 + fh * 4, o[d][rg * 4] * inv, o[d][rg * 4 + 1] * inv, o[d][rg * 4 + 2] * inv, o[d][rg * 4 + 3] * inv);
}

DI void phase3(const Params& p, char* lds, const int tid) {
    char* ws = p.ws;
    constexpr int NMLA = 32 * 16, NSB = 32 * 32;
    for (int u = blockIdx.x; u < NMLA + NSB; u += gridDim.x) {
        if (u < NMLA) {
            const int xcd = u & 7, v = u >> 3; const int pr = v & 15, bh = (v >> 4) * 8 + xcd; const int b = bh >> 3, h = bh & 7;
            const bf16_t* Q = (const bf16_t*)(ws + OFF_QA) + (size_t)b * SEQ * 768 + h * 96;
            const bf16_t* Kp = (const bf16_t*)(ws + OFF_KA) + (size_t)b * SEQ * 768 + h * 96;
            const bf16_t* Vt = (const bf16_t*)(ws + OFF_VTA) + (size_t)(h * 64) * T + (size_t)b * SEQ;
            bf16_t* O = (bf16_t*)(ws + OFF_OA) + (size_t)b * SEQ * 512 + h * 64;
#pragma unroll 1
            for (int half = 0; half < 2; ++half) { const int qb = half ? pr : 31 - pr;
                attn_block<96, 64, 0>(Q, 768, Kp, 768, Vt, T, O, 512, qb * 256, 4 * qb + 4, lds, tid); }
        } else {
            const int uu = u - NMLA; const int xcd = uu & 7, v = uu >> 3; const int qb = v & 31, bh = (v >> 5) * 8 + xcd; const int b = bh >> 3, h = bh & 7;
            const bf16_t* Q = (const bf16_t*)(ws + OFF_SBQ) + (size_t)b * SEQ * 512 + h * 64;
            const bf16_t* Kp = (const bf16_t*)(ws + OFF_SBK) + (size_t)b * SEQ * 512 + h * 64;
            const bf16_t* Vt = (const bf16_t*)(ws + OFF_VTB) + (size_t)(h * 64) * T + (size_t)b * SEQ;
            bf16_t* O = (bf16_t*)(ws + OFF_OB) + (size_t)b * SEQ * 512 + h * 64;
            attn_block<64, 64, 1>(Q, 512, Kp, 512, Vt, T, O, 512, qb * 256, 4 * qb + 4, lds, tid);
        }
    }
}

DI void phase7(const Params& p, char* lds, const int tid) {
    char* ws = p.ws;
    for (int u = blockIdx.x; u < 16 * 32; u += gridDim.x) {
        const int xcd = u & 7, v = u >> 3; const int qb = v & 31, bh = (v >> 5) * 8 + xcd; const int b = bh >> 2, h = bh & 3;
        const bf16_t* Q = (const bf16_t*)(ws + OFF_XQ) + (size_t)b * SEQ * 512 + h * 128;
        const bf16_t* Kp = (const bf16_t*)(ws + OFF_XK) + (size_t)b * MEML * 512 + h * 128;
        const bf16_t* Vt = (const bf16_t*)(ws + OFF_XVT) + (size_t)(h * 128) * MEMT + (size_t)b * MEML;
        bf16_t* O = (bf16_t*)(ws + OFF_XO) + (size_t)b * SEQ * 512 + h * 128;
        attn_block<128, 128, 2>(Q, 512, Kp, 512, Vt, MEMT, O, 512, qb * 256, 4, lds, tid);
    }
}

DI void phase11(const Params& p, const int tid) {
    const float* ssq3 = (const float*)(p.ws + OFF_SSQ3);
    for (size_t i = (size_t)blockIdx.x * NTHR + tid; i < (size_t)T * DM / 4; i += (size_t)gridDim.x * NTHR) {
        const int tok = (int)(i >> 8), c = (int)(i & 255) * 4;
        const float rs = rsqrtf(ssq3[tok] * (1.0f / DM) + EPS);
        f32x4 v = *(f32x4*)(p.out + i * 4); const f32x4 g = *(const f32x4*)(p.g_final + c);
        v[0] *= rs * g[0]; v[1] *= rs * g[1]; v[2] *= rs * g[2]; v[3] *= rs * g[3];
        *(f32x4*)(p.out + i * 4) = v;
    }
}

#define XB_TMO      128
#define XB_XCNT(j)  (256  + 64 * (j))
#define XB_XSUB(j)  (1280 + 64 * (j))
#define XB_XGEN(j)  (2304 + 64 * (j))
#define XB_TOP      3328
#define XB_TOPGEN   3392
#define XCD_BAR_WORDS 3456
#define XB_SPIN_CAP (1u << 22)
DI unsigned xb_ld(unsigned* p) { return __hip_atomic_load(p, __ATOMIC_RELAXED, __HIP_MEMORY_SCOPE_AGENT); }
DI unsigned xb_add(unsigned* p, unsigned v) { return __hip_atomic_fetch_add(p, v, __ATOMIC_RELAXED, __HIP_MEMORY_SCOPE_AGENT); }
DI unsigned xb_xcc_id() { return (unsigned)__builtin_amdgcn_s_getreg((3 << 11) | 20) & 0xFu; }
#define XB_SPIN(cond, bar) do { unsigned _sp = 0; while (cond) { __builtin_amdgcn_s_sleep(1); \
    if ((++_sp & 255u) == 0u) { if (xb_ld(&(bar)[XB_TMO])) break; if (_sp > XB_SPIN_CAP) { atomicAdd(&(bar)[XB_TMO], 1u); break; } } } } while (0)
struct XcdBarrier { unsigned* bar; unsigned x; volatile LAS unsigned* st; };
DI XcdBarrier xcd_barrier_post(unsigned* bar, volatile LAS unsigned* st, const int tid) {
    XcdBarrier b; b.bar = bar; b.x = xb_xcc_id(); b.st = st;
    if (tid == 0) (void)xb_add(&bar[XB_XCNT(b.x)], 1u);
    return b;
}
DI void xcd_barrier_complete(unsigned* bar, unsigned x, unsigned& nloc, unsigned& nx) {
    const unsigned G = gridDim.x * gridDim.y * gridDim.z;
    unsigned sum, cnt, mine, sp = 0u;
    for (;;) {
        sum = 0u; cnt = 0u; mine = 0u;
#pragma unroll
        for (unsigned j = 0; j < 16; ++j) { const unsigned c = xb_ld(&bar[XB_XCNT(j)]); sum += c; cnt += (c > 0u) ? 1u : 0u; mine = (j == x) ? c : mine; }
        if (sum == G) break;
        __builtin_amdgcn_s_sleep(1);
        if ((++sp & 255u) == 0u) { if (xb_ld(&bar[XB_TMO])) break; if (sp > XB_SPIN_CAP) { atomicAdd(&bar[XB_TMO], 1u); break; } }
    }
    nloc = mine > 0u ? mine : 1u; nx = cnt > 0u ? cnt : 1u;
}
DI void xcd_barrier(const XcdBarrier& b, const int tid) {
    asm volatile("s_waitcnt vmcnt(0)" ::: "memory");
    __syncthreads();
    if (tid == 0) {
        unsigned* bar = b.bar;
        __builtin_amdgcn_s_waitcnt(0);
        unsigned nloc = b.st[0], nx = b.st[1];
        if (nloc == 0u) { xcd_barrier_complete(bar, b.x, nloc, nx); b.st[0] = nloc; b.st[1] = nx; }
        const unsigned old = xb_add(&bar[XB_XSUB(b.x)], 1u);
        const unsigned gen = old / nloc;
        if (old + 1u == (gen + 1u) * nloc) {
            __builtin_amdgcn_fence(__ATOMIC_RELEASE, "agent");
            asm volatile("s_waitcnt vmcnt(0)" ::: "memory");
            const unsigned og = xb_add(&bar[XB_TOP], 1u);
            const unsigned tg = og / nx;
            if (og + 1u == (tg + 1u) * nx) xb_add(&bar[XB_TOPGEN], 1u);
            else XB_SPIN(xb_ld(&bar[XB_TOPGEN]) == tg, bar);
            __builtin_amdgcn_fence(__ATOMIC_ACQUIRE, "agent");
            xb_add(&bar[XB_XGEN(b.x)], 1u);
            asm volatile("s_waitcnt vmcnt(0)" ::: "memory");
        } else {
            XB_SPIN(xb_ld(&bar[XB_XGEN(b.x)]) == gen, bar);
            __builtin_amdgcn_fence(__ATOMIC_ACQUIRE, "agent");
            asm volatile("s_waitcnt vmcnt(0)" ::: "memory");
        }
    }
    __syncthreads();
}


constexpr int NPHASE = 12;
__global__ void __launch_bounds__(NTHR, 2) mega(Params p, int ph_lo, int ph_hi, int coop) {
    extern __shared__ __attribute__((aligned(16))) unsigned char dlds[];
    LAS unsigned char* L = (LAS unsigned char*)dlds;
    char* lds = (char*)dlds;
    char* ws = p.ws;
    const int swid = __builtin_amdgcn_readfirstlane((int)(threadIdx.x >> 6));
#define MYTID (swid * 64 + lane_id_fresh())
    volatile LAS unsigned* xbw = (volatile LAS unsigned*)(L + LDS_XB);
    if (threadIdx.x < 4) xbw[threadIdx.x] = 0u;
    __syncthreads();
    XcdBarrier xb; xb.bar = (unsigned*)(ws + OFF_BAR); xb.x = 0; xb.st = xbw;
    if (coop) xb = xcd_barrier_post((unsigned*)(ws + OFF_BAR), xbw, MYTID);
    if (coop == 2) cg::this_grid().sync();
#define PH(n, call) if (ph_lo <= n && n < ph_hi) { call; } if (coop && n + 1 < NPHASE) xcd_barrier(xb, MYTID);
    PH(0, phase0(p, lds, MYTID))
    PH(1, { run_gemm(L, MYTID, (const bf16_t*)(ws + OFF_XB), (const bf16_t*)(ws + OFF_WIN), T, 3584, DM, Epi1{ws, p.b_gate});
            run_gemm(L, MYTID, (const bf16_t*)(ws + OFF_WV), (const bf16_t*)(ws + OFF_XB), 512, T, DM, EpiVt<1>{(bf16_t*)(ws + OFF_VTB), T, (const float*)(ws + OFF_RSTD0)});
            run_gemm(L, MYTID, (const bf16_t*)(ws + OFF_MNB), (const bf16_t*)(ws + OFF_WXKV), MEMT, 512, DM, EpiBf<0, false>{(bf16_t*)(ws + OFF_XK), 512, nullptr});
            run_gemm(L, MYTID, (const bf16_t*)(ws + OFF_WXKV) + (size_t)512 * DM, (const bf16_t*)(ws + OFF_MNB), 512, MEMT, DM, EpiVt<0>{(bf16_t*)(ws + OFF_XVT), MEMT, nullptr}); })
    PH(2, { run_gemm(L, MYTID, (const bf16_t*)(ws + OFF_CQ), (const bf16_t*)(ws + OFF_WUQ), T, 768, 256, Epi2q{ws});
            run_gemm(L, MYTID, (const bf16_t*)(ws + OFF_CKV), (const bf16_t*)(ws + OFF_WUK), T, 512, 256, EpiBf<2, true>{(bf16_t*)(ws + OFF_KA), 768, (const float*)(ws + OFF_SSQ_KV)});
            run_gemm(L, MYTID, (const bf16_t*)(ws + OFF_WUV), (const bf16_t*)(ws + OFF_CKV), 512, T, 256, EpiVt<2>{(bf16_t*)(ws + OFF_VTA), T, (const float*)(ws + OFF_SSQ_KV)}); })
    PH(3, phase3(p, lds, MYTID))
    PH(4, { run_gemm(L, MYTID, (const bf16_t*)(ws + OFF_OA), (const bf16_t*)(ws + OFF_WA), T, DM, 512, Epi4<0>{(const bf16_t*)(ws + OFF_SIGA), p.out, nullptr});
            run_gemm(L, MYTID, (const bf16_t*)(ws + OFF_OB), (const bf16_t*)(ws + OFF_WB), T, DM, 512, Epi4<1>{(const bf16_t*)(ws + OFF_SIGB), p.out, (bf16_t*)(ws + OFF_MERGED)}); })
    PH(5, run_gemm(L, MYTID, (const bf16_t*)(ws + OFF_MERGED), (const bf16_t*)(ws + OFF_WO), T, DM, DM, EpiRes{p.x, p.out, (bf16_t*)(ws + OFF_X1B), (float*)(ws + OFF_SSQ1)}))
    PH(6, run_gemm(L, MYTID, (const bf16_t*)(ws + OFF_X1B), (const bf16_t*)(ws + OFF_WXQ), T, 512, DM, EpiBf<1, false>{(bf16_t*)(ws + OFF_XQ), 512, (const float*)(ws + OFF_SSQ1)}))
    PH(7, phase7(p, lds, MYTID))
    PH(8, run_gemm(L, MYTID, (const bf16_t*)(ws + OFF_XO), (const bf16_t*)(ws + OFF_WXO), T, DM, 512, EpiRes{p.out, p.out, (bf16_t*)(ws + OFF_X2B), (float*)(ws + OFF_SSQ2)}))
    PH(9, run_gemm(L, MYTID, (const bf16_t*)(ws + OFF_X2B), (const bf16_t*)(ws + OFF_WGU), T, 2 * DFF, DM, Epi9{(bf16_t*)(ws + OFF_HID), (const float*)(ws + OFF_SSQ2)}))
    PH(10, run_gemm(L, MYTID, (const bf16_t*)(ws + OFF_HID), (const bf16_t*)(ws + OFF_WD), T, DM, DFF, EpiRes{p.out, p.out, nullptr, (float*)(ws + OFF_SSQ3)}))
    PH(11, phase11(p, MYTID))
}

extern "C" void kernel_launch(void* const* d_in, const int* in_sizes, int n_in, void* d_out, int out_size, void* d_ws, size_t ws_size, hipStream_t stream) {
    static int grid_blocks = 0;
    if (!grid_blocks) {
        int dev = 0, cus = 0, per_cu = 0;
        (void)hipGetDevice(&dev);
        (void)hipDeviceGetAttribute(&cus, hipDeviceAttributeMultiprocessorCount, dev);
        (void)hipFuncSetAttribute((const void*)mega, hipFuncAttributeMaxDynamicSharedMemorySize, LDS_BYTES);
        (void)hipOccupancyMaxActiveBlocksPerMultiprocessor(&per_cu, mega, NTHR, LDS_BYTES);
        if (per_cu != 1) per_cu = 1;
        grid_blocks = cus * per_cu;
    }
    Params p{};
    p.x = (const float*)d_in[0]; p.mem = (const float*)d_in[1]; p.pos = (const int*)d_in[2];
    p.g_mix = (const float*)d_in[3]; p.w_in = (const float*)d_in[4]; p.b_gate = (const float*)d_in[5]; p.g_q_lat = (const float*)d_in[6]; p.w_uq = (const float*)d_in[7];
    p.g_kv_lat = (const float*)d_in[8]; p.w_ukv = (const float*)d_in[9]; p.w_a = (const float*)d_in[10]; p.w_b = (const float*)d_in[11]; p.w_o = (const float*)d_in[12];
    p.g_x = (const float*)d_in[13]; p.g_mem = (const float*)d_in[14]; p.w_xq = (const float*)d_in[15]; p.w_xkv = (const float*)d_in[16]; p.w_xo = (const float*)d_in[17];
    p.g_ffn = (const float*)d_in[18]; p.w_gate = (const float*)d_in[19]; p.w_up = (const float*)d_in[20]; p.w_down = (const float*)d_in[21]; p.g_final = (const float*)d_in[22];
    p.out = (float*)d_out; p.ws = (char*)d_ws;
#if ONE_LAUNCH
    int lo = 0, hi = NPHASE, coop = 1;
    (void)hipMemsetAsync((char*)d_ws + OFF_BAR, 0, XCD_BAR_WORDS * sizeof(unsigned), stream);
    void* args[] = {&p, &lo, &hi, &coop};
    hipError_t e = hipLaunchCooperativeKernel((void*)mega, dim3(grid_blocks), dim3(NTHR), args, LDS_BYTES, stream);
    if (e != hipSuccess) fprintf(stderr, "cooperative launch failed: %s (grid %d)\n", hipGetErrorString(e), grid_blocks);
#else
    for (int ph = 0; ph < NPHASE; ++ph) mega<<<dim3(grid_blocks), dim3(NTHR), LDS_BYTES, stream>>>(p, ph, ph + 1, 0);
#endif
}
```

```cpp
#include <hip/hip_runtime.h>
#include <hip/hip_cooperative_groups.h>
#include <cstdio>
#include <cstdint>
namespace cg = cooperative_groups;

#ifndef ONE_LAUNCH
#define ONE_LAUNCH 1
#endif

namespace pg8 {
#define PG8_LAS __attribute__((address_space(3)))
typedef unsigned short bf16_t;
typedef short bf16x8 __attribute__((ext_vector_type(8)));
typedef float f32x4 __attribute__((ext_vector_type(4)));
typedef unsigned u32x4 __attribute__((ext_vector_type(4)));
constexpr int BM = 256, BK = 64, HALF = 128, HTB = HALF * BK * 2  , STAGE_BYTES = 8 * HTB, NXCD = 8, WGM = 8;

__host__ __device__ __forceinline__ int lds_byte(int r, int c) { const int st = (r >> 4) * 2 + (c >> 5), rr = r & 15, cc = c & 31, ob = rr * 64 + cc * 2; return st * 1024 + (ob ^ (((ob >> 9) & 1) << 5)); }
__host__ __device__ __forceinline__ void stage_rc(int b, int& R, int& C) { const int st = b / 1024, sb = b % 1024, swz = sb ^ (((sb >> 9) & 1) << 5); R = (st >> 1) * 16 + swz / 64; C = (st & 1) * 32 + (swz % 64) / 2; }
__host__ __device__ __forceinline__ int perm32(int rho) { const int n = rho >> 4, i = rho & 15; return 8 * (i >> 2) + 4 * n + (i & 3); }

struct Unit { int pm, pn; };
struct Gemm { const bf16_t* A; const bf16_t* Bt; int M, N, K; };

struct StaticOrder {
    int nM, nN, nwg, G, c;
    __host__ __device__ void init(int M, int N, int G_, int c_) { nM = M / BM; nN = N / BM; nwg = nM * nN; G = G_; c = c_; }
    __host__ __device__ bool next(int i, Unit& u) const {
        const long L = (long)i * G + c; if (L >= nwg) return false;
        int wgid = (int)L; { const int q = nwg / NXCD, r = nwg % NXCD, xcd = wgid % NXCD, off = wgid / NXCD; wgid = (xcd < r ? xcd * (q + 1) : r * (q + 1) + (xcd - r) * q) + off; }
        const int nig = WGM * nN, gid = wgid / nig, fm = gid * WGM, gsz = (nM - fm) < WGM ? (nM - fm) : WGM;
        u.pm = fm + ((wgid % nig) % gsz); u.pn = (wgid % nig) / gsz; return true;
    }
    __device__ __forceinline__ void a_ready(const Unit&) const {}
    __device__ __forceinline__ void done(const Unit&) const {}
};


template <class Epi, class Sched, bool ALIGN_EPI = false, bool SP2 = false>
__device__ __forceinline__ void gemm_phase(PG8_LAS unsigned char* lds, const Gemm g, const Sched& S, const Epi& E, const int tid_in) {
    int tid_ = tid_in; asm volatile("" : "+v"(tid_));
    const int tid = tid_, wid = __builtin_amdgcn_readfirstlane(tid >> 6), lane = tid & 63, wr = wid >> 2, wc = wid & 3, fr = lane & 15, fq = lane >> 4;
    const int K = g.K, nt = K / BK;
    unsigned voffA[2], voffB[2];
#pragma unroll
    for (int i = 0; i < 2; ++i) { int R, C; stage_rc(tid * 16 + i * 8192, R, C); const int Rb = Epi::PERM ? ((R & ~31) + perm32(R & 31)) : R;
        voffA[i] = (unsigned)(R * K + C) * 2u; voffB[i] = (unsigned)(Rb * K + C) * 2u; }
    const size_t kstep = (size_t)(BK * 2);
    const size_t hstep = (size_t)HALF * K * 2;
    const size_t tstep = 2 * hstep;
    const unsigned ldsw = (unsigned)wid * 1024u;
    const int aoff = lds_byte(wr * 64 + fr, fq * 8), boff = lds_byte(wc * 32 + fr, fq * 8);
#define PG8_SA(b, h) (((b) * 2 + (h)) * HTB)
#define PG8_SB(b, h) ((4 + (b) * 2 + (h)) * HTB)
#define PG8_STAGE(bufoff, gbase, voff) do { _Pragma("unroll") for (int _i = 0; _i < 2; ++_i) \
        __builtin_amdgcn_global_load_lds((const unsigned*)((const char*)(gbase) + (voff)[_i]), (PG8_LAS unsigned*)(lds + (bufoff) + ldsw + _i * 8192), 16, 0, 0); } while (0)
#define PG8_LDA(dst, b, h) do { _Pragma("unroll") for (int m = 0; m < 4; ++m) _Pragma("unroll") for (int k = 0; k < 2; ++k) dst[m][k] = *(const PG8_LAS bf16x8*)(lds + PG8_SA(b, h) + aoff + m * 2048 + k * 1024); } while (0)
#define PG8_LDB(dst, b, h) do { _Pragma("unroll") for (int n = 0; n < 2; ++n) _Pragma("unroll") for (int k = 0; k < 2; ++k) dst[n][k] = *(const PG8_LAS bf16x8*)(lds + PG8_SB(b, h) + boff + n * 2048 + k * 1024); } while (0)
#define PG8_MMA(ai, bj, At, Bt) do { __builtin_amdgcn_s_setprio(1); _Pragma("unroll") for (int m = 0; m < 4; ++m) _Pragma("unroll") for (int n = 0; n < 2; ++n) _Pragma("unroll") for (int k = 0; k < 2; ++k) \
        acc[ai][bj][m][n] = __builtin_amdgcn_mfma_f32_16x16x32_bf16(Bt[n][k], At[m][k], acc[ai][bj][m][n], 0, 0, 0); __builtin_amdgcn_s_setprio(0); } while (0)
#define PG8_WAIT_V(n) asm volatile("s_waitcnt vmcnt(" #n ")" ::: "memory")
#define PG8_WAIT_L(n) asm volatile("s_waitcnt lgkmcnt(" #n ")" ::: "memory")
#define PG8_BAR __builtin_amdgcn_s_barrier()
#define PG8_SCHED __builtin_amdgcn_sched_barrier(0)
    Unit cur, nxt; int ui = 0;
    if (!S.next(0, cur)) return;
    f32x4 acc[2][2][4][2];
#pragma unroll
    for (int a = 0; a < 2; ++a)
#pragma unroll
        for (int b = 0; b < 2; ++b)
#pragma unroll
            for (int m = 0; m < 4; ++m)
#pragma unroll
                for (int n = 0; n < 2; ++n) acc[a][b][m][n] = (f32x4){0.f, 0.f, 0.f, 0.f};
    bf16x8 At[4][2], B0[2][2], B1[2][2];
    const char* cA = (const char*)g.A + (size_t)cur.pm * tstep; const char* cB = (const char*)g.Bt + (size_t)cur.pn * tstep;
    S.a_ready(cur);
    if constexpr (SP2) {
        PG8_STAGE(PG8_SB(0, 0), cB, voffB); PG8_STAGE(PG8_SB(0, 1), cB + hstep, voffB); PG8_STAGE(PG8_SA(0, 0), cA, voffA); PG8_STAGE(PG8_SA(0, 1), cA + hstep, voffA);
        if (wr == 1) PG8_BAR;
        PG8_WAIT_V(2); PG8_BAR;
        PG8_STAGE(PG8_SB(1, 0), cB + kstep, voffB); PG8_STAGE(PG8_SA(1, 0), cA + kstep, voffA); PG8_STAGE(PG8_SB(1, 1), cB + hstep + kstep, voffB);
        PG8_WAIT_V(6); PG8_BAR;
    } else {
        PG8_STAGE(PG8_SB(0, 0), cB, voffB); PG8_STAGE(PG8_SA(0, 0), cA, voffA); PG8_STAGE(PG8_SB(0, 1), cB + hstep, voffB); PG8_STAGE(PG8_SA(0, 1), cA + hstep, voffA);
        if (wr == 1) PG8_BAR;
        PG8_WAIT_V(4); PG8_BAR;
        PG8_STAGE(PG8_SB(1, 0), cB + kstep, voffB); PG8_STAGE(PG8_SA(1, 0), cA + kstep, voffA); PG8_STAGE(PG8_SB(1, 1), cB + hstep + kstep, voffB);
        PG8_WAIT_V(6); PG8_BAR;
    }
    for (;;) {
        const bool has_next = S.next(ui + 1, nxt);
        const char* nA = has_next ? (const char*)g.A + (size_t)nxt.pm * tstep : cA; const char* nB = has_next ? (const char*)g.Bt + (size_t)nxt.pn * tstep : cB;
        for (int t = 0; t < nt; t += 2) {
            const bool last = (t == nt - 2);
            const char* a1 = cA + (size_t)(t + 1) * kstep;
            const char* a2 = last ? nA : cA + (size_t)(t + 2) * kstep; const char* b2 = last ? nB : cB + (size_t)(t + 2) * kstep;
            const char* a3 = a2 + kstep; const char* b3 = b2 + kstep;
            if (last && has_next) S.a_ready(nxt);
            if constexpr (SP2) {
            PG8_LDB(B0, 0, 0); PG8_LDB(B1, 0, 1); PG8_SCHED; PG8_LDA(At, 0, 0); PG8_STAGE(PG8_SA(1, 1), a1 + hstep, voffA);
            PG8_WAIT_V(8); PG8_WAIT_L(0); PG8_BAR; PG8_MMA(0, 0, At, B0); PG8_MMA(0, 1, At, B1); PG8_BAR; PG8_SCHED;
            PG8_LDA(At, 0, 1); PG8_STAGE(PG8_SB(0, 0), b2, voffB); PG8_STAGE(PG8_SB(0, 1), b2 + hstep, voffB); PG8_STAGE(PG8_SA(0, 0), a2, voffA);
            PG8_WAIT_V(8); PG8_WAIT_L(0); PG8_BAR; PG8_MMA(1, 0, At, B0); PG8_MMA(1, 1, At, B1); PG8_BAR; PG8_SCHED;
            PG8_LDB(B0, 1, 0); PG8_LDB(B1, 1, 1); PG8_SCHED; PG8_LDA(At, 1, 0); PG8_STAGE(PG8_SA(0, 1), a2 + hstep, voffA);
            PG8_WAIT_V(8); PG8_WAIT_L(0); PG8_BAR; PG8_MMA(0, 0, At, B0); PG8_MMA(0, 1, At, B1); PG8_BAR; PG8_SCHED;
            PG8_LDA(At, 1, 1); PG8_STAGE(PG8_SB(1, 0), b3, voffB); PG8_STAGE(PG8_SB(1, 1), b3 + hstep, voffB); PG8_STAGE(PG8_SA(1, 0), a3, voffA);
            PG8_WAIT_V(8); PG8_WAIT_L(0); PG8_BAR; PG8_MMA(1, 0, At, B0); PG8_MMA(1, 1, At, B1); PG8_BAR; PG8_SCHED;
            } else {
            PG8_LDB(B0, 0, 0); PG8_SCHED; PG8_LDA(At, 0, 0); PG8_STAGE(PG8_SA(1, 1), a1 + hstep, voffA);
            PG8_WAIT_L(8); PG8_BAR; PG8_WAIT_L(0); PG8_MMA(0, 0, At, B0); PG8_BAR; PG8_SCHED;
            PG8_LDB(B1, 0, 1); PG8_STAGE(PG8_SB(0, 0), b2, voffB);
            PG8_BAR; PG8_WAIT_L(0); PG8_MMA(0, 1, At, B1); PG8_BAR;
            PG8_LDA(At, 0, 1); PG8_STAGE(PG8_SA(0, 0), a2, voffA);
            PG8_BAR; PG8_WAIT_L(0); PG8_MMA(1, 0, At, B0); PG8_BAR; PG8_SCHED;
            PG8_STAGE(PG8_SB(0, 1), b2 + hstep, voffB);
            PG8_WAIT_V(6); PG8_BAR; PG8_MMA(1, 1, At, B1); PG8_BAR;
            PG8_LDB(B0, 1, 0); PG8_SCHED; PG8_LDA(At, 1, 0); PG8_STAGE(PG8_SA(0, 1), a2 + hstep, voffA);
            PG8_WAIT_L(8); PG8_BAR; PG8_WAIT_L(0); PG8_MMA(0, 0, At, B0); PG8_BAR; PG8_SCHED;
            PG8_LDB(B1, 1, 1); PG8_STAGE(PG8_SB(1, 0), b3, voffB);
            PG8_BAR; PG8_WAIT_L(0); PG8_MMA(0, 1, At, B1); PG8_BAR;
            PG8_LDA(At, 1, 1); PG8_STAGE(PG8_SA(1, 0), a3, voffA);
            PG8_BAR; PG8_WAIT_L(0); PG8_MMA(1, 0, At, B0); PG8_BAR; PG8_SCHED;
            PG8_STAGE(PG8_SB(1, 1), b3 + hstep, voffB);
            PG8_WAIT_V(6); PG8_BAR; PG8_MMA(1, 1, At, B1); PG8_BAR;
            }
        }
        if constexpr (ALIGN_EPI) { if (wr == 0) PG8_BAR; }
        if constexpr (!Epi::AFTER_DRAIN) { E(acc, cur, wr, wc, fr, fq); S.done(cur); }
        if (!has_next) break;
#pragma unroll
        for (int a = 0; a < 2; ++a)
#pragma unroll
            for (int b = 0; b < 2; ++b)
#pragma unroll
                for (int m = 0; m < 4; ++m)
#pragma unroll
                    for (int n = 0; n < 2; ++n) acc[a][b][m][n] = (f32x4){0.f, 0.f, 0.f, 0.f};
        cur = nxt; cA = nA; cB = nB; ++ui;
        if constexpr (ALIGN_EPI) { if (wr == 1) PG8_BAR; }
    }
    PG8_WAIT_V(0);
    if constexpr (!ALIGN_EPI) { if (wr == 0) PG8_BAR; }
    PG8_BAR;
    if constexpr (Epi::AFTER_DRAIN) { E.fused(acc, cur, wr, wc, fr, fq, lds, wid, lane); S.done(cur); }
#undef PG8_SA
#undef PG8_SB
#undef PG8_STAGE
#undef PG8_LDA
#undef PG8_LDB
#undef PG8_MMA
#undef PG8_WAIT_V
#undef PG8_WAIT_L
#undef PG8_BAR
#undef PG8_SCHED
}
}


typedef unsigned short bf16_t;
typedef short bf16x8 __attribute__((ext_vector_type(8)));
typedef float f32x16 __attribute__((ext_vector_type(16)));
typedef float f32x4 __attribute__((ext_vector_type(4)));
typedef float f32x2 __attribute__((ext_vector_type(2)));
typedef unsigned u32x4 __attribute__((ext_vector_type(4)));
typedef unsigned u32x2 __attribute__((ext_vector_type(2)));
typedef __bf16 bf16x2_t __attribute__((ext_vector_type(2)));
#define DI __device__ __forceinline__
#define LAS __attribute__((address_space(3)))
#define MFMA(a, b, c) __builtin_amdgcn_mfma_f32_32x32x16_bf16((a), (b), (c), 0, 0, 0)
using pg8::Unit;

constexpr int T = 32768, SEQ = 8192, NB = 4, DM = 1024, MEMT = 1024, MEML = 256;
constexpr int DFF = 2816;
constexpr int NTHR = 512, NWV = 8;
constexpr float EPS = 1e-6f;
constexpr float LOG2E = 1.4426950408889634f;
constexpr int LDS_BYTES = 147456;
constexpr int LDS_XB = 131072 + 1024;

constexpr size_t MB = 1024 * 1024;
constexpr size_t OFF_SSQ_Q = 0;
constexpr size_t OFF_SSQ_KV = OFF_SSQ_Q + T * 4;
constexpr size_t OFF_SSQ1 = OFF_SSQ_KV + T * 4;
constexpr size_t OFF_SSQ2 = OFF_SSQ1 + T * 4;
constexpr size_t OFF_SSQ3 = OFF_SSQ2 + T * 4;
constexpr size_t OFF_RSTD0 = OFF_SSQ3 + T * 4;
constexpr size_t OFF_BAR = 832 * 1024;
constexpr size_t OFF_CS = 1 * MB;
constexpr size_t OFF_WIN = 5 * MB;
constexpr size_t OFF_WV = OFF_WIN + 7 * MB;
constexpr size_t OFF_WUQ = OFF_WV + 1 * MB;
constexpr size_t OFF_WUK = OFF_WUQ + 768 * 256 * 2;
constexpr size_t OFF_WUV = OFF_WUK + 512 * 256 * 2;
constexpr size_t OFF_WA = OFF_WUV + 512 * 256 * 2;
constexpr size_t OFF_WB = OFF_WA + 1 * MB;
constexpr size_t OFF_WO = OFF_WB + 1 * MB;
constexpr size_t OFF_WXQ = OFF_WO + 2 * MB;
constexpr size_t OFF_WXKV = OFF_WXQ + 1 * MB;
constexpr size_t OFF_WXO = OFF_WXKV + 2 * MB;
constexpr size_t OFF_WGU = OFF_WXO + 1 * MB;
constexpr size_t OFF_WD = OFF_WGU + 11 * MB;
constexpr size_t OFF_MNB = OFF_WD + 6 * MB;
constexpr size_t OFF_XK = OFF_MNB + 2 * MB;
constexpr size_t OFF_XVT = OFF_XK + 1 * MB;
constexpr size_t OFF_ACT = 48 * MB;
static_assert(OFF_XVT + 1 * MB <= OFF_ACT, "ws map");
constexpr size_t OFF_XB = OFF_ACT;
constexpr size_t OFF_OA = OFF_XB;
constexpr size_t OFF_OB = OFF_XB + 32 * MB;
constexpr size_t OFF_CQ = OFF_XB + 64 * MB;
constexpr size_t OFF_CKV = OFF_CQ + 16 * MB;
constexpr size_t OFF_KA = OFF_CKV + 16 * MB;
constexpr size_t OFF_QA = OFF_KA + 48 * MB;
constexpr size_t OFF_VTA = OFF_QA + 48 * MB;
constexpr size_t OFF_SBQ = OFF_VTA + 32 * MB;
constexpr size_t OFF_SBK = OFF_SBQ + 32 * MB;
constexpr size_t OFF_VTB = OFF_SBK + 32 * MB;
constexpr size_t OFF_SIGA = OFF_VTB + 32 * MB;
constexpr size_t OFF_SIGB = OFF_SIGA + 64 * MB;
constexpr size_t WS_END = OFF_SIGB + 64 * MB;
static_assert(WS_END <= 512 * MB, "ws map");
constexpr size_t OFF_MERGED = OFF_KA;
constexpr size_t OFF_X1B = OFF_VTA;
constexpr size_t OFF_XQ = OFF_SBK;
constexpr size_t OFF_XO = OFF_VTB;
constexpr size_t OFF_X2B = OFF_SIGA;
constexpr size_t OFF_HID = OFF_KA;

struct Params {
    const float* x; const float* mem; const int* pos;
    const float* g_mix; const float* w_in; const float* b_gate; const float* g_q_lat; const float* w_uq;
    const float* g_kv_lat; const float* w_ukv; const float* w_a; const float* w_b; const float* w_o;
    const float* g_x; const float* g_mem; const float* w_xq; const float* w_xkv; const float* w_xo;
    const float* g_ffn; const float* w_gate; const float* w_up; const float* w_down; const float* g_final;
    float* out; char* ws;
};

DI unsigned pk2(float a, float b) { f32x2 v = {a, b}; bf16x2_t r = __builtin_convertvector(v, bf16x2_t); return __builtin_bit_cast(unsigned, r); }
DI bf16_t bf1(float a) { return (bf16_t)(pk2(a, 0.f) & 0xffffu); }
DI float ex2(float x) { return __builtin_amdgcn_exp2f(x); }
DI float lg2(float x) { return __builtin_amdgcn_logf(x); }
DI float shx32(float v) { return __shfl_xor(v, 32); }
DI int lane_id_fresh() { int l; asm volatile("v_mbcnt_lo_u32_b32 %0, -1, 0\n\tv_mbcnt_hi_u32_b32 %0, -1, %0" : "=v"(l)); return l; }
DI float bflo(unsigned u) { return __uint_as_float(u << 16); }
DI float bfhi(unsigned u) { return __uint_as_float(u & 0xffff0000u); }
DI void st_bf4(bf16_t* d, float a, float b, float c, float e) { u32x2 o; o.x = pk2(a, b); o.y = pk2(c, e); *(u32x2*)d = o; }
DI void st_bf8(bf16_t* d, const f32x4& a, const f32x4& b) { u32x4 o; o.x = pk2(a[0], a[1]); o.y = pk2(a[2], a[3]); o.z = pk2(b[0], b[1]); o.w = pk2(b[2], b[3]); *(u32x4*)d = o; }

struct WT { const float* src; const float* g; bf16_t* dst; int N, sc, k0, K, drow0; float scale; };
constexpr float SBQ_SCALE = LOG2E * 0.125f;
constexpr float MLAQ_SCALE = LOG2E * 0.10206207261596577f;
constexpr float XQ_SCALE = LOG2E * 0.08838834764831845f;
constexpr int J0 = 112 * 16;
constexpr int J1 = J0 + 16 * 16;
constexpr int J2 = J1 + 24 * 4;
constexpr int J3 = J2 + 16 * 4;
constexpr int J4 = J3 + 16 * 4;
constexpr int J5 = J4 + 32 * 8;
constexpr int J6 = J5 + 32 * 8;
constexpr int J7 = J6 + 32 * 16;
constexpr int J8 = J7 + 16 * 16;
constexpr int J9 = J8 + 32 * 16;
constexpr int J10 = J9 + 32 * 8;
constexpr int J11 = J10 + 176 * 16;
constexpr int J12 = J11 + 32 * 44;
DI WT wt_desc(const Params& p, int tl) {
    char* ws = p.ws; WT d; d.g = nullptr; d.scale = 1.f; d.src = p.w_in; d.dst = (bf16_t*)(ws + OFF_WIN); d.N = 4000; d.sc = -2; d.k0 = 0; d.K = 1024; d.drow0 = 0;
    if (tl >= J12) return d;
    if (tl < J0) { const int jk = tl / 112, jn = tl - jk * 112; const int d0 = jn * 32; int sc; float s = 1.f;
        if (d0 < 416) sc = d0; else if (d0 < 512) sc = -1; else if (d0 < 1536) { sc = d0 - 96; if (d0 < 1024) s = SBQ_SCALE; } else sc = d0 + 416;
        d.sc = sc; d.k0 = jk * 64; d.drow0 = d0; d.g = p.g_mix; d.scale = s; }
    else if (tl < J1) { const int u = tl - J0; const int jk = u >> 4, jn = u & 15; d.sc = 1440 + jn * 32; d.k0 = jk * 64; d.dst = (bf16_t*)(ws + OFF_WV); d.drow0 = jn * 32; d.g = p.g_mix; }
    else if (tl < J2) { const int u = tl - J1; const int jk = u / 24, jn = u - jk * 24; d.src = p.w_uq; d.N = 768; d.sc = jn * 32; d.k0 = jk * 64; d.dst = (bf16_t*)(ws + OFF_WUQ); d.K = 256; d.drow0 = jn * 32; d.g = p.g_q_lat; d.scale = MLAQ_SCALE; }
    else if (tl < J4) { const bool isv = tl >= J3; const int u = tl - (isv ? J3 : J2); const int jk = u >> 4, jn = u & 15; const int d0 = jn * 32;
        d.src = p.w_ukv; d.N = 1024; d.sc = jk < 2 ? (d0 >> 6) * 128 + (isv ? 64 : 0) + (d0 & 63) : -1; d.k0 = jk * 64; d.dst = (bf16_t*)(ws + (isv ? OFF_WUV : OFF_WUK)); d.K = 256; d.drow0 = d0; d.g = p.g_kv_lat; }
    else if (tl < J6) { const bool isb = tl >= J5; const int u = tl - (isb ? J5 : J4); const int jk = u >> 5, jn = u & 31;
        d.src = isb ? p.w_b : p.w_a; d.N = 1024; d.sc = jn * 32; d.k0 = jk * 64; d.dst = (bf16_t*)(ws + (isb ? OFF_WB : OFF_WA)); d.K = 512; d.drow0 = jn * 32; }
    else if (tl < J7) { const int u = tl - J6; const int jk = u >> 5, jn = u & 31; d.src = p.w_o; d.N = 1024; d.sc = jn * 32; d.k0 = jk * 64; d.dst = (bf16_t*)(ws + OFF_WO); d.drow0 = jn * 32; }
    else if (tl < J8) { const int u = tl - J7; const int jk = u >> 4, jn = u & 15; d.src = p.w_xq; d.N = 512; d.sc = jn * 32; d.k0 = jk * 64; d.dst = (bf16_t*)(ws + OFF_WXQ); d.drow0 = jn * 32; d.g = p.g_x; d.scale = XQ_SCALE; }
    else if (tl < J9) { const int u = tl - J8; const int jk = u >> 5, jn = u & 31; d.src = p.w_xkv; d.N = 1024; d.sc = jn * 32; d.k0 = jk * 64; d.dst = (bf16_t*)(ws + OFF_WXKV); d.drow0 = jn * 32; }
    else if (tl < J10) { const int u = tl - J9; const int jk = u >> 5, jn = u & 31; d.src = p.w_xo; d.N = 1024; d.sc = jn * 32; d.k0 = jk * 64; d.dst = (bf16_t*)(ws + OFF_WXO); d.K = 512; d.drow0 = jn * 32; }
    else if (tl < J11) { const int u = tl - J10; const int jk = u / 176, jn = u - jk * 176; const int d0 = jn * 32; const int rem = d0 & 255;
        d.src = (rem >= 128) ? p.w_up : p.w_gate; d.N = DFF; d.sc = (d0 >> 8) * 128 + (rem & 127); d.k0 = jk * 64; d.dst = (bf16_t*)(ws + OFF_WGU); d.drow0 = d0; d.g = p.g_ffn; }
    else { const int u = tl - J11; const int jk = u >> 5, jn = u & 31; d.src = p.w_down; d.N = 1024; d.sc = jn * 32; d.k0 = jk * 64; d.dst = (bf16_t*)(ws + OFF_WD); d.K = DFF; d.drow0 = jn * 32; }
    return d;
}
DI void wt_load(const WT& d, int t, float (&v)[8]) {
    const int nn = t & 31, kb = t >> 5;
#pragma unroll
    for (int i = 0; i < 8; ++i) { const int kk = kb + 8 * i; float x = 0.f;
        if (d.sc >= 0) { x = d.src[(size_t)(d.k0 + kk) * d.N + d.sc + nn] * d.scale; if (d.g) x *= d.g[d.k0 + kk]; }
        v[i] = x; }
}
DI void wt_put(float* l, int t, const float (&v)[8]) {
    const int nn = t & 31, kb = t >> 5;
#pragma unroll
    for (int i = 0; i < 8; ++i) l[(kb + 8 * i) * 33 + nn] = v[i];
}
DI void wt_store(const WT& d, int t, const float* l) {
    if (d.sc == -2) return;
    const int kk = t & 63, nb = t >> 6;
#pragma unroll
    for (int i = 0; i < 8; ++i) { const int nn = nb + 4 * i; d.dst[(size_t)(d.drow0 + nn) * d.K + d.k0 + kk] = bf1(l[kk * 33 + nn]); }
}

DI void phase0(const Params& p, char* ldsc, const int tid) {
    char* ws = p.ws;
    const int half = tid >> 8, t = tid & 255;
    float* l0 = (float*)ldsc + half * 2 * (64 * 33 + 16);
    float* l1 = l0 + (64 * 33 + 16);
    for (int base = blockIdx.x * 4; base < J12; base += gridDim.x * 4) {
        const WT d0 = wt_desc(p, base + half * 2), d1 = wt_desc(p, base + half * 2 + 1);
        float v0[8], v1[8];
        wt_load(d0, t, v0); wt_load(d1, t, v1);
        wt_put(l0, t, v0); wt_put(l1, t, v1);
        __syncthreads();
        wt_store(d0, t, l0); wt_store(d1, t, l1);
        __syncthreads();
    }
    {
        float* z = (float*)(ws + OFF_SSQ_Q);
        for (int i = blockIdx.x * NTHR + tid; i < 5 * T; i += gridDim.x * NTHR) z[i] = 0.f;
    }
    const int lane = tid & 63, w = tid >> 6;
    for (int row0 = (blockIdx.x * NWV + w) * 4; row0 < T + MEMT; row0 += gridDim.x * NWV * 4) {
        f32x4 v[4][4];
#pragma unroll
        for (int r = 0; r < 4; ++r) { const int row = row0 + r; const float* src = row >= T ? p.mem + (size_t)(row - T) * DM : p.x + (size_t)row * DM;
#pragma unroll
            for (int i = 0; i < 4; ++i) v[r][i] = *(const f32x4*)(src + i * 256 + lane * 4); }
#pragma unroll
        for (int r = 0; r < 4; ++r) {
            const int row = row0 + r; const bool ismem = row >= T;
            float ss = 0.f;
#pragma unroll
            for (int i = 0; i < 4; ++i) ss += v[r][i][0] * v[r][i][0] + v[r][i][1] * v[r][i][1] + v[r][i][2] * v[r][i][2] + v[r][i][3] * v[r][i][3];
#pragma unroll
            for (int o = 32; o >= 1; o >>= 1) ss += __shfl_xor(ss, o);
            const float rstd = rsqrtf(ss * (1.0f / DM) + EPS);
            if (!ismem) {
                bf16_t* d = (bf16_t*)(ws + OFF_XB) + (size_t)row * DM;
#pragma unroll
                for (int i = 0; i < 4; ++i) st_bf4(d + i * 256 + lane * 4, v[r][i][0], v[r][i][1], v[r][i][2], v[r][i][3]);
                if (lane == 0) ((float*)(ws + OFF_RSTD0))[row] = rstd;
                if (lane < 16) {
                    const float invf = exp2f(-(float)(2 * lane) * (13.287712379549449f / 32.0f));
                    const float ang = (float)p.pos[row] * invf;
                    const double a = (double)ang; const double kq = rint(a * 0.15915494309189535); const float rr = (float)(a - kq * 6.283185307179586);
                    f32x2 cs; cs.x = __cosf(rr); cs.y = __sinf(rr);
                    ((f32x2*)(ws + OFF_CS))[(size_t)row * 16 + lane] = cs;
                }
            } else {
                bf16_t* d = (bf16_t*)(ws + OFF_MNB) + (size_t)(row - T) * DM;
#pragma unroll
                for (int i = 0; i < 4; ++i) { const f32x4 g = *(const f32x4*)(p.g_mem + i * 256 + lane * 4);
                    st_bf4(d + i * 256 + lane * 4, v[r][i][0] * rstd * g[0], v[r][i][1] * rstd * g[1], v[r][i][2] * rstd * g[2], v[r][i][3] * rstd * g[3]); }
            }
        }
    }
}

typedef f32x4 Acc[2][2][4][2];
DI float sq4(const f32x4& v) { return v[0] * v[0] + v[1] * v[1] + v[2] * v[2] + v[3] * v[3]; }
DI float red_fq(float s) { s += __shfl_xor(s, 16); s += __shfl_xor(s, 32); return s; }
DI float sigm(float z) { return __builtin_amdgcn_rcpf(1.f + ex2(-z * LOG2E)); }

struct Epi1 {
    static constexpr bool PERM = false, AFTER_DRAIN = false;
    char* ws; const float* b_gate;
    DI void operator()(const Acc& acc, const Unit& u, int wr, int wc, int fr, int fq) const {
        const int pn = u.pn;
        const float* rstd0 = (const float*)(ws + OFF_RSTD0);
#pragma unroll
        for (int ai = 0; ai < 2; ++ai)
#pragma unroll
            for (int m = 0; m < 4; ++m) {
                const int tok = u.pm * 256 + ai * 128 + wr * 64 + m * 16 + fr;
                const float rs = rstd0[tok];
                if (pn <= 1) {
                    bf16_t* d = (bf16_t*)(ws + (pn == 0 ? OFF_CQ : OFF_CKV)) + (size_t)tok * 256 + wc * 32 + fq * 4;
                    float ssq = 0.f;
#pragma unroll
                    for (int bj = 0; bj < 2; ++bj)
#pragma unroll
                        for (int n = 0; n < 2; ++n) { const f32x4 v = acc[ai][bj][m][n] * rs; if (pn == 0 || bj == 0) ssq += sq4(v); st_bf4(d + bj * 128 + n * 16, v[0], v[1], v[2], v[3]); }
                    ssq = red_fq(ssq);
                    if (fq == 0) atomicAdd((float*)(ws + (pn == 0 ? OFF_SSQ_Q : OFF_SSQ_KV)) + tok, ssq);
                    if (pn == 1 && wc == 0) {
                        const f32x4 c01 = *(const f32x4*)(ws + OFF_CS + ((size_t)tok * 16 + fq * 4) * 8), c23 = *(const f32x4*)(ws + OFF_CS + ((size_t)tok * 16 + fq * 4 + 2) * 8);
                        const f32x4 x1 = acc[ai][1][m][0] * rs, x2 = acc[ai][1][m][1] * rs;
                        const float cs_[4] = {c01[0], c01[2], c23[0], c23[2]}, sn_[4] = {c01[1], c01[3], c23[1], c23[3]};
                        float lo[4], hi[4];
#pragma unroll
                        for (int j = 0; j < 4; ++j) { lo[j] = x1[j] * cs_[j] - x2[j] * sn_[j]; hi[j] = x2[j] * cs_[j] + x1[j] * sn_[j]; }
                        bf16_t* k = (bf16_t*)(ws + OFF_KA) + (size_t)tok * 768 + 64 + fq * 4;
#pragma unroll
                        for (int h = 0; h < 8; ++h) { st_bf4(k + h * 96, lo[0], lo[1], lo[2], lo[3]); st_bf4(k + h * 96 + 16, hi[0], hi[1], hi[2], hi[3]); }
                    }
                } else if (pn < 6) {
                    bf16_t* d = (bf16_t*)(ws + (pn < 4 ? OFF_SBQ : OFF_SBK)) + (size_t)tok * 512 + ((pn & 1) * 256) + wc * 32 + fq * 4;
#pragma unroll
                    for (int bj = 0; bj < 2; ++bj)
#pragma unroll
                        for (int n = 0; n < 2; ++n) { const f32x4 v = acc[ai][bj][m][n] * rs; st_bf4(d + bj * 128 + n * 16, v[0], v[1], v[2], v[3]); }
                } else {
                    const int gi = pn >= 10; const int c0 = (pn - (gi ? 10 : 6)) * 256 + wc * 32 + fq * 4;
                    bf16_t* d = (bf16_t*)(ws + (gi ? OFF_SIGB : OFF_SIGA)) + (size_t)tok * DM + c0;
                    const float* bg = b_gate + gi * DM + c0;
#pragma unroll
                    for (int bj = 0; bj < 2; ++bj)
#pragma unroll
                        for (int n = 0; n < 2; ++n) { const f32x4 bb = *(const f32x4*)(bg + bj * 128 + n * 16); const f32x4 v = acc[ai][bj][m][n] * rs + bb;
                            st_bf4(d + bj * 128 + n * 16, sigm(v[0]), sigm(v[1]), sigm(v[2]), sigm(v[3])); }
                }
            }
    }
};

template <int SMODE>
struct EpiVt {
    static constexpr bool PERM = true, AFTER_DRAIN = false;
    bf16_t* out; int ldo; const float* sc;
    DI void operator()(const Acc& acc, const Unit& u, int wr, int wc, int fr, int fq) const {
#pragma unroll
        for (int bj = 0; bj < 2; ++bj) {
            const int col = u.pn * 256 + bj * 128 + wc * 32 + fq * 8;
#pragma unroll
            for (int ai = 0; ai < 2; ++ai)
#pragma unroll
                for (int m = 0; m < 4; ++m) { const int row = u.pm * 256 + ai * 128 + wr * 64 + m * 16 + fr;
                    f32x4 a = acc[ai][bj][m][0], b = acc[ai][bj][m][1];
                    if (SMODE >= 1) { f32x4 s0 = *(const f32x4*)(sc + col), s1 = *(const f32x4*)(sc + col + 4);
                        if (SMODE == 2) {
#pragma unroll
                            for (int j = 0; j < 4; ++j) { s0[j] = rsqrtf(s0[j] * (1.0f / 128.0f) + EPS); s1[j] = rsqrtf(s1[j] * (1.0f / 128.0f) + EPS); }
                        }
                        a *= s0; b *= s1; }
                    st_bf8(out + (size_t)row * ldo + col, a, b); }
        }
    }
};

struct Epi2q {
    static constexpr bool PERM = false, AFTER_DRAIN = false;
    char* ws;
    DI void operator()(const Acc& acc, const Unit& u, int wr, int wc, int fr, int fq) const {
#pragma unroll
        for (int ai = 0; ai < 2; ++ai)
#pragma unroll
            for (int m = 0; m < 4; ++m) {
                const int tok = u.pm * 256 + ai * 128 + wr * 64 + m * 16 + fr;
                const float rs = rsqrtf(((const float*)(ws + OFF_SSQ_Q))[tok] * (1.0f / 256.0f) + EPS);
#pragma unroll
                for (int bj = 0; bj < 2; ++bj) {
                    const int cg0 = u.pn * 256 + bj * 128 + wc * 32;
                    bf16_t* d = (bf16_t*)(ws + OFF_QA) + (size_t)tok * 768 + cg0 + fq * 4;
                    const f32x4 x1 = acc[ai][bj][m][0] * rs, x2 = acc[ai][bj][m][1] * rs;
                    if (((cg0 >> 5) % 3) == 2) {
                        const f32x4 c01 = *(const f32x4*)(ws + OFF_CS + ((size_t)tok * 16 + fq * 4) * 8), c23 = *(const f32x4*)(ws + OFF_CS + ((size_t)tok * 16 + fq * 4 + 2) * 8);
                        const float cs_[4] = {c01[0], c01[2], c23[0], c23[2]}, sn_[4] = {c01[1], c01[3], c23[1], c23[3]};
                        float lo[4], hi[4];
#pragma unroll
                        for (int j = 0; j < 4; ++j) { lo[j] = x1[j] * cs_[j] - x2[j] * sn_[j]; hi[j] = x2[j] * cs_[j] + x1[j] * sn_[j]; }
                        st_bf4(d, lo[0], lo[1], lo[2], lo[3]); st_bf4(d + 16, hi[0], hi[1], hi[2], hi[3]);
                    } else { st_bf4(d, x1[0], x1[1], x1[2], x1[3]); st_bf4(d + 16, x2[0], x2[1], x2[2], x2[3]); }
                }
            }
    }
};

template <int RMODE  , bool KA  >
struct EpiBf {
    static constexpr bool PERM = true, AFTER_DRAIN = false;
    bf16_t* out; int ldo; const float* ssq;
    DI void operator()(const Acc& acc, const Unit& u, int wr, int wc, int fr, int fq) const {
#pragma unroll
        for (int ai = 0; ai < 2; ++ai)
#pragma unroll
            for (int m = 0; m < 4; ++m) {
                const int tok = u.pm * 256 + ai * 128 + wr * 64 + m * 16 + fr;
                float rs = 1.f;
                if (RMODE == 1) rs = rsqrtf(ssq[tok] * (1.0f / 1024.0f) + EPS);
                if (RMODE == 2) rs = rsqrtf(ssq[tok] * (1.0f / 128.0f) + EPS);
#pragma unroll
                for (int bj = 0; bj < 2; ++bj) { int col = u.pn * 256 + bj * 128 + wc * 32 + fq * 8; if (KA) col = (col >> 6) * 96 + (col & 63);
                    st_bf8(out + (size_t)tok * ldo + col, acc[ai][bj][m][0] * rs, acc[ai][bj][m][1] * rs); }
            }
    }
};

template <int STEP>
struct Epi4 {
    static constexpr bool PERM = true, AFTER_DRAIN = false;
    const bf16_t* sig; bf16_t* ta; bf16_t* merged;
    DI void operator()(const Acc& acc, const Unit& u, int wr, int wc, int fr, int fq) const {
#pragma unroll
        for (int ai = 0; ai < 2; ++ai)
#pragma unroll
            for (int m = 0; m < 4; ++m) {
                const int tok = u.pm * 256 + ai * 128 + wr * 64 + m * 16 + fr;
#pragma unroll
                for (int bj = 0; bj < 2; ++bj) { const size_t off = (size_t)tok * DM + u.pn * 256 + bj * 128 + wc * 32 + fq * 8;
                    const u32x4 sg = *(const u32x4*)(sig + off);
                    f32x4 a = acc[ai][bj][m][0], b = acc[ai][bj][m][1];
                    a[0] *= bflo(sg.x); a[1] *= bfhi(sg.x); a[2] *= bflo(sg.y); a[3] *= bfhi(sg.y); b[0] *= bflo(sg.z); b[1] *= bfhi(sg.z); b[2] *= bflo(sg.w); b[3] *= bfhi(sg.w);
                    if (STEP == 0) st_bf8(ta + off, a, b);
                    else { const u32x4 tv = *(const u32x4*)(ta + off); a[0] += bflo(tv.x); a[1] += bfhi(tv.x); a[2] += bflo(tv.y); a[3] += bfhi(tv.y); b[0] += bflo(tv.z); b[1] += bfhi(tv.z); b[2] += bflo(tv.w); b[3] += bfhi(tv.w); st_bf8(merged + off, a, b); } }
            }
    }
};

struct EpiRes {
    static constexpr bool PERM = true, AFTER_DRAIN = false;
    const float* res; float* out; bf16_t* outb; float* ssq;
    DI void operator()(const Acc& acc, const Unit& u, int wr, int wc, int fr, int fq) const {
#pragma unroll
        for (int ai = 0; ai < 2; ++ai)
#pragma unroll
            for (int m = 0; m < 4; ++m) {
                const int tok = u.pm * 256 + ai * 128 + wr * 64 + m * 16 + fr; float s = 0.f;
#pragma unroll
                for (int bj = 0; bj < 2; ++bj) { const size_t off = (size_t)tok * DM + u.pn * 256 + bj * 128 + wc * 32 + fq * 8;
                    const f32x4 a = *(const f32x4*)(res + off) + acc[ai][bj][m][0], b = *(const f32x4*)(res + off + 4) + acc[ai][bj][m][1];
                    s += sq4(a) + sq4(b);
                    *(f32x4*)(out + off) = a; *(f32x4*)(out + off + 4) = b;
                    if (outb) st_bf8(outb + off, a, b); }
                s = red_fq(s);
                if (fq == 0) atomicAdd(ssq + tok, s);
            }
    }
};

struct Epi9 {
    static constexpr bool PERM = true, AFTER_DRAIN = false;
    bf16_t* hid; const float* ssq;
    DI void operator()(const Acc& acc, const Unit& u, int wr, int wc, int fr, int fq) const {
#pragma unroll
        for (int ai = 0; ai < 2; ++ai)
#pragma unroll
            for (int m = 0; m < 4; ++m) {
                const int tok = u.pm * 256 + ai * 128 + wr * 64 + m * 16 + fr;
                const float rs = rsqrtf(ssq[tok] * (1.0f / 1024.0f) + EPS);
                f32x4 o[2];
#pragma unroll
                for (int n = 0; n < 2; ++n)
#pragma unroll
                    for (int j = 0; j < 4; ++j) { const float g = acc[ai][0][m][n][j] * rs, uu = acc[ai][1][m][n][j] * rs; o[n][j] = g * sigm(g) * uu; }
                st_bf8(hid + (size_t)tok * DFF + u.pn * 128 + wc * 32 + fq * 8, o[0], o[1]);
            }
    }
};

template <class Epi>
DI void run_gemm_at(LAS unsigned char* L, const int tid, int first, const bf16_t* A, const bf16_t* Bt, int M, int N, int K, const Epi& E) {
    pg8::Gemm g{A, Bt, M, N, K}; pg8::StaticOrder S; S.init(M, N, (int)gridDim.x, (int)((blockIdx.x + gridDim.x - first) % gridDim.x));
    pg8::gemm_phase<Epi, pg8::StaticOrder, true, true>(L, g, S, E, tid);
}
template <class Epi>
DI void run_gemm(LAS unsigned char* L, const int tid, const bf16_t* A, const bf16_t* Bt, int M, int N, int K, const Epi& E) {
    pg8::Gemm g{A, Bt, M, N, K}; pg8::StaticOrder S; S.init(M, N, (int)gridDim.x, (int)blockIdx.x);
    pg8::gemm_phase<Epi, pg8::StaticOrder, true, true>(L, g, S, E, tid);
}

template <int DQK> DI int ksw(int row, int c) { return DQK == 64 ? (c ^ ((row >> 1) & 7)) : DQK == 96 ? (c ^ ((row >> 2) & 3)) : (c ^ (row & 15)); }

template <int DQK, int DV, int MODE>
DI void attn_block(const bf16_t* __restrict__ Q, int ldq, const bf16_t* __restrict__ Kp, int ldk, const bf16_t* __restrict__ Vt, int ldv,
                   bf16_t* __restrict__ O, int ldo, int q0, int ntiles, char* lds, const int tid) {
    constexpr int NCK = DQK / 8, KB = 64 * DQK * 2, VB = DV * 128, STG = KB + VB, NKC = 64 * NCK, NKL = (NKC + NTHR - 1) / NTHR, NVL = DV * 8 / NTHR, NKK = DQK / 16, NDT = DV / 32;
    const int t = tid, lane = t & 63, w = t >> 6, fr = lane & 31, fh = lane >> 5;
    const int qrow = q0 + w * 32 + fr;
    const int qlo = q0 + w * 32, qhi = qlo + 31;
    unsigned* flags = (unsigned*)(lds + 2 * STG);
    bf16x8 qf[NKK];
#pragma unroll
    for (int kk = 0; kk < NKK; ++kk) qf[kk] = *(const bf16x8*)(Q + (size_t)qrow * ldq + kk * 16 + fh * 8);
    f32x16 o[NDT];
#pragma unroll
    for (int d = 0; d < NDT; ++d)
#pragma unroll
        for (int r = 0; r < 16; ++r) o[d][r] = 0.f;
    float m_run = -1e30f, l_run = 0.f;
    u32x4 rk[NKL], rv[NVL];
    auto gload = [&](int kt) {
        const int key0 = kt * 64;
#pragma unroll
        for (int i = 0; i < NKL; ++i) { const int id = t + NTHR * i; if (NKC % NTHR == 0 || id < NKC) { const int row = id / NCK, c = id - row * NCK; rk[i] = *(const u32x4*)(Kp + (size_t)(key0 + row) * ldk + c * 8); } }
#pragma unroll
        for (int i = 0; i < NVL; ++i) { const int id = t + NTHR * i; const int row = id >> 3, c = id & 7; rv[i] = *(const u32x4*)(Vt + (size_t)row * ldv + key0 + c * 8); }
    };
    auto sstore = [&](char* buf) {
#pragma unroll
        for (int i = 0; i < NKL; ++i) { const int id = t + NTHR * i; if (NKC % NTHR == 0 || id < NKC) { const int row = id / NCK, c = id - row * NCK; *(u32x4*)(buf + row * (DQK * 2) + (ksw<DQK>(row, c) << 4)) = rk[i]; } }
#pragma unroll
        for (int i = 0; i < NVL; ++i) { const int id = t + NTHR * i; const int row = id >> 3, c = id & 7; const int g2 = (c >> 1) * 2, a = c & 1, sw = (row >> 1) & 7;
            char* rb_ = buf + KB + row * 128 + a * 8;
            u32x2 lo2, hi2; lo2.x = rv[i].x; lo2.y = rv[i].y; hi2.x = rv[i].z; hi2.y = rv[i].w;
            *(u32x2*)(rb_ + ((g2 ^ sw) << 4)) = lo2; *(u32x2*)(rb_ + (((g2 + 1) ^ sw) << 4)) = hi2; }
    };
    auto tile_of = [&](int it) { return MODE == 1 ? (ntiles - 1 - it) : it; };
    gload(tile_of(0)); sstore(lds); __syncthreads();
    for (int it = 0; it < ntiles; ++it) {
        const int kt = tile_of(it), key0 = kt * 64;
        const char* buf = lds + (it & 1) * STG;
        const bool more = it + 1 < ntiles;
        if (more && MODE != 2) gload(tile_of(it + 1));
        bool active;
        if (MODE == 0) active = key0 <= qhi; else if (MODE == 1) active = key0 < qhi && !(__all(l_run > 152.f) != 0); else active = true;
        if (active) {
            f32x16 s[2];
#pragma unroll
            for (int mt = 0; mt < 2; ++mt)
#pragma unroll
                for (int r = 0; r < 16; ++r) s[mt][r] = 0.f;
#pragma unroll
            for (int kk = 0; kk < NKK; ++kk)
#pragma unroll
                for (int mt = 0; mt < 2; ++mt) { const int row = mt * 32 + fr; const bf16x8 kf = *(const bf16x8*)(buf + row * (DQK * 2) + (ksw<DQK>(row, kk * 2 + fh) << 4)); s[mt] = MFMA(kf, qf[kk], s[mt]); }
            bf16x8 pf[4];
            if (MODE != 1) {
                if (MODE == 0 && key0 + 63 > qlo) {
#pragma unroll
                    for (int mt = 0; mt < 2; ++mt)
#pragma unroll
                        for (int r = 0; r < 16; ++r) { const int key = key0 + mt * 32 + (r >> 2) * 8 + fh * 4 + (r & 3); if (key > qrow) s[mt][r] = -1e30f; }
                }
                float mx = s[0][0];
#pragma unroll
                for (int mt = 0; mt < 2; ++mt)
#pragma unroll
                    for (int r = 0; r < 16; ++r) mx = fmaxf(mx, s[mt][r]);
                mx = fmaxf(mx, shx32(mx));
                const float mnew = fmaxf(m_run, mx); const float alpha = ex2(m_run - mnew); m_run = mnew;
                float sum = 0.f;
#pragma unroll
                for (int mt = 0; mt < 2; ++mt)
#pragma unroll
                    for (int r = 0; r < 16; ++r) { const float pv = ex2(s[mt][r] - mnew); s[mt][r] = pv; sum += pv; }
                l_run = l_run * alpha + sum;
#pragma unroll
                for (int d = 0; d < NDT; ++d)
#pragma unroll
                    for (int r = 0; r < 16; ++r) o[d][r] *= alpha;
            } else {
                const bool diag = key0 + 63 >= qlo;
                float G[8];
#pragma unroll
                for (int mt = 0; mt < 2; ++mt)
#pragma unroll
                    for (int rg = 0; rg < 4; ++rg) {
                        float g = 0.f;
#pragma unroll
                        for (int j = 3; j >= 0; --j) { const int r = rg * 4 + j; const float z = s[mt][r];
                            const float wv = lg2(1.f + ex2(-fabsf(z)));
                            float nlom = fmaxf(z, 0.f) + wv; float nl = nlom - z;
                            if (diag) { const int key = key0 + mt * 32 + rg * 8 + fh * 4 + j; if (key >= qrow) { nlom = 0.f; nl = 1e30f; } }
                            s[mt][r] = nl + g; g += nlom; }
                        G[mt * 4 + rg] = g;
                    }
                float base[8]; float run = l_run;
#pragma unroll
                for (int oc = 7; oc >= 0; --oc) { const float gp = shx32(G[oc]); base[oc] = run + (fh == 0 ? gp : 0.f); run += G[oc] + gp; }
                l_run = run;
#pragma unroll
                for (int mt = 0; mt < 2; ++mt)
#pragma unroll
                    for (int r = 0; r < 16; ++r) s[mt][r] = ex2(-(s[mt][r] + base[mt * 4 + (r >> 2)]));
            }
#pragma unroll
            for (int s4 = 0; s4 < 4; ++s4) { u32x4 pk; const int mt = s4 >> 1, rb = (s4 & 1) * 8;
                pk.x = pk2(s[mt][rb], s[mt][rb + 1]); pk.y = pk2(s[mt][rb + 2], s[mt][rb + 3]); pk.z = pk2(s[mt][rb + 4], s[mt][rb + 5]); pk.w = pk2(s[mt][rb + 6], s[mt][rb + 7]);
                pf[s4] = __builtin_bit_cast(bf16x8, pk); }
#pragma unroll
            for (int s4 = 0; s4 < 4; ++s4)
#pragma unroll
                for (int d = 0; d < NDT; ++d) { const int row = d * 32 + fr; const bf16x8 vf = *(const bf16x8*)(buf + KB + row * 128 + (((s4 * 2 + fh) ^ ((row >> 1) & 7)) << 4)); o[d] = MFMA(vf, pf[s4], o[d]); }
        }
        if (more) { if (MODE == 2) gload(tile_of(it + 1)); sstore(lds + ((it + 1) & 1) * STG); }
        if (MODE == 1) {
            const bool fin = __all(l_run > 152.f) != 0;
            if (lane == 0) flags[(it & 1) * NWV + w] = fin ? 1u : 0u;
            __syncthreads();
            const unsigned* f = flags + (it & 1) * NWV;
            if ((f[0] & f[1] & f[2] & f[3] & f[4] & f[5] & f[6] & f[7]) != 0u) break;
        } else {
            __syncthreads();
        }
    }
    float inv = 1.f;
    if (MODE != 1) { const float lt = l_run + shx32(l_run); inv = 1.f / lt; }
#pragma unroll
    for (int d = 0; d < NDT; ++d)
#pragma unroll
        for (int rg = 0; rg < 4; ++rg) st_bf4(O + (size_t)qrow * ldo + d * 32 + rg * 8 + fh * 4, o[d][rg * 4] * inv, o[d][rg * 4 + 1] * inv, o[d][rg * 4 + 2] * inv, o[d][rg * 4 + 3] * inv);
}

DI void phase3(const Params& p, char* lds, const int tid) {
    char* ws = p.ws;
    constexpr int NMLA = 32 * 16, NSB = 32 * 32;
    for (int u = blockIdx.x; u < NMLA + NSB; u += gridDim.x) {
        if (u < NMLA) {
            const int xcd = u & 7, v = u >> 3; const int pr = v & 15, bh = (v >> 4) * 8 + xcd; const int b = bh >> 3, h = bh & 7;
            const bf16_t* Q = (const bf16_t*)(ws + OFF_QA) + (size_t)b * SEQ * 768 + h * 96;
            const bf16_t* Kp = (const bf16_t*)(ws + OFF_KA) + (size_t)b * SEQ * 768 + h * 96;
            const bf16_t* Vt = (const bf16_t*)(ws + OFF_VTA) + (size_t)(h * 64) * T + (size_t)b * SEQ;
            bf16_t* O = (bf16_t*)(ws + OFF_OA) + (size_t)b * SEQ * 512 + h * 64;
#pragma unroll 1
            for (int half = 0; half < 2; ++half) { const int qb = half ? pr : 31 - pr;
                attn_block<96, 64, 0>(Q, 768, Kp, 768, Vt, T, O, 512, qb * 256, 4 * qb + 4, lds, tid); }
        } else {
            const int uu = u - NMLA; const int xcd = uu & 7, v = uu >> 3; const int qb = v & 31, bh = (v >> 5) * 8 + xcd; const int b = bh >> 3, h = bh & 7;
            const bf16_t* Q = (const bf16_t*)(ws + OFF_SBQ) + (size_t)b * SEQ * 512 + h * 64;
            const bf16_t* Kp = (const bf16_t*)(ws + OFF_SBK) + (size_t)b * SEQ * 512 + h * 64;
            const bf16_t* Vt = (const bf16_t*)(ws + OFF_VTB) + (size_t)(h * 64) * T + (size_t)b * SEQ;
            bf16_t* O = (bf16_t*)(ws + OFF_OB) + (size_t)b * SEQ * 512 + h * 64;
            attn_block<64, 64, 1>(Q, 512, Kp, 512, Vt, T, O, 512, qb * 256, 4 * qb + 4, lds, tid);
        }
    }
}

DI void phase7(const Params& p, char* lds, const int tid) {
    char* ws = p.ws;
    for (int u = blockIdx.x; u < 16 * 32; u += gridDim.x) {
        const int xcd = u & 7, v = u >> 3; const int qb = v & 31, bh = (v >> 5) * 8 + xcd; const int b = bh >> 2, h = bh & 3;
        const bf16_t* Q = (const bf16_t*)(ws + OFF_XQ) + (size_t)b * SEQ * 512 + h * 128;
        const bf16_t* Kp = (const bf16_t*)(ws + OFF_XK) + (size_t)b * MEML * 512 + h * 128;
        const bf16_t* Vt = (const bf16_t*)(ws + OFF_XVT) + (size_t)(h * 128) * MEMT + (size_t)b * MEML;
        bf16_t* O = (bf16_t*)(ws + OFF_XO) + (size_t)b * SEQ * 512 + h * 128;
        attn_block<128, 128, 2>(Q, 512, Kp, 512, Vt, MEMT, O, 512, qb * 256, 4, lds, tid);
    }
}

DI void phase11(const Params& p, const int tid) {
    const float* ssq3 = (const float*)(p.ws + OFF_SSQ3);
    for (size_t i = (size_t)blockIdx.x * NTHR + tid; i < (size_t)T * DM / 4; i += (size_t)gridDim.x * NTHR) {
        const int tok = (int)(i >> 8), c = (int)(i & 255) * 4;
        const float rs = rsqrtf(ssq3[tok] * (1.0f / DM) + EPS);
        f32x4 v = *(f32x4*)(p.out + i * 4); const f32x4 g = *(const f32x4*)(p.g_final + c);
        v[0] *= rs * g[0]; v[1] *= rs * g[1]; v[2] *= rs * g[2]; v[3] *= rs * g[3];
        *(f32x4*)(p.out + i * 4) = v;
    }
}

#define XB_TMO      128
#define XB_XCNT(j)  (256  + 64 * (j))
#define XB_XSUB(j)  (1280 + 64 * (j))
#define XB_XGEN(j)  (2304 + 64 * (j))
#define XB_TOP      3328
#define XB_TOPGEN   3392
#define XCD_BAR_WORDS 3456
#define XB_SPIN_CAP (1u << 22)
DI unsigned xb_ld(unsigned* p) { return __hip_atomic_load(p, __ATOMIC_RELAXED, __HIP_MEMORY_SCOPE_AGENT); }
DI unsigned xb_add(unsigned* p, unsigned v) { return __hip_atomic_fetch_add(p, v, __ATOMIC_RELAXED, __HIP_MEMORY_SCOPE_AGENT); }
DI unsigned xb_xcc_id() { return (unsigned)__builtin_amdgcn_s_getreg((3 << 11) | 20) & 0xFu; }
#define XB_SPIN(cond, bar) do { unsigned _sp = 0; while (cond) { __builtin_amdgcn_s_sleep(1); \
    if ((++_sp & 255u) == 0u) { if (xb_ld(&(bar)[XB_TMO])) break; if (_sp > XB_SPIN_CAP) { atomicAdd(&(bar)[XB_TMO], 1u); break; } } } } while (0)
struct XcdBarrier { unsigned* bar; unsigned x; volatile LAS unsigned* st; };
DI XcdBarrier xcd_barrier_post(unsigned* bar, volatile LAS unsigned* st, const int tid) {
    XcdBarrier b; b.bar = bar; b.x = xb_xcc_id(); b.st = st;
    if (tid == 0) (void)xb_add(&bar[XB_XCNT(b.x)], 1u);
    return b;
}
DI void xcd_barrier_complete(unsigned* bar, unsigned x, unsigned& nloc, unsigned& nx) {
    const unsigned G = gridDim.x * gridDim.y * gridDim.z;
    unsigned sum, cnt, mine, sp = 0u;
    for (;;) {
        sum = 0u; cnt = 0u; mine = 0u;
#pragma unroll
        for (unsigned j = 0; j < 16; ++j) { const unsigned c = xb_ld(&bar[XB_XCNT(j)]); sum += c; cnt += (c > 0u) ? 1u : 0u; mine = (j == x) ? c : mine; }
        if (sum == G) break;
        __builtin_amdgcn_s_sleep(1);
        if ((++sp & 255u) == 0u) { if (xb_ld(&bar[XB_TMO])) break; if (sp > XB_SPIN_CAP) { atomicAdd(&bar[XB_TMO], 1u); break; } }
    }
    nloc = mine > 0u ? mine : 1u; nx = cnt > 0u ? cnt : 1u;
}
DI void xcd_barrier(const XcdBarrier& b, const int tid) {
    asm volatile("s_waitcnt vmcnt(0)" ::: "memory");
    __syncthreads();
    if (tid == 0) {
        unsigned* bar = b.bar;
        __builtin_amdgcn_s_waitcnt(0);
        unsigned nloc = b.st[0], nx = b.st[1];
        if (nloc == 0u) { xcd_barrier_complete(bar, b.x, nloc, nx); b.st[0] = nloc; b.st[1] = nx; }
        const unsigned old = xb_add(&bar[XB_XSUB(b.x)], 1u);
        const unsigned gen = old / nloc;
        if (old + 1u == (gen + 1u) * nloc) {
            __builtin_amdgcn_fence(__ATOMIC_RELEASE, "agent");
            asm volatile("s_waitcnt vmcnt(0)" ::: "memory");
            const unsigned og = xb_add(&bar[XB_TOP], 1u);
            const unsigned tg = og / nx;
            if (og + 1u == (tg + 1u) * nx) xb_add(&bar[XB_TOPGEN], 1u);
            else XB_SPIN(xb_ld(&bar[XB_TOPGEN]) == tg, bar);
            __builtin_amdgcn_fence(__ATOMIC_ACQUIRE, "agent");
            xb_add(&bar[XB_XGEN(b.x)], 1u);
            asm volatile("s_waitcnt vmcnt(0)" ::: "memory");
        } else {
            XB_SPIN(xb_ld(&bar[XB_XGEN(b.x)]) == gen, bar);
            __builtin_amdgcn_fence(__ATOMIC_ACQUIRE, "agent");
            asm volatile("s_waitcnt vmcnt(0)" ::: "memory");
        }
    }
    __syncthreads();
}


constexpr int NPHASE = 12;
__global__ void __launch_bounds__(NTHR, 2) mega(Params p, int ph_lo, int ph_hi, int coop) {
    extern __shared__ __attribute__((aligned(16))) unsigned char dlds[];
    LAS unsigned char* L = (LAS unsigned char*)dlds;
    char* lds = (char*)dlds;
    char* ws = p.ws;
    const int swid = __builtin_amdgcn_readfirstlane((int)(threadIdx.x >> 6));
#define MYTID (swid * 64 + lane_id_fresh())
    volatile LAS unsigned* xbw = (volatile LAS unsigned*)(L + LDS_XB);
    if (threadIdx.x < 4) xbw[threadIdx.x] = 0u;
    __syncthreads();
    XcdBarrier xb; xb.bar = (unsigned*)(ws + OFF_BAR); xb.x = 0; xb.st = xbw;
    if (coop) xb = xcd_barrier_post((unsigned*)(ws + OFF_BAR), xbw, MYTID);
    if (coop == 2) cg::this_grid().sync();
#define PH(n, call) if (ph_lo <= n && n < ph_hi) { call; } if (coop && n + 1 < NPHASE) xcd_barrier(xb, MYTID);
    PH(0, phase0(p, lds, MYTID))
    PH(1, { run_gemm(L, MYTID, (const bf16_t*)(ws + OFF_XB), (const bf16_t*)(ws + OFF_WIN), T, 3584, DM, Epi1{ws, p.b_gate});
            run_gemm(L, MYTID, (const bf16_t*)(ws + OFF_WV), (const bf16_t*)(ws + OFF_XB), 512, T, DM, EpiVt<1>{(bf16_t*)(ws + OFF_VTB), T, (const float*)(ws + OFF_RSTD0)}); })
    PH(2, { run_gemm(L, MYTID, (const bf16_t*)(ws + OFF_CQ), (const bf16_t*)(ws + OFF_WUQ), T, 768, 256, Epi2q{ws});
            run_gemm(L, MYTID, (const bf16_t*)(ws + OFF_CKV), (const bf16_t*)(ws + OFF_WUK), T, 512, 256, EpiBf<2, true>{(bf16_t*)(ws + OFF_KA), 768, (const float*)(ws + OFF_SSQ_KV)});
            run_gemm(L, MYTID, (const bf16_t*)(ws + OFF_WUV), (const bf16_t*)(ws + OFF_CKV), 512, T, 256, EpiVt<2>{(bf16_t*)(ws + OFF_VTA), T, (const float*)(ws + OFF_SSQ_KV)});
            run_gemm_at(L, MYTID, 128, (const bf16_t*)(ws + OFF_MNB), (const bf16_t*)(ws + OFF_WXKV), MEMT, 512, DM, EpiBf<0, false>{(bf16_t*)(ws + OFF_XK), 512, nullptr});
            run_gemm_at(L, MYTID, 144, (const bf16_t*)(ws + OFF_WXKV) + (size_t)512 * DM, (const bf16_t*)(ws + OFF_MNB), 512, MEMT, DM, EpiVt<0>{(bf16_t*)(ws + OFF_XVT), MEMT, nullptr}); })
    PH(3, phase3(p, lds, MYTID))
    PH(4, { run_gemm(L, MYTID, (const bf16_t*)(ws + OFF_OA), (const bf16_t*)(ws + OFF_WA), T, DM, 512, Epi4<0>{(const bf16_t*)(ws + OFF_SIGA), (bf16_t*)(ws + OFF_VTA), nullptr});
            run_gemm(L, MYTID, (const bf16_t*)(ws + OFF_OB), (const bf16_t*)(ws + OFF_WB), T, DM, 512, Epi4<1>{(const bf16_t*)(ws + OFF_SIGB), (bf16_t*)(ws + OFF_VTA), (bf16_t*)(ws + OFF_MERGED)}); })
    PH(5, run_gemm(L, MYTID, (const bf16_t*)(ws + OFF_MERGED), (const bf16_t*)(ws + OFF_WO), T, DM, DM, EpiRes{p.x, p.out, (bf16_t*)(ws + OFF_X1B), (float*)(ws + OFF_SSQ1)}))
    PH(6, run_gemm(L, MYTID, (const bf16_t*)(ws + OFF_X1B), (const bf16_t*)(ws + OFF_WXQ), T, 512, DM, EpiBf<1, false>{(bf16_t*)(ws + OFF_XQ), 512, (const float*)(ws + OFF_SSQ1)}))
    PH(7, phase7(p, lds, MYTID))
    PH(8, run_gemm(L, MYTID, (const bf16_t*)(ws + OFF_XO), (const bf16_t*)(ws + OFF_WXO), T, DM, 512, EpiRes{p.out, p.out, (bf16_t*)(ws + OFF_X2B), (float*)(ws + OFF_SSQ2)}))
    PH(9, run_gemm(L, MYTID, (const bf16_t*)(ws + OFF_X2B), (const bf16_t*)(ws + OFF_WGU), T, 2 * DFF, DM, Epi9{(bf16_t*)(ws + OFF_HID), (const float*)(ws + OFF_SSQ2)}))
    PH(10, run_gemm(L, MYTID, (const bf16_t*)(ws + OFF_HID), (const bf16_t*)(ws + OFF_WD), T, DM, DFF, EpiRes{p.out, p.out, nullptr, (float*)(ws + OFF_SSQ3)}))
    PH(11, phase11(p, MYTID))
}

extern "C" void kernel_launch(void* const* d_in, const int* in_sizes, int n_in, void* d_out, int out_size, void* d_ws, size_t ws_size, hipStream_t stream) {
    static int grid_blocks = 0;
    if (!grid_blocks) {
        int dev = 0, cus = 0, per_cu = 0;
        (void)hipGetDevice(&dev);
        (void)hipDeviceGetAttribute(&cus, hipDeviceAttributeMultiprocessorCount, dev);
        (void)hipFuncSetAttribute((const void*)mega, hipFuncAttributeMaxDynamicSharedMemorySize, LDS_BYTES);
        (void)hipOccupancyMaxActiveBlocksPerMultiprocessor(&per_cu, mega, NTHR, LDS_BYTES);
        if (per_cu != 1) per_cu = 1;
        grid_blocks = cus * per_cu;
    }
    Params p{};
    p.x = (const float*)d_in[0]; p.mem = (const float*)d_in[1]; p.pos = (const int*)d_in[2];
    p.g_mix = (const float*)d_in[3]; p.w_in = (const float*)d_in[4]; p.b_gate = (const float*)d_in[5]; p.g_q_lat = (const float*)d_in[6]; p.w_uq = (const float*)d_in[7];
    p.g_kv_lat = (const float*)d_in[8]; p.w_ukv = (const float*)d_in[9]; p.w_a = (const float*)d_in[10]; p.w_b = (const float*)d_in[11]; p.w_o = (const float*)d_in[12];
    p.g_x = (const float*)d_in[13]; p.g_mem = (const float*)d_in[14]; p.w_xq = (const float*)d_in[15]; p.w_xkv = (const float*)d_in[16]; p.w_xo = (const float*)d_in[17];
    p.g_ffn = (const float*)d_in[18]; p.w_gate = (const float*)d_in[19]; p.w_up = (const float*)d_in[20]; p.w_down = (const float*)d_in[21]; p.g_final = (const float*)d_in[22];
    p.out = (float*)d_out; p.ws = (char*)d_ws;
#if ONE_LAUNCH
    int lo = 0, hi = NPHASE, coop = 1;
    (void)hipMemsetAsync((char*)d_ws + OFF_BAR, 0, XCD_BAR_WORDS * sizeof(unsigned), stream);
    void* args[] = {&p, &lo, &hi, &coop};
    hipError_t e = hipLaunchCooperativeKernel((void*)mega, dim3(grid_blocks), dim3(NTHR), args, LDS_BYTES, stream);
    if (e != hipSuccess) fprintf(stderr, "cooperative launch failed: %s (grid %d)\n", hipGetErrorString(e), grid_blocks);
#else
    for (int ph = 0; ph < NPHASE; ++ph) mega<<<dim3(grid_blocks), dim3(NTHR), LDS_BYTES, stream>>>(p, ph, ph + 1, 0);
#endif
}
```

```cpp
#include <hip/hip_runtime.h>
#include <hip/hip_cooperative_groups.h>
#include <cstdio>
#include <cstdint>
namespace cg = cooperative_groups;

#ifndef ONE_LAUNCH
#define ONE_LAUNCH 1
#endif

namespace pg8 {
#define PG8_LAS __attribute__((address_space(3)))
typedef unsigned short bf16_t;
typedef short bf16x8 __attribute__((ext_vector_type(8)));
typedef float f32x4 __attribute__((ext_vector_type(4)));
typedef unsigned u32x4 __attribute__((ext_vector_type(4)));
constexpr int BM = 256, BK = 64, HALF = 128, HTB = HALF * BK * 2  , STAGE_BYTES = 8 * HTB, NXCD = 8, WGM = 8;

__host__ __device__ __forceinline__ int lds_byte(int r, int c) { const int st = (r >> 4) * 2 + (c >> 5), rr = r & 15, cc = c & 31, ob = rr * 64 + cc * 2; return st * 1024 + (ob ^ (((ob >> 9) & 1) << 5)); }
__host__ __device__ __forceinline__ void stage_rc(int b, int& R, int& C) { const int st = b / 1024, sb = b % 1024, swz = sb ^ (((sb >> 9) & 1) << 5); R = (st >> 1) * 16 + swz / 64; C = (st & 1) * 32 + (swz % 64) / 2; }
__host__ __device__ __forceinline__ int perm32(int rho) { const int n = rho >> 4, i = rho & 15; return 8 * (i >> 2) + 4 * n + (i & 3); }

struct Unit { int pm, pn; };
struct Gemm { const bf16_t* A; const bf16_t* Bt; int M, N, K; };

struct StaticOrder {
    int nM, nN, nwg, G, c;
    __host__ __device__ void init(int M, int N, int G_, int c_) { nM = M / BM; nN = N / BM; nwg = nM * nN; G = G_; c = c_; }
    __host__ __device__ bool next(int i, Unit& u) const {
        const long L = (long)i * G + c; if (L >= nwg) return false;
        int wgid = (int)L; { const int q = nwg / NXCD, r = nwg % NXCD, xcd = wgid % NXCD, off = wgid / NXCD; wgid = (xcd < r ? xcd * (q + 1) : r * (q + 1) + (xcd - r) * q) + off; }
        const int nig = WGM * nN, gid = wgid / nig, fm = gid * WGM, gsz = (nM - fm) < WGM ? (nM - fm) : WGM;
        u.pm = fm + ((wgid % nig) % gsz); u.pn = (wgid % nig) / gsz; return true;
    }
    __device__ __forceinline__ void a_ready(const Unit&) const {}
    __device__ __forceinline__ void done(const Unit&) const {}
};


template <class Epi, class Sched, bool ALIGN_EPI = false, bool SP2 = false>
__device__ __forceinline__ void gemm_phase(PG8_LAS unsigned char* lds, const Gemm g, const Sched& S, const Epi& E, const int tid_in) {
    int tid_ = tid_in; asm volatile("" : "+v"(tid_));
    const int tid = tid_, wid = __builtin_amdgcn_readfirstlane(tid >> 6), lane = tid & 63, wr = wid >> 2, wc = wid & 3, fr = lane & 15, fq = lane >> 4;
    const int K = g.K, nt = K / BK;
    unsigned voffA[2], voffB[2];
#pragma unroll
    for (int i = 0; i < 2; ++i) { int R, C; stage_rc(tid * 16 + i * 8192, R, C); const int Rb = Epi::PERM ? ((R & ~31) + perm32(R & 31)) : R;
        voffA[i] = (unsigned)(R * K + C) * 2u; voffB[i] = (unsigned)(Rb * K + C) * 2u; }
    const size_t kstep = (size_t)(BK * 2);
    const size_t hstep = (size_t)HALF * K * 2;
    const size_t tstep = 2 * hstep;
    const unsigned ldsw = (unsigned)wid * 1024u;
    const int aoff = lds_byte(wr * 64 + fr, fq * 8), boff = lds_byte(wc * 32 + fr, fq * 8);
#define PG8_SA(b, h) (((b) * 2 + (h)) * HTB)
#define PG8_SB(b, h) ((4 + (b) * 2 + (h)) * HTB)
#define PG8_STAGE(bufoff, gbase, voff) do { _Pragma("unroll") for (int _i = 0; _i < 2; ++_i) \
        __builtin_amdgcn_global_load_lds((const unsigned*)((const char*)(gbase) + (voff)[_i]), (PG8_LAS unsigned*)(lds + (bufoff) + ldsw + _i * 8192), 16, 0, 0); } while (0)
#define PG8_LDA(dst, b, h) do { _Pragma("unroll") for (int m = 0; m < 4; ++m) _Pragma("unroll") for (int k = 0; k < 2; ++k) dst[m][k] = *(const PG8_LAS bf16x8*)(lds + PG8_SA(b, h) + aoff + m * 2048 + k * 1024); } while (0)
#define PG8_LDB(dst, b, h) do { _Pragma("unroll") for (int n = 0; n < 2; ++n) _Pragma("unroll") for (int k = 0; k < 2; ++k) dst[n][k] = *(const PG8_LAS bf16x8*)(lds + PG8_SB(b, h) + boff + n * 2048 + k * 1024); } while (0)
#define PG8_MMA(ai, bj, At, Bt) do { __builtin_amdgcn_s_setprio(1); _Pragma("unroll") for (int m = 0; m < 4; ++m) _Pragma("unroll") for (int n = 0; n < 2; ++n) _Pragma("unroll") for (int k = 0; k < 2; ++k) \
        acc[ai][bj][m][n] = __builtin_amdgcn_mfma_f32_16x16x32_bf16(Bt[n][k], At[m][k], acc[ai][bj][m][n], 0, 0, 0); __builtin_amdgcn_s_setprio(0); } while (0)
#define PG8_WAIT_V(n) asm volatile("s_waitcnt vmcnt(" #n ")" ::: "memory")
#define PG8_WAIT_L(n) asm volatile("s_waitcnt lgkmcnt(" #n ")" ::: "memory")
#define PG8_BAR __builtin_amdgcn_s_barrier()
#define PG8_SCHED __builtin_amdgcn_sched_barrier(0)
    Unit cur, nxt; int ui = 0;
    if (!S.next(0, cur)) return;
    f32x4 acc[2][2][4][2];
#pragma unroll
    for (int a = 0; a < 2; ++a)
#pragma unroll
        for (int b = 0; b < 2; ++b)
#pragma unroll
            for (int m = 0; m < 4; ++m)
#pragma unroll
                for (int n = 0; n < 2; ++n) acc[a][b][m][n] = (f32x4){0.f, 0.f, 0.f, 0.f};
    bf16x8 At[4][2], B0[2][2], B1[2][2];
    const char* cA = (const char*)g.A + (size_t)cur.pm * tstep; const char* cB = (const char*)g.Bt + (size_t)cur.pn * tstep;
    S.a_ready(cur);
    if constexpr (SP2) {
        PG8_STAGE(PG8_SB(0, 0), cB, voffB); PG8_STAGE(PG8_SB(0, 1), cB + hstep, voffB); PG8_STAGE(PG8_SA(0, 0), cA, voffA); PG8_STAGE(PG8_SA(0, 1), cA + hstep, voffA);
        if (wr == 1) PG8_BAR;
        PG8_WAIT_V(2); PG8_BAR;
        PG8_STAGE(PG8_SB(1, 0), cB + kstep, voffB); PG8_STAGE(PG8_SA(1, 0), cA + kstep, voffA); PG8_STAGE(PG8_SB(1, 1), cB + hstep + kstep, voffB);
        PG8_WAIT_V(6); PG8_BAR;
    } else {
        PG8_STAGE(PG8_SB(0, 0), cB, voffB); PG8_STAGE(PG8_SA(0, 0), cA, voffA); PG8_STAGE(PG8_SB(0, 1), cB + hstep, voffB); PG8_STAGE(PG8_SA(0, 1), cA + hstep, voffA);
        if (wr == 1) PG8_BAR;
        PG8_WAIT_V(4); PG8_BAR;
        PG8_STAGE(PG8_SB(1, 0), cB + kstep, voffB); PG8_STAGE(PG8_SA(1, 0), cA + kstep, voffA); PG8_STAGE(PG8_SB(1, 1), cB + hstep + kstep, voffB);
        PG8_WAIT_V(6); PG8_BAR;
    }
    for (;;) {
        const bool has_next = S.next(ui + 1, nxt);
        const char* nA = has_next ? (const char*)g.A + (size_t)nxt.pm * tstep : cA; const char* nB = has_next ? (const char*)g.Bt + (size_t)nxt.pn * tstep : cB;
        for (int t = 0; t < nt; t += 2) {
            const bool last = (t == nt - 2);
            const char* a1 = cA + (size_t)(t + 1) * kstep;
            const char* a2 = last ? nA : cA + (size_t)(t + 2) * kstep; const char* b2 = last ? nB : cB + (size_t)(t + 2) * kstep;
            const char* a3 = a2 + kstep; const char* b3 = b2 + kstep;
            if (last && has_next) S.a_ready(nxt);
            if constexpr (SP2) {
            PG8_LDB(B0, 0, 0); PG8_LDB(B1, 0, 1); PG8_SCHED; PG8_LDA(At, 0, 0); PG8_STAGE(PG8_SA(1, 1), a1 + hstep, voffA);
            PG8_WAIT_V(8); PG8_WAIT_L(0); PG8_BAR; PG8_MMA(0, 0, At, B0); PG8_MMA(0, 1, At, B1); PG8_BAR; PG8_SCHED;
            PG8_LDA(At, 0, 1); PG8_STAGE(PG8_SB(0, 0), b2, voffB); PG8_STAGE(PG8_SB(0, 1), b2 + hstep, voffB); PG8_STAGE(PG8_SA(0, 0), a2, voffA);
            PG8_WAIT_V(8); PG8_WAIT_L(0); PG8_BAR; PG8_MMA(1, 0, At, B0); PG8_MMA(1, 1, At, B1); PG8_BAR; PG8_SCHED;
            PG8_LDB(B0, 1, 0); PG8_LDB(B1, 1, 1); PG8_SCHED; PG8_LDA(At, 1, 0); PG8_STAGE(PG8_SA(0, 1), a2 + hstep, voffA);
            PG8_WAIT_V(8); PG8_WAIT_L(0); PG8_BAR; PG8_MMA(0, 0, At, B0); PG8_MMA(0, 1, At, B1); PG8_BAR; PG8_SCHED;
            PG8_LDA(At, 1, 1); PG8_STAGE(PG8_SB(1, 0), b3, voffB); PG8_STAGE(PG8_SB(1, 1), b3 + hstep, voffB); PG8_STAGE(PG8_SA(1, 0), a3, voffA);
            PG8_WAIT_V(8); PG8_WAIT_L(0); PG8_BAR; PG8_MMA(1, 0, At, B0); PG8_MMA(1, 1, At, B1); PG8_BAR; PG8_SCHED;
            } else {
            PG8_LDB(B0, 0, 0); PG8_SCHED; PG8_LDA(At, 0, 0); PG8_STAGE(PG8_SA(1, 1), a1 + hstep, voffA);
            PG8_WAIT_L(8); PG8_BAR; PG8_WAIT_L(0); PG8_MMA(0, 0, At, B0); PG8_BAR; PG8_SCHED;
            PG8_LDB(B1, 0, 1); PG8_STAGE(PG8_SB(0, 0), b2, voffB);
            PG8_BAR; PG8_WAIT_L(0); PG8_MMA(0, 1, At, B1); PG8_BAR;
            PG8_LDA(At, 0, 1); PG8_STAGE(PG8_SA(0, 0), a2, voffA);
            PG8_BAR; PG8_WAIT_L(0); PG8_MMA(1, 0, At, B0); PG8_BAR; PG8_SCHED;
            PG8_STAGE(PG8_SB(0, 1), b2 + hstep, voffB);
            PG8_WAIT_V(6); PG8_BAR; PG8_MMA(1, 1, At, B1); PG8_BAR;
            PG8_LDB(B0, 1, 0); PG8_SCHED; PG8_LDA(At, 1, 0); PG8_STAGE(PG8_SA(0, 1), a2 + hstep, voffA);
            PG8_WAIT_L(8); PG8_BAR; PG8_WAIT_L(0); PG8_MMA(0, 0, At, B0); PG8_BAR; PG8_SCHED;
            PG8_LDB(B1, 1, 1); PG8_STAGE(PG8_SB(1, 0), b3, voffB);
            PG8_BAR; PG8_WAIT_L(0); PG8_MMA(0, 1, At, B1); PG8_BAR;
            PG8_LDA(At, 1, 1); PG8_STAGE(PG8_SA(1, 0), a3, voffA);
            PG8_BAR; PG8_WAIT_L(0); PG8_MMA(1, 0, At, B0); PG8_BAR; PG8_SCHED;
            PG8_STAGE(PG8_SB(1, 1), b3 + hstep, voffB);
            PG8_WAIT_V(6); PG8_BAR; PG8_MMA(1, 1, At, B1); PG8_BAR;
            }
        }
        if constexpr (ALIGN_EPI) { if (wr == 0) PG8_BAR; }
        if constexpr (!Epi::AFTER_DRAIN) { E(acc, cur, wr, wc, fr, fq); S.done(cur); }
        if (!has_next) break;
#pragma unroll
        for (int a = 0; a < 2; ++a)
#pragma unroll
            for (int b = 0; b < 2; ++b)
#pragma unroll
                for (int m = 0; m < 4; ++m)
#pragma unroll
                    for (int n = 0; n < 2; ++n) acc[a][b][m][n] = (f32x4){0.f, 0.f, 0.f, 0.f};
        cur = nxt; cA = nA; cB = nB; ++ui;
        if constexpr (ALIGN_EPI) { if (wr == 1) PG8_BAR; }
    }
    PG8_WAIT_V(0);
    if constexpr (!ALIGN_EPI) { if (wr == 0) PG8_BAR; }
    PG8_BAR;
    if constexpr (Epi::AFTER_DRAIN) { E.fused(acc, cur, wr, wc, fr, fq, lds, wid, lane); S.done(cur); }
#undef PG8_SA
#undef PG8_SB
#undef PG8_STAGE
#undef PG8_LDA
#undef PG8_LDB
#undef PG8_MMA
#undef PG8_WAIT_V
#undef PG8_WAIT_L
#undef PG8_BAR
#undef PG8_SCHED
}
}


typedef unsigned short bf16_t;
typedef short bf16x8 __attribute__((ext_vector_type(8)));
typedef float f32x16 __attribute__((ext_vector_type(16)));
typedef float f32x4 __attribute__((ext_vector_type(4)));
typedef float f32x2 __attribute__((ext_vector_type(2)));
typedef unsigned u32x4 __attribute__((ext_vector_type(4)));
typedef unsigned u32x2 __attribute__((ext_vector_type(2)));
typedef __bf16 bf16x2_t __attribute__((ext_vector_type(2)));
#define DI __device__ __forceinline__
#define LAS __attribute__((address_space(3)))
#define MFMA(a, b, c) __builtin_amdgcn_mfma_f32_32x32x16_bf16((a), (b), (c), 0, 0, 0)
using pg8::Unit;

constexpr int T = 32768, SEQ = 8192, NB = 4, DM = 1024, MEMT = 1024, MEML = 256;
constexpr int DFF = 2816;
constexpr int NTHR = 512, NWV = 8;
constexpr float EPS = 1e-6f;
constexpr float LOG2E = 1.4426950408889634f;
constexpr int LDS_BYTES = 147456;
constexpr int LDS_XB = 131072 + 1024;

constexpr size_t MB = 1024 * 1024;
constexpr size_t OFF_SSQ_Q = 0;
constexpr size_t OFF_SSQ_KV = OFF_SSQ_Q + T * 4;
constexpr size_t OFF_SSQ1 = OFF_SSQ_KV + T * 4;
constexpr size_t OFF_SSQ2 = OFF_SSQ1 + T * 4;
constexpr size_t OFF_SSQ3 = OFF_SSQ2 + T * 4;
constexpr size_t OFF_RSTD0 = OFF_SSQ3 + T * 4;
constexpr size_t OFF_BAR = 832 * 1024;
constexpr size_t OFF_CS = 1 * MB;
constexpr size_t OFF_WIN = 5 * MB;
constexpr size_t OFF_WV = OFF_WIN + 7 * MB;
constexpr size_t OFF_WUQ = OFF_WV + 1 * MB;
constexpr size_t OFF_WUK = OFF_WUQ + 768 * 256 * 2;
constexpr size_t OFF_WUV = OFF_WUK + 512 * 256 * 2;
constexpr size_t OFF_WA = OFF_WUV + 512 * 256 * 2;
constexpr size_t OFF_WB = OFF_WA + 1 * MB;
constexpr size_t OFF_WO = OFF_WB + 1 * MB;
constexpr size_t OFF_WXQ = OFF_WO + 2 * MB;
constexpr size_t OFF_WXKV = OFF_WXQ + 1 * MB;
constexpr size_t OFF_WXO = OFF_WXKV + 2 * MB;
constexpr size_t OFF_WGU = OFF_WXO + 1 * MB;
constexpr size_t OFF_WD = OFF_WGU + 11 * MB;
constexpr size_t OFF_MNB = OFF_WD + 6 * MB;
constexpr size_t OFF_XK = OFF_MNB + 2 * MB;
constexpr size_t OFF_XVT = OFF_XK + 1 * MB;
constexpr size_t OFF_ACT = 48 * MB;
static_assert(OFF_XVT + 1 * MB <= OFF_ACT, "ws map");
constexpr size_t OFF_XB = OFF_ACT;
constexpr size_t OFF_OA = OFF_XB;
constexpr size_t OFF_OB = OFF_XB + 32 * MB;
constexpr size_t OFF_CQ = OFF_XB + 64 * MB;
constexpr size_t OFF_CKV = OFF_CQ + 16 * MB;
constexpr size_t OFF_KA = OFF_CKV + 16 * MB;
constexpr size_t OFF_QA = OFF_KA + 48 * MB;
constexpr size_t OFF_VTA = OFF_QA + 48 * MB;
constexpr size_t OFF_SBQ = OFF_VTA + 32 * MB;
constexpr size_t OFF_SBK = OFF_SBQ + 32 * MB;
constexpr size_t OFF_VTB = OFF_SBK + 32 * MB;
constexpr size_t OFF_SIGA = OFF_VTB + 32 * MB;
constexpr size_t OFF_SIGB = OFF_SIGA + 64 * MB;
constexpr size_t WS_END = OFF_SIGB + 64 * MB;
static_assert(WS_END <= 512 * MB, "ws map");
constexpr size_t OFF_MERGED = OFF_KA;
constexpr size_t OFF_X1B = OFF_VTA;
constexpr size_t OFF_XQ = OFF_SBK;
constexpr size_t OFF_XO = OFF_VTB;
constexpr size_t OFF_X2B = OFF_SIGA;
constexpr size_t OFF_HID = OFF_KA;

struct Params {
    const float* x; const float* mem; const int* pos;
    const float* g_mix; const float* w_in; const float* b_gate; const float* g_q_lat; const float* w_uq;
    const float* g_kv_lat; const float* w_ukv; const float* w_a; const float* w_b; const float* w_o;
    const float* g_x; const float* g_mem; const float* w_xq; const float* w_xkv; const float* w_xo;
    const float* g_ffn; const float* w_gate; const float* w_up; const float* w_down; const float* g_final;
    float* out; char* ws;
};

DI unsigned pk2(float a, float b) { f32x2 v = {a, b}; bf16x2_t r = __builtin_convertvector(v, bf16x2_t); return __builtin_bit_cast(unsigned, r); }
DI bf16_t bf1(float a) { return (bf16_t)(pk2(a, 0.f) & 0xffffu); }
DI float ex2(float x) { return __builtin_amdgcn_exp2f(x); }
DI float lg2(float x) { return __builtin_amdgcn_logf(x); }
DI float shx32(float v) { return __shfl_xor(v, 32); }
DI int lane_id_fresh() { int l; asm volatile("v_mbcnt_lo_u32_b32 %0, -1, 0\n\tv_mbcnt_hi_u32_b32 %0, -1, %0" : "=v"(l)); return l; }
DI float bflo(unsigned u) { return __uint_as_float(u << 16); }
DI float bfhi(unsigned u) { return __uint_as_float(u & 0xffff0000u); }
DI void st_bf4(bf16_t* d, float a, float b, float c, float e) { u32x2 o; o.x = pk2(a, b); o.y = pk2(c, e); *(u32x2*)d = o; }
DI void st_bf8(bf16_t* d, const f32x4& a, const f32x4& b) { u32x4 o; o.x = pk2(a[0], a[1]); o.y = pk2(a[2], a[3]); o.z = pk2(b[0], b[1]); o.w = pk2(b[2], b[3]); *(u32x4*)d = o; }

struct WT { const float* src; const float* g; bf16_t* dst; int N, sc, k0, K, drow0; float scale; };
constexpr float SBQ_SCALE = LOG2E * 0.125f;
constexpr float MLAQ_SCALE = LOG2E * 0.10206207261596577f;
constexpr float XQ_SCALE = LOG2E * 0.08838834764831845f;
constexpr int J0 = 112 * 16;
constexpr int J1 = J0 + 16 * 16;
constexpr int J2 = J1 + 24 * 4;
constexpr int J3 = J2 + 16 * 4;
constexpr int J4 = J3 + 16 * 4;
constexpr int J5 = J4 + 32 * 8;
constexpr int J6 = J5 + 32 * 8;
constexpr int J7 = J6 + 32 * 16;
constexpr int J8 = J7 + 16 * 16;
constexpr int J9 = J8 + 32 * 16;
constexpr int J10 = J9 + 32 * 8;
constexpr int J11 = J10 + 176 * 16;
constexpr int J12 = J11 + 32 * 44;
DI WT wt_desc(const Params& p, int tl) {
    char* ws = p.ws; WT d; d.g = nullptr; d.scale = 1.f; d.src = p.w_in; d.dst = (bf16_t*)(ws + OFF_WIN); d.N = 4000; d.sc = -2; d.k0 = 0; d.K = 1024; d.drow0 = 0;
    if (tl >= J12) return d;
    if (tl < J0) { const int jk = tl / 112, jn = tl - jk * 112; const int d0 = jn * 32; int sc; float s = 1.f;
        if (d0 < 416) sc = d0; else if (d0 < 512) sc = -1; else if (d0 < 1536) { sc = d0 - 96; if (d0 < 1024) s = SBQ_SCALE; } else sc = d0 + 416;
        d.sc = sc; d.k0 = jk * 64; d.drow0 = d0; d.g = p.g_mix; d.scale = s; }
    else if (tl < J1) { const int u = tl - J0; const int jk = u >> 4, jn = u & 15; d.sc = 1440 + jn * 32; d.k0 = jk * 64; d.dst = (bf16_t*)(ws + OFF_WV); d.drow0 = jn * 32; d.g = p.g_mix; }
    else if (tl < J2) { const int u = tl - J1; const int jk = u / 24, jn = u - jk * 24; d.src = p.w_uq; d.N = 768; d.sc = jn * 32; d.k0 = jk * 64; d.dst = (bf16_t*)(ws + OFF_WUQ); d.K = 256; d.drow0 = jn * 32; d.g = p.g_q_lat; d.scale = MLAQ_SCALE; }
    else if (tl < J4) { const bool isv = tl >= J3; const int u = tl - (isv ? J3 : J2); const int jk = u >> 4, jn = u & 15; const int d0 = jn * 32;
        d.src = p.w_ukv; d.N = 1024; d.sc = jk < 2 ? (d0 >> 6) * 128 + (isv ? 64 : 0) + (d0 & 63) : -1; d.k0 = jk * 64; d.dst = (bf16_t*)(ws + (isv ? OFF_WUV : OFF_WUK)); d.K = 256; d.drow0 = d0; d.g = p.g_kv_lat; }
    else if (tl < J6) { const bool isb = tl >= J5; const int u = tl - (isb ? J5 : J4); const int jk = u >> 5, jn = u & 31;
        d.src = isb ? p.w_b : p.w_a; d.N = 1024; d.sc = jn * 32; d.k0 = jk * 64; d.dst = (bf16_t*)(ws + (isb ? OFF_WB : OFF_WA)); d.K = 512; d.drow0 = jn * 32; }
    else if (tl < J7) { const int u = tl - J6; const int jk = u >> 5, jn = u & 31; d.src = p.w_o; d.N = 1024; d.sc = jn * 32; d.k0 = jk * 64; d.dst = (bf16_t*)(ws + OFF_WO); d.drow0 = jn * 32; }
    else if (tl < J8) { const int u = tl - J7; const int jk = u >> 4, jn = u & 15; d.src = p.w_xq; d.N = 512; d.sc = jn * 32; d.k0 = jk * 64; d.dst = (bf16_t*)(ws + OFF_WXQ); d.drow0 = jn * 32; d.g = p.g_x; d.scale = XQ_SCALE; }
    else if (tl < J9) { const int u = tl - J8; const int jk = u >> 5, jn = u & 31; d.src = p.w_xkv; d.N = 1024; d.sc = jn * 32; d.k0 = jk * 64; d.dst = (bf16_t*)(ws + OFF_WXKV); d.drow0 = jn * 32; }
    else if (tl < J10) { const int u = tl - J9; const int jk = u >> 5, jn = u & 31; d.src = p.w_xo; d.N = 1024; d.sc = jn * 32; d.k0 = jk * 64; d.dst = (bf16_t*)(ws + OFF_WXO); d.K = 512; d.drow0 = jn * 32; }
    else if (tl < J11) { const int u = tl - J10; const int jk = u / 176, jn = u - jk * 176; const int d0 = jn * 32; const int rem = d0 & 255;
        d.src = (rem >= 128) ? p.w_up : p.w_gate; d.N = DFF; d.sc = (d0 >> 8) * 128 + (rem & 127); d.k0 = jk * 64; d.dst = (bf16_t*)(ws + OFF_WGU); d.drow0 = d0; d.g = p.g_ffn; }
    else { const int u = tl - J11; const int jk = u >> 5, jn = u & 31; d.src = p.w_down; d.N = 1024; d.sc = jn * 32; d.k0 = jk * 64; d.dst = (bf16_t*)(ws + OFF_WD); d.K = DFF; d.drow0 = jn * 32; }
    return d;
}
DI void wt_load(const WT& d, int t, float (&v)[8]) {
    const int nn = t & 31, kb = t >> 5;
#pragma unroll
    for (int i = 0; i < 8; ++i) { const int kk = kb + 8 * i; float x = 0.f;
        if (d.sc >= 0) { x = d.src[(size_t)(d.k0 + kk) * d.N + d.sc + nn] * d.scale; if (d.g) x *= d.g[d.k0 + kk]; }
        v[i] = x; }
}
DI void wt_put(float* l, int t, const float (&v)[8]) {
    const int nn = t & 31, kb = t >> 5;
#pragma unroll
    for (int i = 0; i < 8; ++i) l[(kb + 8 * i) * 33 + nn] = v[i];
}
DI void wt_store(const WT& d, int t, const float* l) {
    if (d.sc == -2) return;
    const int kk = t & 63, nb = t >> 6;
#pragma unroll
    for (int i = 0; i < 8; ++i) { const int nn = nb + 4 * i; d.dst[(size_t)(d.drow0 + nn) * d.K + d.k0 + kk] = bf1(l[kk * 33 + nn]); }
}

DI void phase0(const Params& p, char* ldsc, const int tid) {
    char* ws = p.ws;
    const int half = tid >> 8, t = tid & 255;
    float* l0 = (float*)ldsc + half * 2 * (64 * 33 + 16);
    float* l1 = l0 + (64 * 33 + 16);
    for (int base = blockIdx.x * 4; base < J12; base += gridDim.x * 4) {
        const WT d0 = wt_desc(p, base + half * 2), d1 = wt_desc(p, base + half * 2 + 1);
        float v0[8], v1[8];
        wt_load(d0, t, v0); wt_load(d1, t, v1);
        wt_put(l0, t, v0); wt_put(l1, t, v1);
        __syncthreads();
        wt_store(d0, t, l0); wt_store(d1, t, l1);
        __syncthreads();
    }
    {
        float* z = (float*)(ws + OFF_SSQ_Q);
        for (int i = blockIdx.x * NTHR + tid; i < 5 * T; i += gridDim.x * NTHR) z[i] = 0.f;
    }
    const int lane = tid & 63, w = tid >> 6;
    for (int row0 = (blockIdx.x * NWV + w) * 4; row0 < T + MEMT; row0 += gridDim.x * NWV * 4) {
        f32x4 v[4][4];
#pragma unroll
        for (int r = 0; r < 4; ++r) { const int row = row0 + r; const float* src = row >= T ? p.mem + (size_t)(row - T) * DM : p.x + (size_t)row * DM;
#pragma unroll
            for (int i = 0; i < 4; ++i) v[r][i] = *(const f32x4*)(src + i * 256 + lane * 4); }
#pragma unroll
        for (int r = 0; r < 4; ++r) {
            const int row = row0 + r; const bool ismem = row >= T;
            float ss = 0.f;
#pragma unroll
            for (int i = 0; i < 4; ++i) ss += v[r][i][0] * v[r][i][0] + v[r][i][1] * v[r][i][1] + v[r][i][2] * v[r][i][2] + v[r][i][3] * v[r][i][3];
#pragma unroll
            for (int o = 32; o >= 1; o >>= 1) ss += __shfl_xor(ss, o);
            const float rstd = rsqrtf(ss * (1.0f / DM) + EPS);
            if (!ismem) {
                bf16_t* d = (bf16_t*)(ws + OFF_XB) + (size_t)row * DM;
#pragma unroll
                for (int i = 0; i < 4; ++i) st_bf4(d + i * 256 + lane * 4, v[r][i][0], v[r][i][1], v[r][i][2], v[r][i][3]);
                if (lane == 0) ((float*)(ws + OFF_RSTD0))[row] = rstd;
                if (lane < 16) {
                    const float invf = exp2f(-(float)(2 * lane) * (13.287712379549449f / 32.0f));
                    const float ang = (float)p.pos[row] * invf;
                    const double a = (double)ang; const double kq = rint(a * 0.15915494309189535); const float rr = (float)(a - kq * 6.283185307179586);
                    f32x2 cs; cs.x = __cosf(rr); cs.y = __sinf(rr);
                    ((f32x2*)(ws + OFF_CS))[(size_t)row * 16 + lane] = cs;
                }
            } else {
                bf16_t* d = (bf16_t*)(ws + OFF_MNB) + (size_t)(row - T) * DM;
#pragma unroll
                for (int i = 0; i < 4; ++i) { const f32x4 g = *(const f32x4*)(p.g_mem + i * 256 + lane * 4);
                    st_bf4(d + i * 256 + lane * 4, v[r][i][0] * rstd * g[0], v[r][i][1] * rstd * g[1], v[r][i][2] * rstd * g[2], v[r][i][3] * rstd * g[3]); }
            }
        }
    }
}

typedef f32x4 Acc[2][2][4][2];
DI float sq4(const f32x4& v) { return v[0] * v[0] + v[1] * v[1] + v[2] * v[2] + v[3] * v[3]; }
DI float red_fq(float s) { s += __shfl_xor(s, 16); s += __shfl_xor(s, 32); return s; }
DI float sigm(float z) { return __builtin_amdgcn_rcpf(1.f + ex2(-z * LOG2E)); }

struct Epi1 {
    static constexpr bool PERM = false, AFTER_DRAIN = false;
    char* ws; const float* b_gate;
    DI void operator()(const Acc& acc, const Unit& u, int wr, int wc, int fr, int fq) const {
        const int pn = u.pn;
        const float* rstd0 = (const float*)(ws + OFF_RSTD0);
#pragma unroll
        for (int ai = 0; ai < 2; ++ai)
#pragma unroll
            for (int m = 0; m < 4; ++m) {
                const int tok = u.pm * 256 + ai * 128 + wr * 64 + m * 16 + fr;
                const float rs = rstd0[tok];
                if (pn <= 1) {
                    bf16_t* d = (bf16_t*)(ws + (pn == 0 ? OFF_CQ : OFF_CKV)) + (size_t)tok * 256 + wc * 32 + fq * 4;
                    float ssq = 0.f;
#pragma unroll
                    for (int bj = 0; bj < 2; ++bj)
#pragma unroll
                        for (int n = 0; n < 2; ++n) { const f32x4 v = acc[ai][bj][m][n] * rs; if (pn == 0 || bj == 0) ssq += sq4(v); st_bf4(d + bj * 128 + n * 16, v[0], v[1], v[2], v[3]); }
                    ssq = red_fq(ssq);
                    if (fq == 0) atomicAdd((float*)(ws + (pn == 0 ? OFF_SSQ_Q : OFF_SSQ_KV)) + tok, ssq);
                    if (pn == 1 && wc == 0) {
                        const f32x4 c01 = *(const f32x4*)(ws + OFF_CS + ((size_t)tok * 16 + fq * 4) * 8), c23 = *(const f32x4*)(ws + OFF_CS + ((size_t)tok * 16 + fq * 4 + 2) * 8);
                        const f32x4 x1 = acc[ai][1][m][0] * rs, x2 = acc[ai][1][m][1] * rs;
                        const float cs_[4] = {c01[0], c01[2], c23[0], c23[2]}, sn_[4] = {c01[1], c01[3], c23[1], c23[3]};
                        float lo[4], hi[4];
#pragma unroll
                        for (int j = 0; j < 4; ++j) { lo[j] = x1[j] * cs_[j] - x2[j] * sn_[j]; hi[j] = x2[j] * cs_[j] + x1[j] * sn_[j]; }
                        bf16_t* k = (bf16_t*)(ws + OFF_KA) + (size_t)tok * 768 + 64 + fq * 4;
#pragma unroll
                        for (int h = 0; h < 8; ++h) { st_bf4(k + h * 96, lo[0], lo[1], lo[2], lo[3]); st_bf4(k + h * 96 + 16, hi[0], hi[1], hi[2], hi[3]); }
                    }
                } else if (pn < 6) {
                    bf16_t* d = (bf16_t*)(ws + (pn < 4 ? OFF_SBQ : OFF_SBK)) + (size_t)tok * 512 + ((pn & 1) * 256) + wc * 32 + fq * 4;
#pragma unroll
                    for (int bj = 0; bj < 2; ++bj)
#pragma unroll
                        for (int n = 0; n < 2; ++n) { const f32x4 v = acc[ai][bj][m][n] * rs; st_bf4(d + bj * 128 + n * 16, v[0], v[1], v[2], v[3]); }
                } else {
                    const int gi = pn >= 10; const int c0 = (pn - (gi ? 10 : 6)) * 256 + wc * 32 + fq * 4;
                    bf16_t* d = (bf16_t*)(ws + (gi ? OFF_SIGB : OFF_SIGA)) + (size_t)tok * DM + c0;
                    const float* bg = b_gate + gi * DM + c0;
#pragma unroll
                    for (int bj = 0; bj < 2; ++bj)
#pragma unroll
                        for (int n = 0; n < 2; ++n) { const f32x4 bb = *(const f32x4*)(bg + bj * 128 + n * 16); const f32x4 v = acc[ai][bj][m][n] * rs + bb;
                            st_bf4(d + bj * 128 + n * 16, sigm(v[0]), sigm(v[1]), sigm(v[2]), sigm(v[3])); }
                }
            }
    }
};

struct EpiGate {
    static constexpr bool PERM = true, AFTER_DRAIN = false;
    char* ws; const float* b_gate;
    DI void operator()(const Acc& acc, const Unit& u, int wr, int wc, int fr, int fq) const {
        const float* rstd0 = (const float*)(ws + OFF_RSTD0);
        const int gi = u.pn >= 4; const int cb = (u.pn & 3) * 256 + wc * 32 + fq * 8;
        bf16_t* outp = (bf16_t*)(ws + (gi ? OFF_SIGB : OFF_SIGA));
#pragma unroll
        for (int bj = 0; bj < 2; ++bj) {
            const int c0 = cb + bj * 128;
            const f32x4 b0 = *(const f32x4*)(b_gate + gi * DM + c0), b1 = *(const f32x4*)(b_gate + gi * DM + c0 + 4);
#pragma unroll
            for (int ai = 0; ai < 2; ++ai)
#pragma unroll
                for (int m = 0; m < 4; ++m) {
                    const int tok = u.pm * 256 + ai * 128 + wr * 64 + m * 16 + fr;
                    const float rs = rstd0[tok];
                    f32x4 a = acc[ai][bj][m][0] * rs + b0, b = acc[ai][bj][m][1] * rs + b1;
#pragma unroll
                    for (int j = 0; j < 4; ++j) { a[j] = sigm(a[j]); b[j] = sigm(b[j]); }
                    st_bf8(outp + (size_t)tok * DM + c0, a, b);
                }
        }
    }
};

template <int SMODE>
struct EpiVt {
    static constexpr bool PERM = true, AFTER_DRAIN = false;
    bf16_t* out; int ldo; const float* sc;
    DI void operator()(const Acc& acc, const Unit& u, int wr, int wc, int fr, int fq) const {
#pragma unroll
        for (int bj = 0; bj < 2; ++bj) {
            const int col = u.pn * 256 + bj * 128 + wc * 32 + fq * 8;
#pragma unroll
            for (int ai = 0; ai < 2; ++ai)
#pragma unroll
                for (int m = 0; m < 4; ++m) { const int row = u.pm * 256 + ai * 128 + wr * 64 + m * 16 + fr;
                    f32x4 a = acc[ai][bj][m][0], b = acc[ai][bj][m][1];
                    if (SMODE >= 1) { f32x4 s0 = *(const f32x4*)(sc + col), s1 = *(const f32x4*)(sc + col + 4);
                        if (SMODE == 2) {
#pragma unroll
                            for (int j = 0; j < 4; ++j) { s0[j] = rsqrtf(s0[j] * (1.0f / 128.0f) + EPS); s1[j] = rsqrtf(s1[j] * (1.0f / 128.0f) + EPS); }
                        }
                        a *= s0; b *= s1; }
                    st_bf8(out + (size_t)row * ldo + col, a, b); }
        }
    }
};

struct Epi2q {
    static constexpr bool PERM = false, AFTER_DRAIN = false;
    char* ws;
    DI void operator()(const Acc& acc, const Unit& u, int wr, int wc, int fr, int fq) const {
#pragma unroll
        for (int ai = 0; ai < 2; ++ai)
#pragma unroll
            for (int m = 0; m < 4; ++m) {
                const int tok = u.pm * 256 + ai * 128 + wr * 64 + m * 16 + fr;
                const float rs = rsqrtf(((const float*)(ws + OFF_SSQ_Q))[tok] * (1.0f / 256.0f) + EPS);
#pragma unroll
                for (int bj = 0; bj < 2; ++bj) {
                    const int cg0 = u.pn * 256 + bj * 128 + wc * 32;
                    bf16_t* d = (bf16_t*)(ws + OFF_QA) + (size_t)tok * 768 + cg0 + fq * 4;
                    const f32x4 x1 = acc[ai][bj][m][0] * rs, x2 = acc[ai][bj][m][1] * rs;
                    if (((cg0 >> 5) % 3) == 2) {
                        const f32x4 c01 = *(const f32x4*)(ws + OFF_CS + ((size_t)tok * 16 + fq * 4) * 8), c23 = *(const f32x4*)(ws + OFF_CS + ((size_t)tok * 16 + fq * 4 + 2) * 8);
                        const float cs_[4] = {c01[0], c01[2], c23[0], c23[2]}, sn_[4] = {c01[1], c01[3], c23[1], c23[3]};
                        float lo[4], hi[4];
#pragma unroll
                        for (int j = 0; j < 4; ++j) { lo[j] = x1[j] * cs_[j] - x2[j] * sn_[j]; hi[j] = x2[j] * cs_[j] + x1[j] * sn_[j]; }
                        st_bf4(d, lo[0], lo[1], lo[2], lo[3]); st_bf4(d + 16, hi[0], hi[1], hi[2], hi[3]);
                    } else { st_bf4(d, x1[0], x1[1], x1[2], x1[3]); st_bf4(d + 16, x2[0], x2[1], x2[2], x2[3]); }
                }
            }
    }
};

template <int RMODE  , bool KA  >
struct EpiBf {
    static constexpr bool PERM = true, AFTER_DRAIN = false;
    bf16_t* out; int ldo; const float* ssq;
    DI void operator()(const Acc& acc, const Unit& u, int wr, int wc, int fr, int fq) const {
#pragma unroll
        for (int ai = 0; ai < 2; ++ai)
#pragma unroll
            for (int m = 0; m < 4; ++m) {
                const int tok = u.pm * 256 + ai * 128 + wr * 64 + m * 16 + fr;
                float rs = 1.f;
                if (RMODE == 1) rs = rsqrtf(ssq[tok] * (1.0f / 1024.0f) + EPS);
                if (RMODE == 2) rs = rsqrtf(ssq[tok] * (1.0f / 128.0f) + EPS);
#pragma unroll
                for (int bj = 0; bj < 2; ++bj) { int col = u.pn * 256 + bj * 128 + wc * 32 + fq * 8; if (KA) col = (col >> 6) * 96 + (col & 63);
                    st_bf8(out + (size_t)tok * ldo + col, acc[ai][bj][m][0] * rs, acc[ai][bj][m][1] * rs); }
            }
    }
};

template <int STEP>
struct Epi4 {
    static constexpr bool PERM = true, AFTER_DRAIN = false;
    const bf16_t* sig; bf16_t* ta; bf16_t* merged;
    DI void operator()(const Acc& acc, const Unit& u, int wr, int wc, int fr, int fq) const {
#pragma unroll
        for (int ai = 0; ai < 2; ++ai)
#pragma unroll
            for (int m = 0; m < 4; ++m) {
                const int tok = u.pm * 256 + ai * 128 + wr * 64 + m * 16 + fr;
#pragma unroll
                for (int bj = 0; bj < 2; ++bj) { const size_t off = (size_t)tok * DM + u.pn * 256 + bj * 128 + wc * 32 + fq * 8;
                    const u32x4 sg = *(const u32x4*)(sig + off);
                    f32x4 a = acc[ai][bj][m][0], b = acc[ai][bj][m][1];
                    a[0] *= bflo(sg.x); a[1] *= bfhi(sg.x); a[2] *= bflo(sg.y); a[3] *= bfhi(sg.y); b[0] *= bflo(sg.z); b[1] *= bfhi(sg.z); b[2] *= bflo(sg.w); b[3] *= bfhi(sg.w);
                    if (STEP == 0) st_bf8(ta + off, a, b);
                    else { const u32x4 tv = *(const u32x4*)(ta + off); a[0] += bflo(tv.x); a[1] += bfhi(tv.x); a[2] += bflo(tv.y); a[3] += bfhi(tv.y); b[0] += bflo(tv.z); b[1] += bfhi(tv.z); b[2] += bflo(tv.w); b[3] += bfhi(tv.w); st_bf8(merged + off, a, b); } }
            }
    }
};

struct EpiRes {
    static constexpr bool PERM = true, AFTER_DRAIN = false;
    const float* res; float* out; bf16_t* outb; float* ssq;
    DI void operator()(const Acc& acc, const Unit& u, int wr, int wc, int fr, int fq) const {
#pragma unroll
        for (int ai = 0; ai < 2; ++ai)
#pragma unroll
            for (int m = 0; m < 4; ++m) {
                const int tok = u.pm * 256 + ai * 128 + wr * 64 + m * 16 + fr; float s = 0.f;
#pragma unroll
                for (int bj = 0; bj < 2; ++bj) { const size_t off = (size_t)tok * DM + u.pn * 256 + bj * 128 + wc * 32 + fq * 8;
                    const f32x4 a = *(const f32x4*)(res + off) + acc[ai][bj][m][0], b = *(const f32x4*)(res + off + 4) + acc[ai][bj][m][1];
                    s += sq4(a) + sq4(b);
                    *(f32x4*)(out + off) = a; *(f32x4*)(out + off + 4) = b;
                    if (outb) st_bf8(outb + off, a, b); }
                s = red_fq(s);
                if (fq == 0) atomicAdd(ssq + tok, s);
            }
    }
};

struct Epi9 {
    static constexpr bool PERM = true, AFTER_DRAIN = false;
    bf16_t* hid; const float* ssq;
    DI void operator()(const Acc& acc, const Unit& u, int wr, int wc, int fr, int fq) const {
#pragma unroll
        for (int ai = 0; ai < 2; ++ai)
#pragma unroll
            for (int m = 0; m < 4; ++m) {
                const int tok = u.pm * 256 + ai * 128 + wr * 64 + m * 16 + fr;
                const float rs = rsqrtf(ssq[tok] * (1.0f / 1024.0f) + EPS);
                f32x4 o[2];
#pragma unroll
                for (int n = 0; n < 2; ++n)
#pragma unroll
                    for (int j = 0; j < 4; ++j) { const float g = acc[ai][0][m][n][j] * rs, uu = acc[ai][1][m][n][j] * rs; o[n][j] = g * sigm(g) * uu; }
                st_bf8(hid + (size_t)tok * DFF + u.pn * 128 + wc * 32 + fq * 8, o[0], o[1]);
            }
    }
};

template <class Epi>
DI void run_gemm_at(LAS unsigned char* L, const int tid, int first, const bf16_t* A, const bf16_t* Bt, int M, int N, int K, const Epi& E) {
    pg8::Gemm g{A, Bt, M, N, K}; pg8::StaticOrder S; S.init(M, N, (int)gridDim.x, (int)((blockIdx.x + gridDim.x - first) % gridDim.x));
    pg8::gemm_phase<Epi, pg8::StaticOrder, true, true>(L, g, S, E, tid);
}
template <class Epi>
DI void run_gemm(LAS unsigned char* L, const int tid, const bf16_t* A, const bf16_t* Bt, int M, int N, int K, const Epi& E) {
    pg8::Gemm g{A, Bt, M, N, K}; pg8::StaticOrder S; S.init(M, N, (int)gridDim.x, (int)blockIdx.x);
    pg8::gemm_phase<Epi, pg8::StaticOrder, true, true>(L, g, S, E, tid);
}

template <int DQK> DI int ksw(int row, int c) { return DQK == 64 ? (c ^ ((row >> 1) & 7)) : DQK == 96 ? (c ^ ((row >> 2) & 3)) : (c ^ (row & 15)); }

template <int DQK, int DV, int MODE>
DI void attn_block(const bf16_t* __restrict__ Q, int ldq, const bf16_t* __restrict__ Kp, int ldk, const bf16_t* __restrict__ Vt, int ldv,
                   bf16_t* __restrict__ O, int ldo, int q0, int ntiles, char* lds, const int tid) {
    constexpr int NCK = DQK / 8, KB = 64 * DQK * 2, VB = DV * 128, STG = KB + VB, NKC = 64 * NCK, NKL = (NKC + NTHR - 1) / NTHR, NVL = DV * 8 / NTHR, NKK = DQK / 16, NDT = DV / 32;
    const int t = tid, lane = t & 63, w = t >> 6, fr = lane & 31, fh = lane >> 5;
    const int qrow = q0 + w * 32 + fr;
    const int qlo = q0 + w * 32, qhi = qlo + 31;
    unsigned* flags = (unsigned*)(lds + 2 * STG);
    bf16x8 qf[NKK];
#pragma unroll
    for (int kk = 0; kk < NKK; ++kk) qf[kk] = *(const bf16x8*)(Q + (size_t)qrow * ldq + kk * 16 + fh * 8);
    f32x16 o[NDT];
#pragma unroll
    for (int d = 0; d < NDT; ++d)
#pragma unroll
        for (int r = 0; r < 16; ++r) o[d][r] = 0.f;
    float l_run = 0.f;
    f32x16 negm;
#pragma unroll
    for (int r = 0; r < 16; ++r) negm[r] = 0.f;
    bool first = true;
    float m_run = -1e30f;
    u32x4 rk[NKL], rv[NVL];
    auto gload = [&](int kt) {
        const int key0 = kt * 64;
#pragma unroll
        for (int i = 0; i < NKL; ++i) { const int id = t + NTHR * i; if (NKC % NTHR == 0 || id < NKC) { const int row = id / NCK, c = id - row * NCK; rk[i] = *(const u32x4*)(Kp + (size_t)(key0 + row) * ldk + c * 8); } }
#pragma unroll
        for (int i = 0; i < NVL; ++i) { const int id = t + NTHR * i; const int row = id >> 3, c = id & 7; rv[i] = *(const u32x4*)(Vt + (size_t)row * ldv + key0 + c * 8); }
    };
    auto sstore = [&](char* buf) {
#pragma unroll
        for (int i = 0; i < NKL; ++i) { const int id = t + NTHR * i; if (NKC % NTHR == 0 || id < NKC) { const int row = id / NCK, c = id - row * NCK; *(u32x4*)(buf + row * (DQK * 2) + (ksw<DQK>(row, c) << 4)) = rk[i]; } }
#pragma unroll
        for (int i = 0; i < NVL; ++i) { const int id = t + NTHR * i; const int row = id >> 3, c = id & 7; const int g2 = (c >> 1) * 2, a = c & 1, sw = (row >> 1) & 7;
            char* rb_ = buf + KB + row * 128 + a * 8;
            u32x2 lo2, hi2; lo2.x = rv[i].x; lo2.y = rv[i].y; hi2.x = rv[i].z; hi2.y = rv[i].w;
            *(u32x2*)(rb_ + ((g2 ^ sw) << 4)) = lo2; *(u32x2*)(rb_ + (((g2 + 1) ^ sw) << 4)) = hi2; }
    };
    auto tile_of = [&](int it) { return MODE == 1 ? (ntiles - 1 - it) : it; };
    gload(tile_of(0)); sstore(lds); __syncthreads();
    for (int it = 0; it < ntiles; ++it) {
        const int kt = tile_of(it), key0 = kt * 64;
        const char* buf = lds + (it & 1) * STG;
        const bool more = it + 1 < ntiles;
        if (more && MODE != 2) gload(tile_of(it + 1));
        bool active;
        if (MODE == 0) active = key0 <= qhi; else if (MODE == 1) active = key0 < qhi && !(__all(l_run > 152.f) != 0); else active = true;
        if (active) {
            f32x16 s[2];
            if (MODE != 0) {
#pragma unroll
                for (int mt = 0; mt < 2; ++mt)
#pragma unroll
                    for (int r = 0; r < 16; ++r) s[mt][r] = 0.f;
            }
#pragma unroll
            for (int kk = 0; kk < NKK; ++kk)
#pragma unroll
                for (int mt = 0; mt < 2; ++mt) { const int row = mt * 32 + fr; const bf16x8 kf = *(const bf16x8*)(buf + row * (DQK * 2) + (ksw<DQK>(row, kk * 2 + fh) << 4));
                    if (MODE == 0 && kk == 0) s[mt] = MFMA(kf, qf[kk], negm); else s[mt] = MFMA(kf, qf[kk], s[mt]); }
            bf16x8 pf[4];
            if (MODE != 1) {
                if (MODE == 0 && key0 + 63 > qlo) {
#pragma unroll
                    for (int mt = 0; mt < 2; ++mt)
#pragma unroll
                        for (int r = 0; r < 16; ++r) { const int key = key0 + mt * 32 + (r >> 2) * 8 + fh * 4 + (r & 3); if (key > qrow) s[mt][r] = -1e30f; }
                }
                float mx = s[0][0];
#pragma unroll
                for (int mt = 0; mt < 2; ++mt)
#pragma unroll
                    for (int r = 0; r < 16; ++r) mx = fmaxf(mx, s[mt][r]);
                mx = fmaxf(mx, shx32(mx));
                if (MODE == 2) {
                    if (__any(mx > m_run + 8.f)) {
                        const float mnew = fmaxf(m_run, mx); const float alpha = ex2(m_run - mnew); m_run = mnew; l_run *= alpha;
#pragma unroll
                        for (int d = 0; d < NDT; ++d)
#pragma unroll
                            for (int r = 0; r < 16; ++r) o[d][r] *= alpha;
                    }
#pragma unroll
                    for (int mt = 0; mt < 2; ++mt)
#pragma unroll
                        for (int r = 0; r < 16; ++r) s[mt][r] -= m_run;
                } else
                if (first || __any(mx > 8.f)) {
                    const float delta = first ? mx : fmaxf(mx, 0.f); const float alpha = first ? 1.f : ex2(-delta); l_run *= alpha; first = false;
#pragma unroll
                    for (int d = 0; d < NDT; ++d)
#pragma unroll
                        for (int r = 0; r < 16; ++r) o[d][r] *= alpha;
#pragma unroll
                    for (int mt = 0; mt < 2; ++mt)
#pragma unroll
                        for (int r = 0; r < 16; ++r) s[mt][r] -= delta;
#pragma unroll
                    for (int r = 0; r < 16; ++r) negm[r] -= delta;
                }
                float sum = 0.f;
#pragma unroll
                for (int mt = 0; mt < 2; ++mt)
#pragma unroll
                    for (int r = 0; r < 16; ++r) { const float pv = ex2(s[mt][r]); s[mt][r] = pv; sum += pv; }
                l_run += sum;
            } else {
                const bool diag = key0 + 63 >= qlo;
                float G[8];
#pragma unroll
                for (int mt = 0; mt < 2; ++mt)
#pragma unroll
                    for (int rg = 0; rg < 4; ++rg) {
                        float g = 0.f;
#pragma unroll
                        for (int j = 3; j >= 0; --j) { const int r = rg * 4 + j; const float z = s[mt][r];
                            const float wv = lg2(1.f + ex2(-fabsf(z)));
                            float nlom = fmaxf(z, 0.f) + wv; float nl = nlom - z;
                            if (diag) { const int key = key0 + mt * 32 + rg * 8 + fh * 4 + j; if (key >= qrow) { nlom = 0.f; nl = 1e30f; } }
                            s[mt][r] = nl + g; g += nlom; }
                        G[mt * 4 + rg] = g;
                    }
                float base[8]; float run = l_run;
#pragma unroll
                for (int oc = 7; oc >= 0; --oc) { const float gp = shx32(G[oc]); base[oc] = run + (fh == 0 ? gp : 0.f); run += G[oc] + gp; }
                l_run = run;
#pragma unroll
                for (int mt = 0; mt < 2; ++mt)
#pragma unroll
                    for (int r = 0; r < 16; ++r) s[mt][r] = ex2(-(s[mt][r] + base[mt * 4 + (r >> 2)]));
            }
#pragma unroll
            for (int s4 = 0; s4 < 4; ++s4) { u32x4 pk; const int mt = s4 >> 1, rb = (s4 & 1) * 8;
                pk.x = pk2(s[mt][rb], s[mt][rb + 1]); pk.y = pk2(s[mt][rb + 2], s[mt][rb + 3]); pk.z = pk2(s[mt][rb + 4], s[mt][rb + 5]); pk.w = pk2(s[mt][rb + 6], s[mt][rb + 7]);
                pf[s4] = __builtin_bit_cast(bf16x8, pk); }
#pragma unroll
            for (int s4 = 0; s4 < 4; ++s4)
#pragma unroll
                for (int d = 0; d < NDT; ++d) { const int row = d * 32 + fr; const bf16x8 vf = *(const bf16x8*)(buf + KB + row * 128 + (((s4 * 2 + fh) ^ ((row >> 1) & 7)) << 4)); o[d] = MFMA(vf, pf[s4], o[d]); }
        }
        if (more) { if (MODE == 2) gload(tile_of(it + 1)); sstore(lds + ((it + 1) & 1) * STG); }
        if (MODE == 1) {
            const bool fin = __all(l_run > 152.f) != 0;
            if (lane == 0) flags[(it & 1) * NWV + w] = fin ? 1u : 0u;
            __syncthreads();
            const unsigned* f = flags + (it & 1) * NWV;
            if ((f[0] & f[1] & f[2] & f[3] & f[4] & f[5] & f[6] & f[7]) != 0u) break;
        } else {
            __syncthreads();
        }
    }
    float inv = 1.f;
    if (MODE != 1) { const float lt = l_run + shx32(l_run); inv = 1.f / lt; }
#pragma unroll
    for (int d = 0; d < NDT; ++d)
#pragma unroll
        for (int rg = 0; rg < 4; ++rg) st_bf4(O + (size_t)qrow * ldo + d * 32 + rg * 8 + fh * 4, o[d][rg * 4] * inv, o[d][rg * 4 + 1] * inv, o[d][rg * 4 + 2] * inv, o[d][rg * 4 + 3] * inv);
}

DI void phase3(const Params& p, char* lds, const int tid) {
    char* ws = p.ws;
    constexpr int NMLA = 32 * 16, NSB = 32 * 32;
    for (int u = blockIdx.x; u < NMLA + NSB; u += gridDim.x) {
        if (u < NMLA) {
            const int xcd = u & 7, v = u >> 3; const int pr = v & 15, bh = (v >> 4) * 8 + xcd; const int b = bh >> 3, h = bh & 7;
            const bf16_t* Q = (const bf16_t*)(ws + OFF_QA) + (size_t)b * SEQ * 768 + h * 96;
            const bf16_t* Kp = (const bf16_t*)(ws + OFF_KA) + (size_t)b * SEQ * 768 + h * 96;
            const bf16_t* Vt = (const bf16_t*)(ws + OFF_VTA) + (size_t)(h * 64) * T + (size_t)b * SEQ;
            bf16_t* O = (bf16_t*)(ws + OFF_OA) + (size_t)b * SEQ * 512 + h * 64;
#pragma unroll 1
            for (int half = 0; half < 2; ++half) { const int qb = half ? pr : 31 - pr;
                attn_block<96, 64, 0>(Q, 768, Kp, 768, Vt, T, O, 512, qb * 256, 4 * qb + 4, lds, tid); }
        } else {
            const int uu = u - NMLA; const int xcd = uu & 7, v = uu >> 3; const int qb = v & 31, bh = (v >> 5) * 8 + xcd; const int b = bh >> 3, h = bh & 7;
            const bf16_t* Q = (const bf16_t*)(ws + OFF_SBQ) + (size_t)b * SEQ * 512 + h * 64;
            const bf16_t* Kp = (const bf16_t*)(ws + OFF_SBK) + (size_t)b * SEQ * 512 + h * 64;
            const bf16_t* Vt = (const bf16_t*)(ws + OFF_VTB) + (size_t)(h * 64) * T + (size_t)b * SEQ;
            bf16_t* O = (bf16_t*)(ws + OFF_OB) + (size_t)b * SEQ * 512 + h * 64;
            attn_block<64, 64, 1>(Q, 512, Kp, 512, Vt, T, O, 512, qb * 256, 4 * qb + 4, lds, tid);
        }
    }
}

DI void phase7(const Params& p, char* lds, const int tid) {
    char* ws = p.ws;
    for (int u = blockIdx.x; u < 16 * 32; u += gridDim.x) {
        const int xcd = u & 7, v = u >> 3; const int qb = v & 31, bh = (v >> 5) * 8 + xcd; const int b = bh >> 2, h = bh & 3;
        const bf16_t* Q = (const bf16_t*)(ws + OFF_XQ) + (size_t)b * SEQ * 512 + h * 128;
        const bf16_t* Kp = (const bf16_t*)(ws + OFF_XK) + (size_t)b * MEML * 512 + h * 128;
        const bf16_t* Vt = (const bf16_t*)(ws + OFF_XVT) + (size_t)(h * 128) * MEMT + (size_t)b * MEML;
        bf16_t* O = (bf16_t*)(ws + OFF_XO) + (size_t)b * SEQ * 512 + h * 128;
        attn_block<128, 128, 2>(Q, 512, Kp, 512, Vt, MEMT, O, 512, qb * 256, 4, lds, tid);
    }
}

DI void phase11(const Params& p, const int tid) {
    const float* ssq3 = (const float*)(p.ws + OFF_SSQ3);
    for (size_t i = (size_t)blockIdx.x * NTHR + tid; i < (size_t)T * DM / 4; i += (size_t)gridDim.x * NTHR) {
        const int tok = (int)(i >> 8), c = (int)(i & 255) * 4;
        const float rs = rsqrtf(ssq3[tok] * (1.0f / DM) + EPS);
        f32x4 v = *(f32x4*)(p.out + i * 4); const f32x4 g = *(const f32x4*)(p.g_final + c);
        v[0] *= rs * g[0]; v[1] *= rs * g[1]; v[2] *= rs * g[2]; v[3] *= rs * g[3];
        *(f32x4*)(p.out + i * 4) = v;
    }
}

#define XB_TMO      128
#define XB_XCNT(j)  (256  + 64 * (j))
#define XB_XSUB(j)  (1280 + 64 * (j))
#define XB_XGEN(j)  (2304 + 64 * (j))
#define XB_TOP      3328
#define XB_TOPGEN   3392
#define XCD_BAR_WORDS 3456
#define XB_SPIN_CAP (1u << 22)
DI unsigned xb_ld(unsigned* p) { return __hip_atomic_load(p, __ATOMIC_RELAXED, __HIP_MEMORY_SCOPE_AGENT); }
DI unsigned xb_add(unsigned* p, unsigned v) { return __hip_atomic_fetch_add(p, v, __ATOMIC_RELAXED, __HIP_MEMORY_SCOPE_AGENT); }
DI unsigned xb_xcc_id() { return (unsigned)__builtin_amdgcn_s_getreg((3 << 11) | 20) & 0xFu; }
#define XB_SPIN(cond, bar) do { unsigned _sp = 0; while (cond) { __builtin_amdgcn_s_sleep(1); \
    if ((++_sp & 255u) == 0u) { if (xb_ld(&(bar)[XB_TMO])) break; if (_sp > XB_SPIN_CAP) { atomicAdd(&(bar)[XB_TMO], 1u); break; } } } } while (0)
struct XcdBarrier { unsigned* bar; unsigned x; volatile LAS unsigned* st; };
DI XcdBarrier xcd_barrier_post(unsigned* bar, volatile LAS unsigned* st, const int tid) {
    XcdBarrier b; b.bar = bar; b.x = xb_xcc_id(); b.st = st;
    if (tid == 0) (void)xb_add(&bar[XB_XCNT(b.x)], 1u);
    return b;
}
DI void xcd_barrier_complete(unsigned* bar, unsigned x, unsigned& nloc, unsigned& nx) {
    const unsigned G = gridDim.x * gridDim.y * gridDim.z;
    unsigned sum, cnt, mine, sp = 0u;
    for (;;) {
        sum = 0u; cnt = 0u; mine = 0u;
#pragma unroll
        for (unsigned j = 0; j < 16; ++j) { const unsigned c = xb_ld(&bar[XB_XCNT(j)]); sum += c; cnt += (c > 0u) ? 1u : 0u; mine = (j == x) ? c : mine; }
        if (sum == G) break;
        __builtin_amdgcn_s_sleep(1);
        if ((++sp & 255u) == 0u) { if (xb_ld(&bar[XB_TMO])) break; if (sp > XB_SPIN_CAP) { atomicAdd(&bar[XB_TMO], 1u); break; } }
    }
    nloc = mine > 0u ? mine : 1u; nx = cnt > 0u ? cnt : 1u;
}
DI void xcd_barrier(const XcdBarrier& b, const int tid) {
    asm volatile("s_waitcnt vmcnt(0)" ::: "memory");
    __syncthreads();
    if (tid == 0) {
        unsigned* bar = b.bar;
        __builtin_amdgcn_s_waitcnt(0);
        unsigned nloc = b.st[0], nx = b.st[1];
        if (nloc == 0u) { xcd_barrier_complete(bar, b.x, nloc, nx); b.st[0] = nloc; b.st[1] = nx; }
        const unsigned old = xb_add(&bar[XB_XSUB(b.x)], 1u);
        const unsigned gen = old / nloc;
        if (old + 1u == (gen + 1u) * nloc) {
            __builtin_amdgcn_fence(__ATOMIC_RELEASE, "agent");
            asm volatile("s_waitcnt vmcnt(0)" ::: "memory");
            const unsigned og = xb_add(&bar[XB_TOP], 1u);
            const unsigned tg = og / nx;
            if (og + 1u == (tg + 1u) * nx) xb_add(&bar[XB_TOPGEN], 1u);
            else XB_SPIN(xb_ld(&bar[XB_TOPGEN]) == tg, bar);
            __builtin_amdgcn_fence(__ATOMIC_ACQUIRE, "agent");
            xb_add(&bar[XB_XGEN(b.x)], 1u);
            asm volatile("s_waitcnt vmcnt(0)" ::: "memory");
        } else {
            XB_SPIN(xb_ld(&bar[XB_XGEN(b.x)]) == gen, bar);
            __builtin_amdgcn_fence(__ATOMIC_ACQUIRE, "agent");
            asm volatile("s_waitcnt vmcnt(0)" ::: "memory");
        }
    }
    __syncthreads();
}


constexpr int NPHASE = 12;
__global__ void __launch_bounds__(NTHR, 2) mega(Params p, int ph_lo, int ph_hi, int coop) {
    extern __shared__ __attribute__((aligned(16))) unsigned char dlds[];
    LAS unsigned char* L = (LAS unsigned char*)dlds;
    char* lds = (char*)dlds;
    char* ws = p.ws;
    const int swid = __builtin_amdgcn_readfirstlane((int)(threadIdx.x >> 6));
#define MYTID (swid * 64 + lane_id_fresh())
    volatile LAS unsigned* xbw = (volatile LAS unsigned*)(L + LDS_XB);
    if (threadIdx.x < 4) xbw[threadIdx.x] = 0u;
    __syncthreads();
    XcdBarrier xb; xb.bar = (unsigned*)(ws + OFF_BAR); xb.x = 0; xb.st = xbw;
    if (coop) xb = xcd_barrier_post((unsigned*)(ws + OFF_BAR), xbw, MYTID);
    if (coop == 2) cg::this_grid().sync();
#define PH(n, call) if (ph_lo <= n && n < ph_hi) { call; } if (coop && n + 1 < NPHASE) xcd_barrier(xb, MYTID);
    PH(0, phase0(p, lds, MYTID))
    PH(1, { run_gemm(L, MYTID, (const bf16_t*)(ws + OFF_XB), (const bf16_t*)(ws + OFF_WIN), T, 1536, DM, Epi1{ws, p.b_gate});
            run_gemm(L, MYTID, (const bf16_t*)(ws + OFF_XB), (const bf16_t*)(ws + OFF_WIN) + (size_t)1536 * DM, T, 2048, DM, EpiGate{ws, p.b_gate});
            run_gemm(L, MYTID, (const bf16_t*)(ws + OFF_WV), (const bf16_t*)(ws + OFF_XB), 512, T, DM, EpiVt<1>{(bf16_t*)(ws + OFF_VTB), T, (const float*)(ws + OFF_RSTD0)}); })
    PH(2, { run_gemm(L, MYTID, (const bf16_t*)(ws + OFF_CQ), (const bf16_t*)(ws + OFF_WUQ), T, 768, 256, Epi2q{ws});
            run_gemm(L, MYTID, (const bf16_t*)(ws + OFF_CKV), (const bf16_t*)(ws + OFF_WUK), T, 512, 256, EpiBf<2, true>{(bf16_t*)(ws + OFF_KA), 768, (const float*)(ws + OFF_SSQ_KV)});
            run_gemm(L, MYTID, (const bf16_t*)(ws + OFF_WUV), (const bf16_t*)(ws + OFF_CKV), 512, T, 256, EpiVt<2>{(bf16_t*)(ws + OFF_VTA), T, (const float*)(ws + OFF_SSQ_KV)});
            run_gemm_at(L, MYTID, 128, (const bf16_t*)(ws + OFF_MNB), (const bf16_t*)(ws + OFF_WXKV), MEMT, 512, DM, EpiBf<0, false>{(bf16_t*)(ws + OFF_XK), 512, nullptr});
            run_gemm_at(L, MYTID, 144, (const bf16_t*)(ws + OFF_WXKV) + (size_t)512 * DM, (const bf16_t*)(ws + OFF_MNB), 512, MEMT, DM, EpiVt<0>{(bf16_t*)(ws + OFF_XVT), MEMT, nullptr}); })
    PH(3, phase3(p, lds, MYTID))
    PH(4, { run_gemm(L, MYTID, (const bf16_t*)(ws + OFF_OA), (const bf16_t*)(ws + OFF_WA), T, DM, 512, Epi4<0>{(const bf16_t*)(ws + OFF_SIGA), (bf16_t*)(ws + OFF_VTA), nullptr});
            run_gemm(L, MYTID, (const bf16_t*)(ws + OFF_OB), (const bf16_t*)(ws + OFF_WB), T, DM, 512, Epi4<1>{(const bf16_t*)(ws + OFF_SIGB), (bf16_t*)(ws + OFF_VTA), (bf16_t*)(ws + OFF_MERGED)}); })
    PH(5, run_gemm(L, MYTID, (const bf16_t*)(ws + OFF_MERGED), (const bf16_t*)(ws + OFF_WO), T, DM, DM, EpiRes{p.x, p.out, (bf16_t*)(ws + OFF_X1B), (float*)(ws + OFF_SSQ1)}))
    PH(6, run_gemm(L, MYTID, (const bf16_t*)(ws + OFF_X1B), (const bf16_t*)(ws + OFF_WXQ), T, 512, DM, EpiBf<1, false>{(bf16_t*)(ws + OFF_XQ), 512, (const float*)(ws + OFF_SSQ1)}))
    PH(7, phase7(p, lds, MYTID))
    PH(8, run_gemm(L, MYTID, (const bf16_t*)(ws + OFF_XO), (const bf16_t*)(ws + OFF_WXO), T, DM, 512, EpiRes{p.out, p.out, (bf16_t*)(ws + OFF_X2B), (float*)(ws + OFF_SSQ2)}))
    PH(9, run_gemm(L, MYTID, (const bf16_t*)(ws + OFF_X2B), (const bf16_t*)(ws + OFF_WGU), T, 2 * DFF, DM, Epi9{(bf16_t*)(ws + OFF_HID), (const float*)(ws + OFF_SSQ2)}))
    PH(10, run_gemm(L, MYTID, (const bf16_t*)(ws + OFF_HID), (const bf16_t*)(ws + OFF_WD), T, DM, DFF, EpiRes{p.out, p.out, nullptr, (float*)(ws + OFF_SSQ3)}))
    PH(11, phase11(p, MYTID))
}

extern "C" void kernel_launch(void* const* d_in, const int* in_sizes, int n_in, void* d_out, int out_size, void* d_ws, size_t ws_size, hipStream_t stream) {
    static int grid_blocks = 0;
    if (!grid_blocks) {
        int dev = 0, cus = 0, per_cu = 0;
        (void)hipGetDevice(&dev);
        (void)hipDeviceGetAttribute(&cus, hipDeviceAttributeMultiprocessorCount, dev);
        (void)hipFuncSetAttribute((const void*)mega, hipFuncAttributeMaxDynamicSharedMemorySize, LDS_BYTES);
        (void)hipOccupancyMaxActiveBlocksPerMultiprocessor(&per_cu, mega, NTHR, LDS_BYTES);
        if (per_cu != 1) per_cu = 1;
        grid_blocks = cus * per_cu;
    }
    Params p{};
    p.x = (const float*)d_in[0]; p.mem = (const float*)d_in[1]; p.pos = (const int*)d_in[2];
    p.g_mix = (const float*)d_in[3]; p.w_in = (const float*)d_in[4]; p.b_gate = (const float*)d_in[5]; p.g_q_lat = (const float*)d_in[6]; p.w_uq = (const float*)d_in[7];
    p.g_kv_lat = (const float*)d_in[8]; p.w_ukv = (const float*)d_in[9]; p.w_a = (const float*)d_in[10]; p.w_b = (const float*)d_in[11]; p.w_o = (const float*)d_in[12];
    p.g_x = (const float*)d_in[13]; p.g_mem = (const float*)d_in[14]; p.w_xq = (const float*)d_in[15]; p.w_xkv = (const float*)d_in[16]; p.w_xo = (const float*)d_in[17];
    p.g_ffn = (const float*)d_in[18]; p.w_gate = (const float*)d_in[19]; p.w_up = (const float*)d_in[20]; p.w_down = (const float*)d_in[21]; p.g_final = (const float*)d_in[22];
    p.out = (float*)d_out; p.ws = (char*)d_ws;
#if ONE_LAUNCH
    int lo = 0, hi = NPHASE, coop = 1;
    (void)hipMemsetAsync((char*)d_ws + OFF_BAR, 0, XCD_BAR_WORDS * sizeof(unsigned), stream);
    void* args[] = {&p, &lo, &hi, &coop};
    hipError_t e = hipLaunchCooperativeKernel((void*)mega, dim3(grid_blocks), dim3(NTHR), args, LDS_BYTES, stream);
    if (e != hipSuccess) fprintf(stderr, "cooperative launch failed: %s (grid %d)\n", hipGetErrorString(e), grid_blocks);
#else
    for (int ph = 0; ph < NPHASE; ++ph) mega<<<dim3(grid_blocks), dim3(NTHR), LDS_BYTES, stream>>>(p, ph, ph + 1, 0);
#endif
}
```

```cpp
#include <hip/hip_runtime.h>
#include <hip/hip_cooperative_groups.h>
#include <cstdio>
#include <cstdint>
namespace cg = cooperative_groups;

#ifndef ONE_LAUNCH
#define ONE_LAUNCH 1
#endif

namespace pg8 {
#define PG8_LAS __attribute__((address_space(3)))
typedef unsigned short bf16_t;
typedef short bf16x8 __attribute__((ext_vector_type(8)));
typedef float f32x4 __attribute__((ext_vector_type(4)));
typedef unsigned u32x4 __attribute__((ext_vector_type(4)));
constexpr int BM = 256, BK = 64, HALF = 128, HTB = HALF * BK * 2  , STAGE_BYTES = 8 * HTB, NXCD = 8, WGM = 8;

__host__ __device__ __forceinline__ int lds_byte(int r, int c) { const int st = (r >> 4) * 2 + (c >> 5), rr = r & 15, cc = c & 31, ob = rr * 64 + cc * 2; return st * 1024 + (ob ^ (((ob >> 9) & 1) << 5)); }
__host__ __device__ __forceinline__ void stage_rc(int b, int& R, int& C) { const int st = b / 1024, sb = b % 1024, swz = sb ^ (((sb >> 9) & 1) << 5); R = (st >> 1) * 16 + swz / 64; C = (st & 1) * 32 + (swz % 64) / 2; }
__host__ __device__ __forceinline__ int perm32(int rho) { const int n = rho >> 4, i = rho & 15; return 8 * (i >> 2) + 4 * n + (i & 3); }

struct Unit { int pm, pn; };
struct Gemm { const bf16_t* A; const bf16_t* Bt; int M, N, K; };

struct StaticOrder {
    int nM, nN, nwg, G, c;
    __host__ __device__ void init(int M, int N, int G_, int c_) { nM = M / BM; nN = N / BM; nwg = nM * nN; G = G_; c = c_; }
    __host__ __device__ bool next(int i, Unit& u) const {
        const long L = (long)i * G + c; if (L >= nwg) return false;
        int wgid = (int)L; { const int q = nwg / NXCD, r = nwg % NXCD, xcd = wgid % NXCD, off = wgid / NXCD; wgid = (xcd < r ? xcd * (q + 1) : r * (q + 1) + (xcd - r) * q) + off; }
        const int nig = WGM * nN, gid = wgid / nig, fm = gid * WGM, gsz = (nM - fm) < WGM ? (nM - fm) : WGM;
        u.pm = fm + ((wgid % nig) % gsz); u.pn = (wgid % nig) / gsz; return true;
    }
    __device__ __forceinline__ void a_ready(const Unit&) const {}
    __device__ __forceinline__ void done(const Unit&) const {}
};


template <class Epi, class Sched, bool ALIGN_EPI = false, bool SP2 = false>
__device__ __forceinline__ void gemm_phase(PG8_LAS unsigned char* lds, const Gemm g, const Sched& S, const Epi& E, const int tid_in) {
    int tid_ = tid_in; asm volatile("" : "+v"(tid_));
    const int tid = tid_, wid = __builtin_amdgcn_readfirstlane(tid >> 6), lane = tid & 63, wr = wid >> 2, wc = wid & 3, fr = lane & 15, fq = lane >> 4;
    const int K = g.K, nt = K / BK;
    unsigned voffA[2], voffB[2];
#pragma unroll
    for (int i = 0; i < 2; ++i) { int R, C; stage_rc(tid * 16 + i * 8192, R, C); const int Rb = Epi::PERM ? ((R & ~31) + perm32(R & 31)) : R;
        voffA[i] = (unsigned)(R * K + C) * 2u; voffB[i] = (unsigned)(Rb * K + C) * 2u; }
    const size_t kstep = (size_t)(BK * 2);
    const size_t hstep = (size_t)HALF * K * 2;
    const size_t tstep = 2 * hstep;
    const unsigned ldsw = (unsigned)wid * 1024u;
    const int aoff = lds_byte(wr * 64 + fr, fq * 8), boff = lds_byte(wc * 32 + fr, fq * 8);
#define PG8_SA(b, h) (((b) * 2 + (h)) * HTB)
#define PG8_SB(b, h) ((4 + (b) * 2 + (h)) * HTB)
#define PG8_STAGE(bufoff, gbase, voff) do { _Pragma("unroll") for (int _i = 0; _i < 2; ++_i) \
        __builtin_amdgcn_global_load_lds((const unsigned*)((const char*)(gbase) + (voff)[_i]), (PG8_LAS unsigned*)(lds + (bufoff) + ldsw + _i * 8192), 16, 0, 0); } while (0)
#define PG8_LDA(dst, b, h) do { _Pragma("unroll") for (int m = 0; m < 4; ++m) _Pragma("unroll") for (int k = 0; k < 2; ++k) dst[m][k] = *(const PG8_LAS bf16x8*)(lds + PG8_SA(b, h) + aoff + m * 2048 + k * 1024); } while (0)
#define PG8_LDB(dst, b, h) do { _Pragma("unroll") for (int n = 0; n < 2; ++n) _Pragma("unroll") for (int k = 0; k < 2; ++k) dst[n][k] = *(const PG8_LAS bf16x8*)(lds + PG8_SB(b, h) + boff + n * 2048 + k * 1024); } while (0)
#define PG8_MMA(ai, bj, At, Bt) do { __builtin_amdgcn_s_setprio(1); _Pragma("unroll") for (int m = 0; m < 4; ++m) _Pragma("unroll") for (int n = 0; n < 2; ++n) _Pragma("unroll") for (int k = 0; k < 2; ++k) \
        acc[ai][bj][m][n] = __builtin_amdgcn_mfma_f32_16x16x32_bf16(Bt[n][k], At[m][k], acc[ai][bj][m][n], 0, 0, 0); __builtin_amdgcn_s_setprio(0); } while (0)
#define PG8_WAIT_V(n) asm volatile("s_waitcnt vmcnt(" #n ")" ::: "memory")
#define PG8_WAIT_L(n) asm volatile("s_waitcnt lgkmcnt(" #n ")" ::: "memory")
#define PG8_BAR __builtin_amdgcn_s_barrier()
#define PG8_SCHED __builtin_amdgcn_sched_barrier(0)
    Unit cur, nxt; int ui = 0;
    if (!S.next(0, cur)) return;
    f32x4 acc[2][2][4][2];
#pragma unroll
    for (int a = 0; a < 2; ++a)
#pragma unroll
        for (int b = 0; b < 2; ++b)
#pragma unroll
            for (int m = 0; m < 4; ++m)
#pragma unroll
                for (int n = 0; n < 2; ++n) acc[a][b][m][n] = (f32x4){0.f, 0.f, 0.f, 0.f};
    bf16x8 At[4][2], B0[2][2], B1[2][2];
    const char* cA = (const char*)g.A + (size_t)cur.pm * tstep; const char* cB = (const char*)g.Bt + (size_t)cur.pn * tstep;
    S.a_ready(cur);
    if constexpr (SP2) {
        PG8_STAGE(PG8_SB(0, 0), cB, voffB); PG8_STAGE(PG8_SB(0, 1), cB + hstep, voffB); PG8_STAGE(PG8_SA(0, 0), cA, voffA); PG8_STAGE(PG8_SA(0, 1), cA + hstep, voffA);
        if (wr == 1) PG8_BAR;
        PG8_WAIT_V(2); PG8_BAR;
        PG8_STAGE(PG8_SB(1, 0), cB + kstep, voffB); PG8_STAGE(PG8_SA(1, 0), cA + kstep, voffA); PG8_STAGE(PG8_SB(1, 1), cB + hstep + kstep, voffB);
        PG8_WAIT_V(6); PG8_BAR;
    } else {
        PG8_STAGE(PG8_SB(0, 0), cB, voffB); PG8_STAGE(PG8_SA(0, 0), cA, voffA); PG8_STAGE(PG8_SB(0, 1), cB + hstep, voffB); PG8_STAGE(PG8_SA(0, 1), cA + hstep, voffA);
        if (wr == 1) PG8_BAR;
        PG8_WAIT_V(4); PG8_BAR;
        PG8_STAGE(PG8_SB(1, 0), cB + kstep, voffB); PG8_STAGE(PG8_SA(1, 0), cA + kstep, voffA); PG8_STAGE(PG8_SB(1, 1), cB + hstep + kstep, voffB);
        PG8_WAIT_V(6); PG8_BAR;
    }
    for (;;) {
        const bool has_next = S.next(ui + 1, nxt);
        const char* nA = has_next ? (const char*)g.A + (size_t)nxt.pm * tstep : cA; const char* nB = has_next ? (const char*)g.Bt + (size_t)nxt.pn * tstep : cB;
        for (int t = 0; t < nt; t += 2) {
            const bool last = (t == nt - 2);
            const char* a1 = cA + (size_t)(t + 1) * kstep;
            const char* a2 = last ? nA : cA + (size_t)(t + 2) * kstep; const char* b2 = last ? nB : cB + (size_t)(t + 2) * kstep;
            const char* a3 = a2 + kstep; const char* b3 = b2 + kstep;
            if (last && has_next) S.a_ready(nxt);
            if constexpr (SP2) {
            PG8_LDB(B0, 0, 0); PG8_LDB(B1, 0, 1); PG8_SCHED; PG8_LDA(At, 0, 0); PG8_STAGE(PG8_SA(1, 1), a1 + hstep, voffA);
            PG8_WAIT_V(8); PG8_WAIT_L(0); PG8_BAR; PG8_MMA(0, 0, At, B0); PG8_MMA(0, 1, At, B1); PG8_BAR; PG8_SCHED;
            PG8_LDA(At, 0, 1); PG8_STAGE(PG8_SB(0, 0), b2, voffB); PG8_STAGE(PG8_SB(0, 1), b2 + hstep, voffB); PG8_STAGE(PG8_SA(0, 0), a2, voffA);
            PG8_WAIT_V(8); PG8_WAIT_L(0); PG8_BAR; PG8_MMA(1, 0, At, B0); PG8_MMA(1, 1, At, B1); PG8_BAR; PG8_SCHED;
            PG8_LDB(B0, 1, 0); PG8_LDB(B1, 1, 1); PG8_SCHED; PG8_LDA(At, 1, 0); PG8_STAGE(PG8_SA(0, 1), a2 + hstep, voffA);
            PG8_WAIT_V(8); PG8_WAIT_L(0); PG8_BAR; PG8_MMA(0, 0, At, B0); PG8_MMA(0, 1, At, B1); PG8_BAR; PG8_SCHED;
            PG8_LDA(At, 1, 1); PG8_STAGE(PG8_SB(1, 0), b3, voffB); PG8_STAGE(PG8_SB(1, 1), b3 + hstep, voffB); PG8_STAGE(PG8_SA(1, 0), a3, voffA);
            PG8_WAIT_V(8); PG8_WAIT_L(0); PG8_BAR; PG8_MMA(1, 0, At, B0); PG8_MMA(1, 1, At, B1); PG8_BAR; PG8_SCHED;
            } else {
            PG8_LDB(B0, 0, 0); PG8_SCHED; PG8_LDA(At, 0, 0); PG8_STAGE(PG8_SA(1, 1), a1 + hstep, voffA);
            PG8_WAIT_L(8); PG8_BAR; PG8_WAIT_L(0); PG8_MMA(0, 0, At, B0); PG8_BAR; PG8_SCHED;
            PG8_LDB(B1, 0, 1); PG8_STAGE(PG8_SB(0, 0), b2, voffB);
            PG8_BAR; PG8_WAIT_L(0); PG8_MMA(0, 1, At, B1); PG8_BAR;
            PG8_LDA(At, 0, 1); PG8_STAGE(PG8_SA(0, 0), a2, voffA);
            PG8_BAR; PG8_WAIT_L(0); PG8_MMA(1, 0, At, B0); PG8_BAR; PG8_SCHED;
            PG8_STAGE(PG8_SB(0, 1), b2 + hstep, voffB);
            PG8_WAIT_V(6); PG8_BAR; PG8_MMA(1, 1, At, B1); PG8_BAR;
            PG8_LDB(B0, 1, 0); PG8_SCHED; PG8_LDA(At, 1, 0); PG8_STAGE(PG8_SA(0, 1), a2 + hstep, voffA);
            PG8_WAIT_L(8); PG8_BAR; PG8_WAIT_L(0); PG8_MMA(0, 0, At, B0); PG8_BAR; PG8_SCHED;
            PG8_LDB(B1, 1, 1); PG8_STAGE(PG8_SB(1, 0), b3, voffB);
            PG8_BAR; PG8_WAIT_L(0); PG8_MMA(0, 1, At, B1); PG8_BAR;
            PG8_LDA(At, 1, 1); PG8_STAGE(PG8_SA(1, 0), a3, voffA);
            PG8_BAR; PG8_WAIT_L(0); PG8_MMA(1, 0, At, B0); PG8_BAR; PG8_SCHED;
            PG8_STAGE(PG8_SB(1, 1), b3 + hstep, voffB);
            PG8_WAIT_V(6); PG8_BAR; PG8_MMA(1, 1, At, B1); PG8_BAR;
            }
        }
        if constexpr (ALIGN_EPI) { if (wr == 0) PG8_BAR; }
        if constexpr (!Epi::AFTER_DRAIN) { int fr2 = fr, fq2 = fq; asm volatile("" : "+v"(fr2), "+v"(fq2));
            E(acc, cur, wr, wc, fr2, fq2); S.done(cur); }
        if (!has_next) break;
#pragma unroll
        for (int a = 0; a < 2; ++a)
#pragma unroll
            for (int b = 0; b < 2; ++b)
#pragma unroll
                for (int m = 0; m < 4; ++m)
#pragma unroll
                    for (int n = 0; n < 2; ++n) acc[a][b][m][n] = (f32x4){0.f, 0.f, 0.f, 0.f};
        cur = nxt; cA = nA; cB = nB; ++ui;
        if constexpr (ALIGN_EPI) { if (wr == 1) PG8_BAR; }
    }
    PG8_WAIT_V(0);
    if constexpr (!ALIGN_EPI) { if (wr == 0) PG8_BAR; }
    PG8_BAR;
    if constexpr (Epi::AFTER_DRAIN) { E.fused(acc, cur, wr, wc, fr, fq, lds, wid, lane); S.done(cur); }
#undef PG8_SA
#undef PG8_SB
#undef PG8_STAGE
#undef PG8_LDA
#undef PG8_LDB
#undef PG8_MMA
#undef PG8_WAIT_V
#undef PG8_WAIT_L
#undef PG8_BAR
#undef PG8_SCHED
}
}


typedef unsigned short bf16_t;
typedef short bf16x8 __attribute__((ext_vector_type(8)));
typedef float f32x16 __attribute__((ext_vector_type(16)));
typedef float f32x4 __attribute__((ext_vector_type(4)));
typedef float f32x2 __attribute__((ext_vector_type(2)));
typedef unsigned u32x4 __attribute__((ext_vector_type(4)));
typedef unsigned u32x2 __attribute__((ext_vector_type(2)));
typedef __bf16 bf16x2_t __attribute__((ext_vector_type(2)));
#define DI __device__ __forceinline__
#define LAS __attribute__((address_space(3)))
#define MFMA(a, b, c) __builtin_amdgcn_mfma_f32_32x32x16_bf16((a), (b), (c), 0, 0, 0)
using pg8::Unit;

constexpr int T = 32768, SEQ = 8192, NB = 4, DM = 1024, MEMT = 1024, MEML = 256;
constexpr int DFF = 2816;
constexpr int NTHR = 512, NWV = 8;
constexpr float EPS = 1e-6f;
constexpr float LOG2E = 1.4426950408889634f;
constexpr int LDS_BYTES = 147456;
constexpr int LDS_XB = 131072 + 1024;

constexpr size_t MB = 1024 * 1024;
constexpr size_t OFF_SSQ_Q = 0;
constexpr size_t OFF_SSQ_KV = OFF_SSQ_Q + T * 4;
constexpr size_t OFF_SSQ1 = OFF_SSQ_KV + T * 4;
constexpr size_t OFF_SSQ2 = OFF_SSQ1 + T * 4;
constexpr size_t OFF_SSQ3 = OFF_SSQ2 + T * 4;
constexpr size_t OFF_RSTD0 = OFF_SSQ3 + T * 4;
constexpr size_t OFF_BAR = 832 * 1024;
constexpr size_t OFF_CS = 1 * MB;
constexpr size_t OFF_WIN = 5 * MB;
constexpr size_t OFF_WV = OFF_WIN + 7 * MB;
constexpr size_t OFF_WUQ = OFF_WV + 1 * MB;
constexpr size_t OFF_WUK = OFF_WUQ + 768 * 256 * 2;
constexpr size_t OFF_WUV = OFF_WUK + 512 * 256 * 2;
constexpr size_t OFF_WA = OFF_WUV + 512 * 256 * 2;
constexpr size_t OFF_WB = OFF_WA + 1 * MB;
constexpr size_t OFF_WO = OFF_WB + 1 * MB;
constexpr size_t OFF_WXQ = OFF_WO + 2 * MB;
constexpr size_t OFF_WXKV = OFF_WXQ + 1 * MB;
constexpr size_t OFF_WXO = OFF_WXKV + 2 * MB;
constexpr size_t OFF_WGU = OFF_WXO + 1 * MB;
constexpr size_t OFF_WD = OFF_WGU + 11 * MB;
constexpr size_t OFF_MNB = OFF_WD + 6 * MB;
constexpr size_t OFF_XK = OFF_MNB + 2 * MB;
constexpr size_t OFF_XVT = OFF_XK + 1 * MB;
constexpr size_t OFF_ACT = 48 * MB;
static_assert(OFF_XVT + 1 * MB <= OFF_ACT, "ws map");
constexpr size_t OFF_XB = OFF_ACT;
constexpr size_t OFF_OA = OFF_XB;
constexpr size_t OFF_OB = OFF_XB + 32 * MB;
constexpr size_t OFF_CQ = OFF_XB + 64 * MB;
constexpr size_t OFF_CKV = OFF_CQ + 16 * MB;
constexpr size_t OFF_KA = OFF_CKV + 16 * MB;
constexpr size_t OFF_QA = OFF_KA + 48 * MB;
constexpr size_t OFF_VTA = OFF_QA + 48 * MB;
constexpr size_t OFF_SBQ = OFF_VTA + 32 * MB;
constexpr size_t OFF_SBK = OFF_SBQ + 32 * MB;
constexpr size_t OFF_VTB = OFF_SBK + 32 * MB;
constexpr size_t OFF_SIGA = OFF_VTB + 32 * MB;
constexpr size_t OFF_SIGB = OFF_SIGA + 64 * MB;
constexpr size_t WS_END = OFF_SIGB + 64 * MB;
static_assert(WS_END <= 512 * MB, "ws map");
constexpr size_t OFF_MERGED = OFF_KA;
constexpr size_t OFF_X1B = OFF_VTA;
constexpr size_t OFF_XQ = OFF_SBK;
constexpr size_t OFF_XO = OFF_VTB;
constexpr size_t OFF_X2B = OFF_SIGA;
constexpr size_t OFF_HID = OFF_KA;

struct Params {
    const float* x; const float* mem; const int* pos;
    const float* g_mix; const float* w_in; const float* b_gate; const float* g_q_lat; const float* w_uq;
    const float* g_kv_lat; const float* w_ukv; const float* w_a; const float* w_b; const float* w_o;
    const float* g_x; const float* g_mem; const float* w_xq; const float* w_xkv; const float* w_xo;
    const float* g_ffn; const float* w_gate; const float* w_up; const float* w_down; const float* g_final;
    float* out; char* ws;
};

DI unsigned pk2(float a, float b) { f32x2 v = {a, b}; bf16x2_t r = __builtin_convertvector(v, bf16x2_t); return __builtin_bit_cast(unsigned, r); }
DI bf16_t bf1(float a) { return (bf16_t)(pk2(a, 0.f) & 0xffffu); }
DI float ex2(float x) { return __builtin_amdgcn_exp2f(x); }
DI float lg2(float x) { return __builtin_amdgcn_logf(x); }
DI float shx32(float v) { return __shfl_xor(v, 32); }
DI int lane_id_fresh() { int l; asm volatile("v_mbcnt_lo_u32_b32 %0, -1, 0\n\tv_mbcnt_hi_u32_b32 %0, -1, %0" : "=v"(l)); return l; }
DI float bflo(unsigned u) { return __uint_as_float(u << 16); }
DI float bfhi(unsigned u) { return __uint_as_float(u & 0xffff0000u); }
DI void st_bf4(bf16_t* d, float a, float b, float c, float e) { u32x2 o; o.x = pk2(a, b); o.y = pk2(c, e); *(u32x2*)d = o; }
DI void st_bf8(bf16_t* d, const f32x4& a, const f32x4& b) { u32x4 o; o.x = pk2(a[0], a[1]); o.y = pk2(a[2], a[3]); o.z = pk2(b[0], b[1]); o.w = pk2(b[2], b[3]); *(u32x4*)d = o; }

struct WT { const float* src; const float* g; bf16_t* dst; int N, sc, k0, K, drow0; float scale; };
constexpr float SBQ_SCALE = LOG2E * 0.125f;
constexpr float MLAQ_SCALE = LOG2E * 0.10206207261596577f;
constexpr float XQ_SCALE = LOG2E * 0.08838834764831845f;
constexpr int J0 = 112 * 16;
constexpr int J1 = J0 + 16 * 16;
constexpr int J2 = J1 + 24 * 4;
constexpr int J3 = J2 + 16 * 4;
constexpr int J4 = J3 + 16 * 4;
constexpr int J5 = J4 + 32 * 8;
constexpr int J6 = J5 + 32 * 8;
constexpr int J7 = J6 + 32 * 16;
constexpr int J8 = J7 + 16 * 16;
constexpr int J9 = J8 + 32 * 16;
constexpr int J10 = J9 + 32 * 8;
constexpr int J11 = J10 + 176 * 16;
constexpr int J12 = J11 + 32 * 44;
DI WT wt_desc(const Params& p, int tl) {
    char* ws = p.ws; WT d; d.g = nullptr; d.scale = 1.f; d.src = p.w_in; d.dst = (bf16_t*)(ws + OFF_WIN); d.N = 4000; d.sc = -2; d.k0 = 0; d.K = 1024; d.drow0 = 0;
    if (tl >= J12) return d;
    if (tl < J0) { const int jk = tl / 112, jn = tl - jk * 112; const int d0 = jn * 32; int sc; float s = 1.f;
        if (d0 < 416) sc = d0; else if (d0 < 512) sc = -1; else if (d0 < 1536) { sc = d0 - 96; if (d0 < 1024) s = SBQ_SCALE; } else sc = d0 + 416;
        d.sc = sc; d.k0 = jk * 64; d.drow0 = d0; d.g = p.g_mix; d.scale = s; }
    else if (tl < J1) { const int u = tl - J0; const int jk = u >> 4, jn = u & 15; d.sc = 1440 + jn * 32; d.k0 = jk * 64; d.dst = (bf16_t*)(ws + OFF_WV); d.drow0 = jn * 32; d.g = p.g_mix; }
    else if (tl < J2) { const int u = tl - J1; const int jk = u / 24, jn = u - jk * 24; d.src = p.w_uq; d.N = 768; d.sc = jn * 32; d.k0 = jk * 64; d.dst = (bf16_t*)(ws + OFF_WUQ); d.K = 256; d.drow0 = jn * 32; d.g = p.g_q_lat; d.scale = MLAQ_SCALE; }
    else if (tl < J4) { const bool isv = tl >= J3; const int u = tl - (isv ? J3 : J2); const int jk = u >> 4, jn = u & 15; const int d0 = jn * 32;
        d.src = p.w_ukv; d.N = 1024; d.sc = jk < 2 ? (d0 >> 6) * 128 + (isv ? 64 : 0) + (d0 & 63) : -1; d.k0 = jk * 64; d.dst = (bf16_t*)(ws + (isv ? OFF_WUV : OFF_WUK)); d.K = 256; d.drow0 = d0; d.g = p.g_kv_lat; }
    else if (tl < J6) { const bool isb = tl >= J5; const int u = tl - (isb ? J5 : J4); const int jk = u >> 5, jn = u & 31;
        d.src = isb ? p.w_b : p.w_a; d.N = 1024; d.sc = jn * 32; d.k0 = jk * 64; d.dst = (bf16_t*)(ws + (isb ? OFF_WB : OFF_WA)); d.K = 512; d.drow0 = jn * 32; }
    else if (tl < J7) { const int u = tl - J6; const int jk = u >> 5, jn = u & 31; d.src = p.w_o; d.N = 1024; d.sc = jn * 32; d.k0 = jk * 64; d.dst = (bf16_t*)(ws + OFF_WO); d.drow0 = jn * 32; }
    else if (tl < J8) { const int u = tl - J7; const int jk = u >> 4, jn = u & 15; d.src = p.w_xq; d.N = 512; d.sc = jn * 32; d.k0 = jk * 64; d.dst = (bf16_t*)(ws + OFF_WXQ); d.drow0 = jn * 32; d.g = p.g_x; d.scale = XQ_SCALE; }
    else if (tl < J9) { const int u = tl - J8; const int jk = u >> 5, jn = u & 31; d.src = p.w_xkv; d.N = 1024; d.sc = jn * 32; d.k0 = jk * 64; d.dst = (bf16_t*)(ws + OFF_WXKV); d.drow0 = jn * 32; }
    else if (tl < J10) { const int u = tl - J9; const int jk = u >> 5, jn = u & 31; d.src = p.w_xo; d.N = 1024; d.sc = jn * 32; d.k0 = jk * 64; d.dst = (bf16_t*)(ws + OFF_WXO); d.K = 512; d.drow0 = jn * 32; }
    else if (tl < J11) { const int u = tl - J10; const int jk = u / 176, jn = u - jk * 176; const int d0 = jn * 32; const int rem = d0 & 255;
        d.src = (rem >= 128) ? p.w_up : p.w_gate; d.N = DFF; d.sc = (d0 >> 8) * 128 + (rem & 127); d.k0 = jk * 64; d.dst = (bf16_t*)(ws + OFF_WGU); d.drow0 = d0; d.g = p.g_ffn; }
    else { const int u = tl - J11; const int jk = u >> 5, jn = u & 31; d.src = p.w_down; d.N = 1024; d.sc = jn * 32; d.k0 = jk * 64; d.dst = (bf16_t*)(ws + OFF_WD); d.K = DFF; d.drow0 = jn * 32; }
    return d;
}
DI void wt_load(const WT& d, int t, float (&v)[8], float (&gv)[8]) {
    const int nn = t & 31, kb = t >> 5;
    const bool z = d.sc < 0; const int sc = z ? 0 : d.sc, ks = z ? 0 : d.k0;
    const float* gp = d.g ? d.g + ks : d.src;
#pragma unroll
    for (int i = 0; i < 8; ++i) { const int kk = kb + 8 * i; v[i] = d.src[(size_t)(ks + kk) * d.N + sc + nn]; gv[i] = gp[kk]; }
}
DI void wt_fix(const WT& d, float (&v)[8], const float (&gv)[8]) {
    const bool z = d.sc < 0;
#pragma unroll
    for (int i = 0; i < 8; ++i) { float x = v[i] * d.scale; if (d.g) x *= gv[i]; v[i] = z ? 0.f : x; }
}
DI void wt_put(float* l, int t, const float (&v)[8]) {
    const int nn = t & 31, kb = t >> 5;
#pragma unroll
    for (int i = 0; i < 8; ++i) l[(kb + 8 * i) * 33 + nn] = v[i];
}
DI void wt_store(const WT& d, int t, const float* l) {
    if (d.sc == -2) return;
    const int kk = t & 63, nb = t >> 6;
#pragma unroll
    for (int i = 0; i < 8; ++i) { const int nn = nb + 4 * i; d.dst[(size_t)(d.drow0 + nn) * d.K + d.k0 + kk] = bf1(l[kk * 33 + nn]); }
}

DI void phase0(const Params& p, char* ldsc, const int tid) {
    char* ws = p.ws;
    const int half = tid >> 8, t = tid & 255;
    float* l0 = (float*)ldsc + half * 2 * (64 * 33 + 16);
    float* l1 = l0 + (64 * 33 + 16);
    for (int base = blockIdx.x * 4; base < J12; base += gridDim.x * 4) {
        const WT d0 = wt_desc(p, base + half * 2), d1 = wt_desc(p, base + half * 2 + 1);
        float v0[8], v1[8], g0[8], g1[8];
        wt_load(d0, t, v0, g0); wt_load(d1, t, v1, g1);
        wt_fix(d0, v0, g0); wt_fix(d1, v1, g1);
        wt_put(l0, t, v0); wt_put(l1, t, v1);
        __syncthreads();
        wt_store(d0, t, l0); wt_store(d1, t, l1);
        __syncthreads();
    }
    {
        float* z = (float*)(ws + OFF_SSQ_Q);
        for (int i = blockIdx.x * NTHR + tid; i < 5 * T; i += gridDim.x * NTHR) z[i] = 0.f;
    }
    const int lane = tid & 63, w = tid >> 6;
    for (int row0 = (blockIdx.x * NWV + w) * 4; row0 < T + MEMT; row0 += gridDim.x * NWV * 4) {
        f32x4 v[4][4];
#pragma unroll
        for (int r = 0; r < 4; ++r) { const int row = row0 + r; const float* src = row >= T ? p.mem + (size_t)(row - T) * DM : p.x + (size_t)row * DM;
#pragma unroll
            for (int i = 0; i < 4; ++i) v[r][i] = *(const f32x4*)(src + i * 256 + lane * 4); }
#pragma unroll
        for (int r = 0; r < 4; ++r) {
            const int row = row0 + r; const bool ismem = row >= T;
            float ss = 0.f;
#pragma unroll
            for (int i = 0; i < 4; ++i) ss += v[r][i][0] * v[r][i][0] + v[r][i][1] * v[r][i][1] + v[r][i][2] * v[r][i][2] + v[r][i][3] * v[r][i][3];
#pragma unroll
            for (int o = 32; o >= 1; o >>= 1) ss += __shfl_xor(ss, o);
            const float rstd = rsqrtf(ss * (1.0f / DM) + EPS);
            if (!ismem) {
                bf16_t* d = (bf16_t*)(ws + OFF_XB) + (size_t)row * DM;
#pragma unroll
                for (int i = 0; i < 4; ++i) st_bf4(d + i * 256 + lane * 4, v[r][i][0], v[r][i][1], v[r][i][2], v[r][i][3]);
                if (lane == 0) ((float*)(ws + OFF_RSTD0))[row] = rstd;
                if (lane < 16) {
                    const float invf = exp2f(-(float)(2 * lane) * (13.287712379549449f / 32.0f));
                    const float ang = (float)p.pos[row] * invf;
                    const double a = (double)ang; const double kq = rint(a * 0.15915494309189535); const float rr = (float)(a - kq * 6.283185307179586);
                    f32x2 cs; cs.x = __cosf(rr); cs.y = __sinf(rr);
                    ((f32x2*)(ws + OFF_CS))[(size_t)row * 16 + lane] = cs;
                }
            } else {
                bf16_t* d = (bf16_t*)(ws + OFF_MNB) + (size_t)(row - T) * DM;
#pragma unroll
                for (int i = 0; i < 4; ++i) { const f32x4 g = *(const f32x4*)(p.g_mem + i * 256 + lane * 4);
                    st_bf4(d + i * 256 + lane * 4, v[r][i][0] * rstd * g[0], v[r][i][1] * rstd * g[1], v[r][i][2] * rstd * g[2], v[r][i][3] * rstd * g[3]); }
            }
        }
    }
}

typedef f32x4 Acc[2][2][4][2];
DI float sq4(const f32x4& v) { return v[0] * v[0] + v[1] * v[1] + v[2] * v[2] + v[3] * v[3]; }
DI float red_fq(float s) { s += __shfl_xor(s, 16); s += __shfl_xor(s, 32); return s; }
DI float sigm(float z) { return __builtin_amdgcn_rcpf(1.f + ex2(-z * LOG2E)); }

struct Epi1 {
    static constexpr bool PERM = false, AFTER_DRAIN = false;
    char* ws; const float* b_gate;
    DI void operator()(const Acc& acc, const Unit& u, int wr, int wc, int fr, int fq) const {
        const int pn = u.pn;
        float rsv[2][4];
#pragma unroll
        for (int ai = 0; ai < 2; ++ai)
#pragma unroll
            for (int m = 0; m < 4; ++m) rsv[ai][m] = ((const float*)(ws + OFF_RSTD0))[u.pm * 256 + ai * 128 + wr * 64 + m * 16 + fr];
#pragma unroll
        for (int ai = 0; ai < 2; ++ai)
#pragma unroll
            for (int m = 0; m < 4; ++m) {
                const int tok = u.pm * 256 + ai * 128 + wr * 64 + m * 16 + fr;
                const float rs = rsv[ai][m];
                if (pn <= 1) {
                    bf16_t* d = (bf16_t*)(ws + (pn == 0 ? OFF_CQ : OFF_CKV)) + (size_t)tok * 256 + wc * 32 + fq * 4;
                    float ssq = 0.f;
#pragma unroll
                    for (int bj = 0; bj < 2; ++bj)
#pragma unroll
                        for (int n = 0; n < 2; ++n) { const f32x4 v = acc[ai][bj][m][n] * rs; if (pn == 0 || bj == 0) ssq += sq4(v); st_bf4(d + bj * 128 + n * 16, v[0], v[1], v[2], v[3]); }
                    ssq = red_fq(ssq);
                    if (fq == 0) atomicAdd((float*)(ws + (pn == 0 ? OFF_SSQ_Q : OFF_SSQ_KV)) + tok, ssq);
                    if (pn == 1 && wc == 0) {
                        const f32x4 c01 = *(const f32x4*)(ws + OFF_CS + ((size_t)tok * 16 + fq * 4) * 8), c23 = *(const f32x4*)(ws + OFF_CS + ((size_t)tok * 16 + fq * 4 + 2) * 8);
                        const f32x4 x1 = acc[ai][1][m][0] * rs, x2 = acc[ai][1][m][1] * rs;
                        const float cs_[4] = {c01[0], c01[2], c23[0], c23[2]}, sn_[4] = {c01[1], c01[3], c23[1], c23[3]};
                        float lo[4], hi[4];
#pragma unroll
                        for (int j = 0; j < 4; ++j) { lo[j] = x1[j] * cs_[j] - x2[j] * sn_[j]; hi[j] = x2[j] * cs_[j] + x1[j] * sn_[j]; }
                        bf16_t* k = (bf16_t*)(ws + OFF_KA) + (size_t)tok * 768 + 64 + fq * 4;
#pragma unroll
                        for (int h = 0; h < 8; ++h) { st_bf4(k + h * 96, lo[0], lo[1], lo[2], lo[3]); st_bf4(k + h * 96 + 16, hi[0], hi[1], hi[2], hi[3]); }
                    }
                } else if (pn < 6) {
                    bf16_t* d = (bf16_t*)(ws + (pn < 4 ? OFF_SBQ : OFF_SBK)) + (size_t)tok * 512 + ((pn & 1) * 256) + wc * 32 + fq * 4;
#pragma unroll
                    for (int bj = 0; bj < 2; ++bj)
#pragma unroll
                        for (int n = 0; n < 2; ++n) { const f32x4 v = acc[ai][bj][m][n] * rs; st_bf4(d + bj * 128 + n * 16, v[0], v[1], v[2], v[3]); }
                } else {
                    const int gi = pn >= 10; const int c0 = (pn - (gi ? 10 : 6)) * 256 + wc * 32 + fq * 4;
                    bf16_t* d = (bf16_t*)(ws + (gi ? OFF_SIGB : OFF_SIGA)) + (size_t)tok * DM + c0;
                    const float* bg = b_gate + gi * DM + c0;
#pragma unroll
                    for (int bj = 0; bj < 2; ++bj)
#pragma unroll
                        for (int n = 0; n < 2; ++n) { const f32x4 bb = *(const f32x4*)(bg + bj * 128 + n * 16); const f32x4 v = acc[ai][bj][m][n] * rs + bb;
                            st_bf4(d + bj * 128 + n * 16, sigm(v[0]), sigm(v[1]), sigm(v[2]), sigm(v[3])); }
                }
            }
    }
};

DI void ld_rstd0(const float* rstd0, const Unit& u, int wr, int fr, float (&rs)[2][4]) {
#pragma unroll
    for (int ai = 0; ai < 2; ++ai)
#pragma unroll
        for (int m = 0; m < 4; ++m) rs[ai][m] = rstd0[u.pm * 256 + ai * 128 + wr * 64 + m * 16 + fr];
}
struct EpiGate {
    static constexpr bool PERM = true, AFTER_DRAIN = false;
    char* ws; const float* b_gate;
    DI void operator()(const Acc& acc, const Unit& u, int wr, int wc, int fr, int fq) const {
        const int gi = u.pn >= 4; const int cb = (u.pn & 3) * 256 + wc * 32 + fq * 8;
        bf16_t* outp = (bf16_t*)(ws + (gi ? OFF_SIGB : OFF_SIGA));
        float rs[2][4]; ld_rstd0((const float*)(ws + OFF_RSTD0), u, wr, fr, rs);
        f32x4 bb[2][2];
#pragma unroll
        for (int bj = 0; bj < 2; ++bj) { bb[bj][0] = *(const f32x4*)(b_gate + gi * DM + cb + bj * 128); bb[bj][1] = *(const f32x4*)(b_gate + gi * DM + cb + bj * 128 + 4); }
#pragma unroll
        for (int bj = 0; bj < 2; ++bj)
#pragma unroll
            for (int ai = 0; ai < 2; ++ai)
#pragma unroll
                for (int m = 0; m < 4; ++m) {
                    const int tok = u.pm * 256 + ai * 128 + wr * 64 + m * 16 + fr;
                    f32x4 a = acc[ai][bj][m][0] * rs[ai][m] + bb[bj][0], b = acc[ai][bj][m][1] * rs[ai][m] + bb[bj][1];
#pragma unroll
                    for (int j = 0; j < 4; ++j) { a[j] = sigm(a[j]); b[j] = sigm(b[j]); }
                    st_bf8(outp + (size_t)tok * DM + cb + bj * 128, a, b);
                }
    }
};

template <int SMODE>
struct EpiVt {
    static constexpr bool PERM = true, AFTER_DRAIN = false;
    bf16_t* out; int ldo; const float* sc;
    DI void operator()(const Acc& acc, const Unit& u, int wr, int wc, int fr, int fq) const {
#pragma unroll
        for (int bj = 0; bj < 2; ++bj) {
            const int col = u.pn * 256 + bj * 128 + wc * 32 + fq * 8;
            f32x4 s0 = {1.f, 1.f, 1.f, 1.f}, s1 = s0;
            if (SMODE >= 1) { s0 = *(const f32x4*)(sc + col); s1 = *(const f32x4*)(sc + col + 4); }
            if (SMODE == 2) {
#pragma unroll
                for (int j = 0; j < 4; ++j) { s0[j] = rsqrtf(s0[j] * (1.0f / 128.0f) + EPS); s1[j] = rsqrtf(s1[j] * (1.0f / 128.0f) + EPS); }
            }
#pragma unroll
            for (int ai = 0; ai < 2; ++ai)
#pragma unroll
                for (int m = 0; m < 4; ++m) { const int row = u.pm * 256 + ai * 128 + wr * 64 + m * 16 + fr;
                    st_bf8(out + (size_t)row * ldo + col, acc[ai][bj][m][0] * s0, acc[ai][bj][m][1] * s1); }
        }
    }
};

struct Epi2q {
    static constexpr bool PERM = false, AFTER_DRAIN = false;
    char* ws;
    DI void operator()(const Acc& acc, const Unit& u, int wr, int wc, int fr, int fq) const {
        float rs[2][4]; ld_rstd0((const float*)(ws + OFF_SSQ_Q), u, wr, fr, rs);
#pragma unroll
        for (int ai = 0; ai < 2; ++ai) {
#pragma unroll
            for (int m = 0; m < 4; ++m) rs[ai][m] = rsqrtf(rs[ai][m] * (1.0f / 256.0f) + EPS);
#pragma unroll
            for (int m = 0; m < 4; ++m) {
                const int tok = u.pm * 256 + ai * 128 + wr * 64 + m * 16 + fr;
                const f32x4 c01m = *(const f32x4*)(ws + OFF_CS + ((size_t)tok * 16 + fq * 4) * 8), c23m = *(const f32x4*)(ws + OFF_CS + ((size_t)tok * 16 + fq * 4 + 2) * 8);
#pragma unroll
                for (int bj = 0; bj < 2; ++bj) {
                    const int cg0 = u.pn * 256 + bj * 128 + wc * 32;
                    bf16_t* d = (bf16_t*)(ws + OFF_QA) + (size_t)tok * 768 + cg0 + fq * 4;
                    const f32x4 x1 = acc[ai][bj][m][0] * rs[ai][m], x2 = acc[ai][bj][m][1] * rs[ai][m];
                    if (((cg0 >> 5) % 3) == 2) {
                        const f32x4 a = c01m, b = c23m;
                        const float cs_[4] = {a[0], a[2], b[0], b[2]}, sn_[4] = {a[1], a[3], b[1], b[3]};
                        float lo[4], hi[4];
#pragma unroll
                        for (int j = 0; j < 4; ++j) { lo[j] = x1[j] * cs_[j] - x2[j] * sn_[j]; hi[j] = x2[j] * cs_[j] + x1[j] * sn_[j]; }
                        st_bf4(d, lo[0], lo[1], lo[2], lo[3]); st_bf4(d + 16, hi[0], hi[1], hi[2], hi[3]);
                    } else { st_bf4(d, x1[0], x1[1], x1[2], x1[3]); st_bf4(d + 16, x2[0], x2[1], x2[2], x2[3]); }
                }
            }
        }
    }
};

template <int RMODE  , bool KA  >
struct EpiBf {
    static constexpr bool PERM = true, AFTER_DRAIN = false;
    bf16_t* out; int ldo; const float* ssq;
    DI void operator()(const Acc& acc, const Unit& u, int wr, int wc, int fr, int fq) const {
        float rs[2][4];
        if (RMODE != 0) ld_rstd0(ssq, u, wr, fr, rs);
#pragma unroll
        for (int ai = 0; ai < 2; ++ai)
#pragma unroll
            for (int m = 0; m < 4; ++m) { if (RMODE == 0) rs[ai][m] = 1.f; if (RMODE == 1) rs[ai][m] = rsqrtf(rs[ai][m] * (1.0f / 1024.0f) + EPS); if (RMODE == 2) rs[ai][m] = rsqrtf(rs[ai][m] * (1.0f / 128.0f) + EPS); }
#pragma unroll
        for (int ai = 0; ai < 2; ++ai)
#pragma unroll
            for (int m = 0; m < 4; ++m) {
                const int tok = u.pm * 256 + ai * 128 + wr * 64 + m * 16 + fr;
#pragma unroll
                for (int bj = 0; bj < 2; ++bj) { int col = u.pn * 256 + bj * 128 + wc * 32 + fq * 8; if (KA) col = (col >> 6) * 96 + (col & 63);
                    st_bf8(out + (size_t)tok * ldo + col, acc[ai][bj][m][0] * rs[ai][m], acc[ai][bj][m][1] * rs[ai][m]); }
            }
    }
};

template <int STEP>
struct Epi4 {
    static constexpr bool PERM = true, AFTER_DRAIN = false;
    const bf16_t* sig; bf16_t* ta; bf16_t* merged;
    DI void operator()(const Acc& acc, const Unit& u, int wr, int wc, int fr, int fq) const {
#pragma unroll
        for (int ai = 0; ai < 2; ++ai) {
            u32x4 sg[4][2], tv[4][2];
#pragma unroll
            for (int m = 0; m < 4; ++m)
#pragma unroll
                for (int bj = 0; bj < 2; ++bj) { const size_t off = (size_t)(u.pm * 256 + ai * 128 + wr * 64 + m * 16 + fr) * DM + u.pn * 256 + bj * 128 + wc * 32 + fq * 8;
                    sg[m][bj] = *(const u32x4*)(sig + off); if (STEP == 1) tv[m][bj] = *(const u32x4*)(ta + off); }
#pragma unroll
            for (int m = 0; m < 4; ++m)
#pragma unroll
                for (int bj = 0; bj < 2; ++bj) { const size_t off = (size_t)(u.pm * 256 + ai * 128 + wr * 64 + m * 16 + fr) * DM + u.pn * 256 + bj * 128 + wc * 32 + fq * 8;
                    const u32x4 s4 = sg[m][bj];
                    f32x4 a = acc[ai][bj][m][0], b = acc[ai][bj][m][1];
                    a[0] *= bflo(s4.x); a[1] *= bfhi(s4.x); a[2] *= bflo(s4.y); a[3] *= bfhi(s4.y); b[0] *= bflo(s4.z); b[1] *= bfhi(s4.z); b[2] *= bflo(s4.w); b[3] *= bfhi(s4.w);
                    if (STEP == 0) st_bf8(ta + off, a, b);
                    else { const u32x4 t4 = tv[m][bj]; a[0] += bflo(t4.x); a[1] += bfhi(t4.x); a[2] += bflo(t4.y); a[3] += bfhi(t4.y); b[0] += bflo(t4.z); b[1] += bfhi(t4.z); b[2] += bflo(t4.w); b[3] += bfhi(t4.w); st_bf8(merged + off, a, b); } }
        }
    }
};

struct EpiRes {
    static constexpr bool PERM = true, AFTER_DRAIN = false;
    const float* res; float* out; bf16_t* outb; float* ssq;
    DI void operator()(const Acc& acc, const Unit& u, int wr, int wc, int fr, int fq) const {
#pragma unroll
        for (int ai = 0; ai < 2; ++ai)
#pragma unroll
            for (int mh = 0; mh < 2; ++mh) {
                f32x4 rv[2][2][2];
#pragma unroll
                for (int mi = 0; mi < 2; ++mi)
#pragma unroll
                    for (int bj = 0; bj < 2; ++bj) { const size_t off = (size_t)(u.pm * 256 + ai * 128 + wr * 64 + (mh * 2 + mi) * 16 + fr) * DM + u.pn * 256 + bj * 128 + wc * 32 + fq * 8;
                        rv[mi][bj][0] = *(const f32x4*)(res + off); rv[mi][bj][1] = *(const f32x4*)(res + off + 4); }
#pragma unroll
                for (int mi = 0; mi < 2; ++mi) {
                    const int m = mh * 2 + mi; const int tok = u.pm * 256 + ai * 128 + wr * 64 + m * 16 + fr; float s = 0.f;
#pragma unroll
                    for (int bj = 0; bj < 2; ++bj) { const size_t off = (size_t)tok * DM + u.pn * 256 + bj * 128 + wc * 32 + fq * 8;
                        const f32x4 a = rv[mi][bj][0] + acc[ai][bj][m][0], b = rv[mi][bj][1] + acc[ai][bj][m][1];
                        s += sq4(a) + sq4(b);
                        *(f32x4*)(out + off) = a; *(f32x4*)(out + off + 4) = b;
                        if (outb) st_bf8(outb + off, a, b); }
                    s = red_fq(s);
                    if (fq == 0) atomicAdd(ssq + tok, s);
                }
            }
    }
};

struct Epi9 {
    static constexpr bool PERM = true, AFTER_DRAIN = false;
    bf16_t* hid; const float* ssq;
    DI void operator()(const Acc& acc, const Unit& u, int wr, int wc, int fr, int fq) const {
        float rs[2][4]; ld_rstd0(ssq, u, wr, fr, rs);
#pragma unroll
        for (int ai = 0; ai < 2; ++ai)
#pragma unroll
            for (int m = 0; m < 4; ++m) rs[ai][m] = rsqrtf(rs[ai][m] * (1.0f / 1024.0f) + EPS);
#pragma unroll
        for (int ai = 0; ai < 2; ++ai)
#pragma unroll
            for (int m = 0; m < 4; ++m) {
                const int tok = u.pm * 256 + ai * 128 + wr * 64 + m * 16 + fr;
                f32x4 o[2];
#pragma unroll
                for (int n = 0; n < 2; ++n)
#pragma unroll
                    for (int j = 0; j < 4; ++j) { const float g = acc[ai][0][m][n][j] * rs[ai][m], uu = acc[ai][1][m][n][j] * rs[ai][m]; o[n][j] = g * sigm(g) * uu; }
                st_bf8(hid + (size_t)tok * DFF + u.pn * 128 + wc * 32 + fq * 8, o[0], o[1]);
            }
    }
};

template <class Epi>
DI void run_gemm_at(LAS unsigned char* L, const int tid, int first, const bf16_t* A, const bf16_t* Bt, int M, int N, int K, const Epi& E) {
    pg8::Gemm g{A, Bt, M, N, K}; pg8::StaticOrder S; S.init(M, N, (int)gridDim.x, (int)((blockIdx.x + gridDim.x - first) % gridDim.x));
    pg8::gemm_phase<Epi, pg8::StaticOrder, true, true>(L, g, S, E, tid);
}
template <class Epi>
DI void run_gemm(LAS unsigned char* L, const int tid, const bf16_t* A, const bf16_t* Bt, int M, int N, int K, const Epi& E) {
    pg8::Gemm g{A, Bt, M, N, K}; pg8::StaticOrder S; S.init(M, N, (int)gridDim.x, (int)blockIdx.x);
    pg8::gemm_phase<Epi, pg8::StaticOrder, true, true>(L, g, S, E, tid);
}

template <int DQK> DI int ksw(int row, int c) { return DQK == 64 ? (c ^ ((row >> 1) & 7)) : DQK == 96 ? (c ^ ((row >> 2) & 3)) : (c ^ (row & 15)); }

template <int DQK, int DV, int MODE>
DI void attn_block(const bf16_t* __restrict__ Q, int ldq, const bf16_t* __restrict__ Kp, int ldk, const bf16_t* __restrict__ Vt, int ldv,
                   bf16_t* __restrict__ O, int ldo, int q0, int ntiles, char* lds, const int tid) {
    constexpr int NCK = DQK / 8, KB = 64 * DQK * 2, VB = DV * 128, STG = KB + VB, NKC = 64 * NCK, NKL = (NKC + NTHR - 1) / NTHR, NVL = DV * 8 / NTHR, NKK = DQK / 16, NDT = DV / 32;
    const int t = tid, lane = t & 63, w = t >> 6, fr = lane & 31, fh = lane >> 5;
    const int qrow = q0 + w * 32 + fr;
    const int qlo = q0 + w * 32, qhi = qlo + 31;
    unsigned* flags = (unsigned*)(lds + 2 * STG);
    bf16x8 qf[NKK];
#pragma unroll
    for (int kk = 0; kk < NKK; ++kk) qf[kk] = *(const bf16x8*)(Q + (size_t)qrow * ldq + kk * 16 + fh * 8);
    f32x16 o[NDT];
#pragma unroll
    for (int d = 0; d < NDT; ++d)
#pragma unroll
        for (int r = 0; r < 16; ++r) o[d][r] = 0.f;
    float l_run = 0.f;
    f32x16 negm;
#pragma unroll
    for (int r = 0; r < 16; ++r) negm[r] = 0.f;
    bool first = true;
    float m_run = -1e30f;
    u32x4 rk[NKL], rv[NVL];
    auto gload = [&](int kt) {
        const int key0 = kt * 64;
#pragma unroll
        for (int i = 0; i < NKL; ++i) { const int id = t + NTHR * i; if (NKC % NTHR == 0 || id < NKC) { const int row = id / NCK, c = id - row * NCK; rk[i] = *(const u32x4*)(Kp + (size_t)(key0 + row) * ldk + c * 8); } }
#pragma unroll
        for (int i = 0; i < NVL; ++i) { const int id = t + NTHR * i; const int row = id >> 3, c = id & 7; rv[i] = *(const u32x4*)(Vt + (size_t)row * ldv + key0 + c * 8); }
    };
    auto sstore = [&](char* buf) {
#pragma unroll
        for (int i = 0; i < NKL; ++i) { const int id = t + NTHR * i; if (NKC % NTHR == 0 || id < NKC) { const int row = id / NCK, c = id - row * NCK; *(u32x4*)(buf + row * (DQK * 2) + (ksw<DQK>(row, c) << 4)) = rk[i]; } }
#pragma unroll
        for (int i = 0; i < NVL; ++i) { const int id = t + NTHR * i; const int row = id >> 3, c = id & 7; const int g2 = (c >> 1) * 2, a = c & 1, sw = (row >> 1) & 7;
            char* rb_ = buf + KB + row * 128 + a * 8;
            u32x2 lo2, hi2; lo2.x = rv[i].x; lo2.y = rv[i].y; hi2.x = rv[i].z; hi2.y = rv[i].w;
            *(u32x2*)(rb_ + ((g2 ^ sw) << 4)) = lo2; *(u32x2*)(rb_ + (((g2 + 1) ^ sw) << 4)) = hi2; }
    };
    auto tile_of = [&](int it) { return MODE == 1 ? (ntiles - 1 - it) : it; };
    gload(tile_of(0)); sstore(lds); __syncthreads();
    for (int it = 0; it < ntiles; ++it) {
        const int kt = tile_of(it), key0 = kt * 64;
        const char* buf = lds + (it & 1) * STG;
        const bool more = it + 1 < ntiles;
        if (more && MODE != 2) gload(tile_of(it + 1));
        bool active;
        if (MODE == 0) active = key0 <= qhi; else if (MODE == 1) active = key0 < qhi && !(__all(l_run > 152.f) != 0); else active = true;
        if (active) {
            f32x16 s[2];
            if (MODE != 0) {
#pragma unroll
                for (int mt = 0; mt < 2; ++mt)
#pragma unroll
                    for (int r = 0; r < 16; ++r) s[mt][r] = 0.f;
            }
#pragma unroll
            for (int kk = 0; kk < NKK; ++kk)
#pragma unroll
                for (int mt = 0; mt < 2; ++mt) { const int row = mt * 32 + fr; const bf16x8 kf = *(const bf16x8*)(buf + row * (DQK * 2) + (ksw<DQK>(row, kk * 2 + fh) << 4));
                    if (MODE == 0 && kk == 0) s[mt] = MFMA(kf, qf[kk], negm); else s[mt] = MFMA(kf, qf[kk], s[mt]); }
            bf16x8 pf[4];
            if (MODE != 1) {
                if (MODE == 0 && key0 + 63 > qlo) {
#pragma unroll
                    for (int mt = 0; mt < 2; ++mt)
#pragma unroll
                        for (int r = 0; r < 16; ++r) { const int key = key0 + mt * 32 + (r >> 2) * 8 + fh * 4 + (r & 3); if (key > qrow) s[mt][r] = -1e30f; }
                }
                float mx = s[0][0];
#pragma unroll
                for (int mt = 0; mt < 2; ++mt)
#pragma unroll
                    for (int r = 0; r < 16; ++r) mx = fmaxf(mx, s[mt][r]);
                mx = fmaxf(mx, shx32(mx));
                if (MODE == 2) {
                    if (__any(mx > m_run + 8.f)) {
                        const float mnew = fmaxf(m_run, mx); const float alpha = ex2(m_run - mnew); m_run = mnew; l_run *= alpha;
#pragma unroll
                        for (int d = 0; d < NDT; ++d)
#pragma unroll
                            for (int r = 0; r < 16; ++r) o[d][r] *= alpha;
                    }
#pragma unroll
                    for (int mt = 0; mt < 2; ++mt)
#pragma unroll
                        for (int r = 0; r < 16; ++r) s[mt][r] -= m_run;
                } else
                if (first || __any(mx > 8.f)) {
                    const float delta = first ? mx : fmaxf(mx, 0.f); const float alpha = first ? 1.f : ex2(-delta); l_run *= alpha; first = false;
#pragma unroll
                    for (int d = 0; d < NDT; ++d)
#pragma unroll
                        for (int r = 0; r < 16; ++r) o[d][r] *= alpha;
#pragma unroll
                    for (int mt = 0; mt < 2; ++mt)
#pragma unroll
                        for (int r = 0; r < 16; ++r) s[mt][r] -= delta;
#pragma unroll
                    for (int r = 0; r < 16; ++r) negm[r] -= delta;
                }
                float sum = 0.f;
#pragma unroll
                for (int mt = 0; mt < 2; ++mt)
#pragma unroll
                    for (int r = 0; r < 16; ++r) { const float pv = ex2(s[mt][r]); s[mt][r] = pv; sum += pv; }
                l_run += sum;
            } else {
                const bool diag = key0 + 63 >= qlo;
                float G[8];
#pragma unroll
                for (int mt = 0; mt < 2; ++mt)
#pragma unroll
                    for (int rg = 0; rg < 4; ++rg) {
                        float g = 0.f;
#pragma unroll
                        for (int j = 3; j >= 0; --j) { const int r = rg * 4 + j; const float z = s[mt][r];
                            const float wv = lg2(1.f + ex2(-fabsf(z)));
                            float nlom = fmaxf(z, 0.f) + wv; float nl = nlom - z;
                            if (diag) { const int key = key0 + mt * 32 + rg * 8 + fh * 4 + j; if (key >= qrow) { nlom = 0.f; nl = 1e30f; } }
                            s[mt][r] = nl + g; g += nlom; }
                        G[mt * 4 + rg] = g;
                    }
                float base[8]; float run = l_run;
#pragma unroll
                for (int oc = 7; oc >= 0; --oc) { const float gp = shx32(G[oc]); base[oc] = run + (fh == 0 ? gp : 0.f); run += G[oc] + gp; }
                l_run = run;
#pragma unroll
                for (int mt = 0; mt < 2; ++mt)
#pragma unroll
                    for (int r = 0; r < 16; ++r) s[mt][r] = ex2(-(s[mt][r] + base[mt * 4 + (r >> 2)]));
            }
#pragma unroll
            for (int s4 = 0; s4 < 4; ++s4) { u32x4 pk; const int mt = s4 >> 1, rb = (s4 & 1) * 8;
                pk.x = pk2(s[mt][rb], s[mt][rb + 1]); pk.y = pk2(s[mt][rb + 2], s[mt][rb + 3]); pk.z = pk2(s[mt][rb + 4], s[mt][rb + 5]); pk.w = pk2(s[mt][rb + 6], s[mt][rb + 7]);
                pf[s4] = __builtin_bit_cast(bf16x8, pk); }
#pragma unroll
            for (int s4 = 0; s4 < 4; ++s4)
#pragma unroll
                for (int d = 0; d < NDT; ++d) { const int row = d * 32 + fr; const bf16x8 vf = *(const bf16x8*)(buf + KB + row * 128 + (((s4 * 2 + fh) ^ ((row >> 1) & 7)) << 4)); o[d] = MFMA(vf, pf[s4], o[d]); }
        }
        if (more) { if (MODE == 2) gload(tile_of(it + 1)); sstore(lds + ((it + 1) & 1) * STG); }
        if (MODE == 1) {
            const bool fin = __all(l_run > 152.f) != 0;
            if (lane == 0) flags[(it & 1) * NWV + w] = fin ? 1u : 0u;
            __syncthreads();
            const unsigned* f = flags + (it & 1) * NWV;
            if ((f[0] & f[1] & f[2] & f[3] & f[4] & f[5] & f[6] & f[7]) != 0u) break;
        } else {
            __syncthreads();
        }
    }
    float inv = 1.f;
    if (MODE != 1) { const float lt = l_run + shx32(l_run); inv = 1.f / lt; }
#pragma unroll
    for (int d = 0; d < NDT; ++d)
#pragma unroll
        for (int rg = 0; rg < 4; ++rg) st_bf4(O + (size_t)qrow * ldo + d * 32 + rg * 8 + fh * 4, o[d][rg * 4] * inv, o[d][rg * 4 + 1] * inv, o[d][rg * 4 + 2] * inv, o[d][rg * 4 + 3] * inv);
}

DI void phase3(const Params& p, char* lds, const int tid) {
    char* ws = p.ws;
    constexpr int NMLA = 32 * 16, NSB = 32 * 32;
    for (int u = blockIdx.x; u < NMLA + NSB; u += gridDim.x) {
        if (u < NMLA) {
            const int xcd = u & 7, v = u >> 3; const int pr = v & 15, bh = (v >> 4) * 8 + xcd; const int b = bh >> 3, h = bh & 7;
            const bf16_t* Q = (const bf16_t*)(ws + OFF_QA) + (size_t)b * SEQ * 768 + h * 96;
            const bf16_t* Kp = (const bf16_t*)(ws + OFF_KA) + (size_t)b * SEQ * 768 + h * 96;
            const bf16_t* Vt = (const bf16_t*)(ws + OFF_VTA) + (size_t)(h * 64) * T + (size_t)b * SEQ;
            bf16_t* O = (bf16_t*)(ws + OFF_OA) + (size_t)b * SEQ * 512 + h * 64;
#pragma unroll 1
            for (int half = 0; half < 2; ++half) { const int qb = half ? pr : 31 - pr;
                attn_block<96, 64, 0>(Q, 768, Kp, 768, Vt, T, O, 512, qb * 256, 4 * qb + 4, lds, tid); }
        } else {
            const int uu = u - NMLA; const int xcd = uu & 7, v = uu >> 3; const int qb = v & 31, bh = (v >> 5) * 8 + xcd; const int b = bh >> 3, h = bh & 7;
            const bf16_t* Q = (const bf16_t*)(ws + OFF_SBQ) + (size_t)b * SEQ * 512 + h * 64;
            const bf16_t* Kp = (const bf16_t*)(ws + OFF_SBK) + (size_t)b * SEQ * 512 + h * 64;
            const bf16_t* Vt = (const bf16_t*)(ws + OFF_VTB) + (size_t)(h * 64) * T + (size_t)b * SEQ;
            bf16_t* O = (bf16_t*)(ws + OFF_OB) + (size_t)b * SEQ * 512 + h * 64;
            attn_block<64, 64, 1>(Q, 512, Kp, 512, Vt, T, O, 512, qb * 256, 4 * qb + 4, lds, tid);
        }
    }
}

DI void phase7(const Params& p, char* lds, const int tid) {
    char* ws = p.ws;
    for (int u = blockIdx.x; u < 16 * 32; u += gridDim.x) {
        const int xcd = u & 7, v = u >> 3; const int qb = v & 31, bh = (v >> 5) * 8 + xcd; const int b = bh >> 2, h = bh & 3;
        const bf16_t* Q = (const bf16_t*)(ws + OFF_XQ) + (size_t)b * SEQ * 512 + h * 128;
        const bf16_t* Kp = (const bf16_t*)(ws + OFF_XK) + (size_t)b * MEML * 512 + h * 128;
        const bf16_t* Vt = (const bf16_t*)(ws + OFF_XVT) + (size_t)(h * 128) * MEMT + (size_t)b * MEML;
        bf16_t* O = (bf16_t*)(ws + OFF_XO) + (size_t)b * SEQ * 512 + h * 128;
        attn_block<128, 128, 2>(Q, 512, Kp, 512, Vt, MEMT, O, 512, qb * 256, 4, lds, tid);
    }
}

DI void phase11(const Params& p, const int tid) {
    const float* ssq3 = (const float*)(p.ws + OFF_SSQ3);
    for (size_t i = (size_t)blockIdx.x * NTHR + tid; i < (size_t)T * DM / 4; i += (size_t)gridDim.x * NTHR) {
        const int tok = (int)(i >> 8), c = (int)(i & 255) * 4;
        const float rs = rsqrtf(ssq3[tok] * (1.0f / DM) + EPS);
        f32x4 v = *(f32x4*)(p.out + i * 4); const f32x4 g = *(const f32x4*)(p.g_final + c);
        v[0] *= rs * g[0]; v[1] *= rs * g[1]; v[2] *= rs * g[2]; v[3] *= rs * g[3];
        *(f32x4*)(p.out + i * 4) = v;
    }
}

#define XB_TMO      128
#define XB_XCNT(j)  (256  + 64 * (j))
#define XB_XSUB(j)  (1280 + 64 * (j))
#define XB_XGEN(j)  (2304 + 64 * (j))
#define XB_TOP      3328
#define XB_TOPGEN   3392
#define XCD_BAR_WORDS 3456
#define XB_SPIN_CAP (1u << 22)
DI unsigned xb_ld(unsigned* p) { return __hip_atomic_load(p, __ATOMIC_RELAXED, __HIP_MEMORY_SCOPE_AGENT); }
DI unsigned xb_add(unsigned* p, unsigned v) { return __hip_atomic_fetch_add(p, v, __ATOMIC_RELAXED, __HIP_MEMORY_SCOPE_AGENT); }
DI unsigned xb_xcc_id() { return (unsigned)__builtin_amdgcn_s_getreg((3 << 11) | 20) & 0xFu; }
#define XB_SPIN(cond, bar) do { unsigned _sp = 0; while (cond) { __builtin_amdgcn_s_sleep(1); \
    if ((++_sp & 255u) == 0u) { if (xb_ld(&(bar)[XB_TMO])) break; if (_sp > XB_SPIN_CAP) { atomicAdd(&(bar)[XB_TMO], 1u); break; } } } } while (0)
struct XcdBarrier { unsigned* bar; unsigned x; volatile LAS unsigned* st; };
DI XcdBarrier xcd_barrier_post(unsigned* bar, volatile LAS unsigned* st, const int tid) {
    XcdBarrier b; b.bar = bar; b.x = xb_xcc_id(); b.st = st;
    if (tid == 0) (void)xb_add(&bar[XB_XCNT(b.x)], 1u);
    return b;
}
DI void xcd_barrier_complete(unsigned* bar, unsigned x, unsigned& nloc, unsigned& nx) {
    const unsigned G = gridDim.x * gridDim.y * gridDim.z;
    unsigned sum, cnt, mine, sp = 0u;
    for (;;) {
        sum = 0u; cnt = 0u; mine = 0u;
#pragma unroll
        for (unsigned j = 0; j < 16; ++j) { const unsigned c = xb_ld(&bar[XB_XCNT(j)]); sum += c; cnt += (c > 0u) ? 1u : 0u; mine = (j == x) ? c : mine; }
        if (sum == G) break;
        __builtin_amdgcn_s_sleep(1);
        if ((++sp & 255u) == 0u) { if (xb_ld(&bar[XB_TMO])) break; if (sp > XB_SPIN_CAP) { atomicAdd(&bar[XB_TMO], 1u); break; } }
    }
    nloc = mine > 0u ? mine : 1u; nx = cnt > 0u ? cnt : 1u;
}
DI void xcd_barrier(const XcdBarrier& b, const int tid) {
    asm volatile("s_waitcnt vmcnt(0)" ::: "memory");
    __syncthreads();
    if (tid == 0) {
        unsigned* bar = b.bar;
        __builtin_amdgcn_s_waitcnt(0);
        unsigned nloc = b.st[0], nx = b.st[1];
        if (nloc == 0u) { xcd_barrier_complete(bar, b.x, nloc, nx); b.st[0] = nloc; b.st[1] = nx; }
        const unsigned old = xb_add(&bar[XB_XSUB(b.x)], 1u);
        const unsigned gen = old / nloc;
        if (old + 1u == (gen + 1u) * nloc) {
            __builtin_amdgcn_fence(__ATOMIC_RELEASE, "agent");
            asm volatile("s_waitcnt vmcnt(0)" ::: "memory");
            const unsigned og = xb_add(&bar[XB_TOP], 1u);
            const unsigned tg = og / nx;
            if (og + 1u == (tg + 1u) * nx) xb_add(&bar[XB_TOPGEN], 1u);
            else XB_SPIN(xb_ld(&bar[XB_TOPGEN]) == tg, bar);
            __builtin_amdgcn_fence(__ATOMIC_ACQUIRE, "agent");
            xb_add(&bar[XB_XGEN(b.x)], 1u);
            asm volatile("s_waitcnt vmcnt(0)" ::: "memory");
        } else {
            XB_SPIN(xb_ld(&bar[XB_XGEN(b.x)]) == gen, bar);
            __builtin_amdgcn_fence(__ATOMIC_ACQUIRE, "agent");
            asm volatile("s_waitcnt vmcnt(0)" ::: "memory");
        }
    }
    __syncthreads();
}


constexpr int NPHASE = 12;
__global__ void __launch_bounds__(NTHR, 2) mega(Params p, int ph_lo, int ph_hi, int coop) {
    extern __shared__ __attribute__((aligned(16))) unsigned char dlds[];
    LAS unsigned char* L = (LAS unsigned char*)dlds;
    char* lds = (char*)dlds;
    char* ws = p.ws;
    const int swid = __builtin_amdgcn_readfirstlane((int)(threadIdx.x >> 6));
#define MYTID (swid * 64 + lane_id_fresh())
    volatile LAS unsigned* xbw = (volatile LAS unsigned*)(L + LDS_XB);
    if (threadIdx.x < 4) xbw[threadIdx.x] = 0u;
    __syncthreads();
    XcdBarrier xb; xb.bar = (unsigned*)(ws + OFF_BAR); xb.x = 0; xb.st = xbw;
    if (coop) xb = xcd_barrier_post((unsigned*)(ws + OFF_BAR), xbw, MYTID);
    if (coop == 2) cg::this_grid().sync();
#define PH(n, call) if (ph_lo <= n && n < ph_hi) { call; } if (coop && n + 1 < NPHASE) xcd_barrier(xb, MYTID);
    PH(0, phase0(p, lds, MYTID))
    PH(1, { run_gemm(L, MYTID, (const bf16_t*)(ws + OFF_XB), (const bf16_t*)(ws + OFF_WIN), T, 1536, DM, Epi1{ws, p.b_gate});
            run_gemm(L, MYTID, (const bf16_t*)(ws + OFF_XB), (const bf16_t*)(ws + OFF_WIN) + (size_t)1536 * DM, T, 2048, DM, EpiGate{ws, p.b_gate});
            run_gemm(L, MYTID, (const bf16_t*)(ws + OFF_WV), (const bf16_t*)(ws + OFF_XB), 512, T, DM, EpiVt<1>{(bf16_t*)(ws + OFF_VTB), T, (const float*)(ws + OFF_RSTD0)}); })
    PH(2, { run_gemm(L, MYTID, (const bf16_t*)(ws + OFF_CQ), (const bf16_t*)(ws + OFF_WUQ), T, 768, 256, Epi2q{ws});
            run_gemm(L, MYTID, (const bf16_t*)(ws + OFF_CKV), (const bf16_t*)(ws + OFF_WUK), T, 512, 256, EpiBf<2, true>{(bf16_t*)(ws + OFF_KA), 768, (const float*)(ws + OFF_SSQ_KV)});
            run_gemm(L, MYTID, (const bf16_t*)(ws + OFF_WUV), (const bf16_t*)(ws + OFF_CKV), 512, T, 256, EpiVt<2>{(bf16_t*)(ws + OFF_VTA), T, (const float*)(ws + OFF_SSQ_KV)});
            run_gemm_at(L, MYTID, 128, (const bf16_t*)(ws + OFF_MNB), (const bf16_t*)(ws + OFF_WXKV), MEMT, 512, DM, EpiBf<0, false>{(bf16_t*)(ws + OFF_XK), 512, nullptr});
            run_gemm_at(L, MYTID, 144, (const bf16_t*)(ws + OFF_WXKV) + (size_t)512 * DM, (const bf16_t*)(ws + OFF_MNB), 512, MEMT, DM, EpiVt<0>{(bf16_t*)(ws + OFF_XVT), MEMT, nullptr}); })
    PH(3, phase3(p, lds, MYTID))
    PH(4, { run_gemm(L, MYTID, (const bf16_t*)(ws + OFF_OA), (const bf16_t*)(ws + OFF_WA), T, DM, 512, Epi4<0>{(const bf16_t*)(ws + OFF_SIGA), (bf16_t*)(ws + OFF_VTA), nullptr});
            run_gemm(L, MYTID, (const bf16_t*)(ws + OFF_OB), (const bf16_t*)(ws + OFF_WB), T, DM, 512, Epi4<1>{(const bf16_t*)(ws + OFF_SIGB), (bf16_t*)(ws + OFF_VTA), (bf16_t*)(ws + OFF_MERGED)}); })
    PH(5, run_gemm(L, MYTID, (const bf16_t*)(ws + OFF_MERGED), (const bf16_t*)(ws + OFF_WO), T, DM, DM, EpiRes{p.x, p.out, (bf16_t*)(ws + OFF_X1B), (float*)(ws + OFF_SSQ1)}))
    PH(6, run_gemm(L, MYTID, (const bf16_t*)(ws + OFF_X1B), (const bf16_t*)(ws + OFF_WXQ), T, 512, DM, EpiBf<1, false>{(bf16_t*)(ws + OFF_XQ), 512, (const float*)(ws + OFF_SSQ1)}))
    PH(7, phase7(p, lds, MYTID))
    PH(8, run_gemm(L, MYTID, (const bf16_t*)(ws + OFF_XO), (const bf16_t*)(ws + OFF_WXO), T, DM, 512, EpiRes{p.out, p.out, (bf16_t*)(ws + OFF_X2B), (float*)(ws + OFF_SSQ2)}))
    PH(9, run_gemm(L, MYTID, (const bf16_t*)(ws + OFF_X2B), (const bf16_t*)(ws + OFF_WGU), T, 2 * DFF, DM, Epi9{(bf16_t*)(ws + OFF_HID), (const float*)(ws + OFF_SSQ2)}))
    PH(10, run_gemm(L, MYTID, (const bf16_t*)(ws + OFF_HID), (const bf16_t*)(ws + OFF_WD), T, DM, DFF, EpiRes{p.out, p.out, nullptr, (float*)(ws + OFF_SSQ3)}))
    PH(11, phase11(p, MYTID))
}

extern "C" void kernel_launch(void* const* d_in, const int* in_sizes, int n_in, void* d_out, int out_size, void* d_ws, size_t ws_size, hipStream_t stream) {
    static int grid_blocks = 0;
    if (!grid_blocks) {
        int dev = 0, cus = 0, per_cu = 0;
        (void)hipGetDevice(&dev);
        (void)hipDeviceGetAttribute(&cus, hipDeviceAttributeMultiprocessorCount, dev);
        (void)hipFuncSetAttribute((const void*)mega, hipFuncAttributeMaxDynamicSharedMemorySize, LDS_BYTES);
        (void)hipOccupancyMaxActiveBlocksPerMultiprocessor(&per_cu, mega, NTHR, LDS_BYTES);
        if (per_cu != 1) per_cu = 1;
        grid_blocks = cus * per_cu;
    }
    Params p{};
    p.x = (const float*)d_in[0]; p.mem = (const float*)d_in[1]; p.pos = (const int*)d_in[2];
    p.g_mix = (const float*)d_in[3]; p.w_in = (const float*)d_in[4]; p.b_gate = (const float*)d_in[5]; p.g_q_lat = (const float*)d_in[6]; p.w_uq = (const float*)d_in[7];
    p.g_kv_lat = (const float*)d_in[8]; p.w_ukv = (const float*)d_in[9]; p.w_a = (const float*)d_in[10]; p.w_b = (const float*)d_in[11]; p.w_o = (const float*)d_in[12];
    p.g_x = (const float*)d_in[13]; p.g_mem = (const float*)d_in[14]; p.w_xq = (const float*)d_in[15]; p.w_xkv = (const float*)d_in[16]; p.w_xo = (const float*)d_in[17];
    p.g_ffn = (const float*)d_in[18]; p.w_gate = (const float*)d_in[19]; p.w_up = (const float*)d_in[20]; p.w_down = (const float*)d_in[21]; p.g_final = (const float*)d_in[22];
    p.out = (float*)d_out; p.ws = (char*)d_ws;
#if ONE_LAUNCH
    int lo = 0, hi = NPHASE, coop = 1;
    (void)hipMemsetAsync((char*)d_ws + OFF_BAR, 0, XCD_BAR_WORDS * sizeof(unsigned), stream);
    void* args[] = {&p, &lo, &hi, &coop};
    hipError_t e = hipLaunchCooperativeKernel((void*)mega, dim3(grid_blocks), dim3(NTHR), args, LDS_BYTES, stream);
    if (e != hipSuccess) fprintf(stderr, "cooperative launch failed: %s (grid %d)\n", hipGetErrorString(e), grid_blocks);
#else
    for (int ph = 0; ph < NPHASE; ++ph) mega<<<dim3(grid_blocks), dim3(NTHR), LDS_BYTES, stream>>>(p, ph, ph + 1, 0);
#endif
}
```

```cpp
#include <hip/hip_runtime.h>
#include <hip/hip_cooperative_groups.h>
#include <cstdio>
#include <cstdint>
namespace cg = cooperative_groups;

#ifndef ONE_LAUNCH
#define ONE_LAUNCH 1
#endif

namespace pg8 {
#define PG8_LAS __attribute__((address_space(3)))
typedef unsigned short bf16_t;
typedef short bf16x8 __attribute__((ext_vector_type(8)));
typedef float f32x4 __attribute__((ext_vector_type(4)));
typedef unsigned u32x4 __attribute__((ext_vector_type(4)));
constexpr int BM = 256, BK = 64, HALF = 128, HTB = HALF * BK * 2  , STAGE_BYTES = 8 * HTB, NXCD = 8, WGM = 8;

__host__ __device__ __forceinline__ int lds_byte(int r, int c) { const int st = (r >> 4) * 2 + (c >> 5), rr = r & 15, cc = c & 31, ob = rr * 64 + cc * 2; return st * 1024 + (ob ^ (((ob >> 9) & 1) << 5)); }
__host__ __device__ __forceinline__ void stage_rc(int b, int& R, int& C) { const int st = b / 1024, sb = b % 1024, swz = sb ^ (((sb >> 9) & 1) << 5); R = (st >> 1) * 16 + swz / 64; C = (st & 1) * 32 + (swz % 64) / 2; }
__host__ __device__ __forceinline__ int perm32(int rho) { const int n = rho >> 4, i = rho & 15; return 8 * (i >> 2) + 4 * n + (i & 3); }

struct Unit { int pm, pn; };
struct Gemm { const bf16_t* A; const bf16_t* Bt; int M, N, K; };

struct StaticOrder {
    int nM, nN, nwg, G, c;
    __host__ __device__ void init(int M, int N, int G_, int c_) { nM = M / BM; nN = N / BM; nwg = nM * nN; G = G_; c = c_; }
    __host__ __device__ bool next(int i, Unit& u) const {
        const long L = (long)i * G + c; if (L >= nwg) return false;
        int wgid = (int)L; { const int q = nwg / NXCD, r = nwg % NXCD, xcd = wgid % NXCD, off = wgid / NXCD; wgid = (xcd < r ? xcd * (q + 1) : r * (q + 1) + (xcd - r) * q) + off; }
        const int nig = WGM * nN, gid = wgid / nig, fm = gid * WGM, gsz = (nM - fm) < WGM ? (nM - fm) : WGM;
        u.pm = fm + ((wgid % nig) % gsz); u.pn = (wgid % nig) / gsz; return true;
    }
    __device__ __forceinline__ void a_ready(const Unit&) const {}
    __device__ __forceinline__ void done(const Unit&) const {}
};


template <class Epi, class Sched, bool ALIGN_EPI = false, bool SP2 = false>
__device__ __forceinline__ void gemm_phase(PG8_LAS unsigned char* lds, const Gemm g, const Sched& S, const Epi& E, const int tid_in) {
    int tid_ = tid_in; asm volatile("" : "+v"(tid_));
    const int tid = tid_, wid = __builtin_amdgcn_readfirstlane(tid >> 6), lane = tid & 63, wr = wid >> 2, wc = wid & 3, fr = lane & 15, fq = lane >> 4;
    const int K = g.K, nt = K / BK;
    unsigned voffA[2], voffB[2];
#pragma unroll
    for (int i = 0; i < 2; ++i) { int R, C; stage_rc(tid * 16 + i * 8192, R, C); const int Rb = Epi::PERM ? ((R & ~31) + perm32(R & 31)) : R;
        voffA[i] = (unsigned)(R * K + C) * 2u; voffB[i] = (unsigned)(Rb * K + C) * 2u; }
    const size_t kstep = (size_t)(BK * 2);
    const size_t hstep = (size_t)HALF * K * 2;
    const size_t tstep = 2 * hstep;
    const unsigned ldsw = (unsigned)wid * 1024u;
    const int aoff = lds_byte(wr * 64 + fr, fq * 8), boff = lds_byte(wc * 32 + fr, fq * 8);
#define PG8_SA(b, h) (((b) * 2 + (h)) * HTB)
#define PG8_SB(b, h) ((4 + (b) * 2 + (h)) * HTB)
#define PG8_STAGE(bufoff, gbase, voff) do { _Pragma("unroll") for (int _i = 0; _i < 2; ++_i) \
        __builtin_amdgcn_global_load_lds((const unsigned*)((const char*)(gbase) + (voff)[_i]), (PG8_LAS unsigned*)(lds + (bufoff) + ldsw + _i * 8192), 16, 0, 0); } while (0)
#define PG8_LDA(dst, b, h) do { _Pragma("unroll") for (int m = 0; m < 4; ++m) _Pragma("unroll") for (int k = 0; k < 2; ++k) dst[m][k] = *(const PG8_LAS bf16x8*)(lds + PG8_SA(b, h) + aoff + m * 2048 + k * 1024); } while (0)
#define PG8_LDB(dst, b, h) do { _Pragma("unroll") for (int n = 0; n < 2; ++n) _Pragma("unroll") for (int k = 0; k < 2; ++k) dst[n][k] = *(const PG8_LAS bf16x8*)(lds + PG8_SB(b, h) + boff + n * 2048 + k * 1024); } while (0)
#define PG8_MMA(ai, bj, At, Bt) do { __builtin_amdgcn_s_setprio(1); _Pragma("unroll") for (int m = 0; m < 4; ++m) _Pragma("unroll") for (int n = 0; n < 2; ++n) _Pragma("unroll") for (int k = 0; k < 2; ++k) \
        acc[ai][bj][m][n] = __builtin_amdgcn_mfma_f32_16x16x32_bf16(Bt[n][k], At[m][k], acc[ai][bj][m][n], 0, 0, 0); __builtin_amdgcn_s_setprio(0); } while (0)
#define PG8_WAIT_V(n) asm volatile("s_waitcnt vmcnt(" #n ")" ::: "memory")
#define PG8_WAIT_L(n) asm volatile("s_waitcnt lgkmcnt(" #n ")" ::: "memory")
#define PG8_BAR __builtin_amdgcn_s_barrier()
#define PG8_SCHED __builtin_amdgcn_sched_barrier(0)
    Unit cur, nxt; int ui = 0;
    if (!S.next(0, cur)) return;
    f32x4 acc[2][2][4][2];
#pragma unroll
    for (int a = 0; a < 2; ++a)
#pragma unroll
        for (int b = 0; b < 2; ++b)
#pragma unroll
            for (int m = 0; m < 4; ++m)
#pragma unroll
                for (int n = 0; n < 2; ++n) acc[a][b][m][n] = (f32x4){0.f, 0.f, 0.f, 0.f};
    bf16x8 At[4][2], B0[2][2], B1[2][2];
    const char* cA = (const char*)g.A + (size_t)cur.pm * tstep; const char* cB = (const char*)g.Bt + (size_t)cur.pn * tstep;
    S.a_ready(cur);
    if constexpr (SP2) {
        PG8_STAGE(PG8_SB(0, 0), cB, voffB); PG8_STAGE(PG8_SB(0, 1), cB + hstep, voffB); PG8_STAGE(PG8_SA(0, 0), cA, voffA); PG8_STAGE(PG8_SA(0, 1), cA + hstep, voffA);
        if (wr == 1) PG8_BAR;
        PG8_WAIT_V(2); PG8_BAR;
        PG8_STAGE(PG8_SB(1, 0), cB + kstep, voffB); PG8_STAGE(PG8_SA(1, 0), cA + kstep, voffA); PG8_STAGE(PG8_SB(1, 1), cB + hstep + kstep, voffB);
        PG8_WAIT_V(6); PG8_BAR;
    } else {
        PG8_STAGE(PG8_SB(0, 0), cB, voffB); PG8_STAGE(PG8_SA(0, 0), cA, voffA); PG8_STAGE(PG8_SB(0, 1), cB + hstep, voffB); PG8_STAGE(PG8_SA(0, 1), cA + hstep, voffA);
        if (wr == 1) PG8_BAR;
        PG8_WAIT_V(4); PG8_BAR;
        PG8_STAGE(PG8_SB(1, 0), cB + kstep, voffB); PG8_STAGE(PG8_SA(1, 0), cA + kstep, voffA); PG8_STAGE(PG8_SB(1, 1), cB + hstep + kstep, voffB);
        PG8_WAIT_V(6); PG8_BAR;
    }
    for (;;) {
        const bool has_next = S.next(ui + 1, nxt);
        const char* nA = has_next ? (const char*)g.A + (size_t)nxt.pm * tstep : cA; const char* nB = has_next ? (const char*)g.Bt + (size_t)nxt.pn * tstep : cB;
        for (int t = 0; t < nt; t += 2) {
            const bool last = (t == nt - 2);
            const char* a1 = cA + (size_t)(t + 1) * kstep;
            const char* a2 = last ? nA : cA + (size_t)(t + 2) * kstep; const char* b2 = last ? nB : cB + (size_t)(t + 2) * kstep;
            const char* a3 = a2 + kstep; const char* b3 = b2 + kstep;
            if (last && has_next) S.a_ready(nxt);
            if constexpr (SP2) {
            PG8_LDB(B0, 0, 0); PG8_LDB(B1, 0, 1); PG8_SCHED; PG8_LDA(At, 0, 0); PG8_STAGE(PG8_SA(1, 1), a1 + hstep, voffA);
            PG8_WAIT_V(8); PG8_WAIT_L(0); PG8_BAR; PG8_MMA(0, 0, At, B0); PG8_MMA(0, 1, At, B1); PG8_BAR; PG8_SCHED;
            PG8_LDA(At, 0, 1); PG8_STAGE(PG8_SB(0, 0), b2, voffB); PG8_STAGE(PG8_SB(0, 1), b2 + hstep, voffB); PG8_STAGE(PG8_SA(0, 0), a2, voffA);
            PG8_WAIT_V(8); PG8_WAIT_L(0); PG8_BAR; PG8_MMA(1, 0, At, B0); PG8_MMA(1, 1, At, B1); PG8_BAR; PG8_SCHED;
            PG8_LDB(B0, 1, 0); PG8_LDB(B1, 1, 1); PG8_SCHED; PG8_LDA(At, 1, 0); PG8_STAGE(PG8_SA(0, 1), a2 + hstep, voffA);
            PG8_WAIT_V(8); PG8_WAIT_L(0); PG8_BAR; PG8_MMA(0, 0, At, B0); PG8_MMA(0, 1, At, B1); PG8_BAR; PG8_SCHED;
            PG8_LDA(At, 1, 1); PG8_STAGE(PG8_SB(1, 0), b3, voffB); PG8_STAGE(PG8_SB(1, 1), b3 + hstep, voffB); PG8_STAGE(PG8_SA(1, 0), a3, voffA);
            PG8_WAIT_V(8); PG8_WAIT_L(0); PG8_BAR; PG8_MMA(1, 0, At, B0); PG8_MMA(1, 1, At, B1); PG8_BAR; PG8_SCHED;
            } else {
            PG8_LDB(B0, 0, 0); PG8_SCHED; PG8_LDA(At, 0, 0); PG8_STAGE(PG8_SA(1, 1), a1 + hstep, voffA);
            PG8_WAIT_L(8); PG8_BAR; PG8_WAIT_L(0); PG8_MMA(0, 0, At, B0); PG8_BAR; PG8_SCHED;
            PG8_LDB(B1, 0, 1); PG8_STAGE(PG8_SB(0, 0), b2, voffB);
            PG8_BAR; PG8_WAIT_L(0); PG8_MMA(0, 1, At, B1); PG8_BAR;
            PG8_LDA(At, 0, 1); PG8_STAGE(PG8_SA(0, 0), a2, voffA);
            PG8_BAR; PG8_WAIT_L(0); PG8_MMA(1, 0, At, B0); PG8_BAR; PG8_SCHED;
            PG8_STAGE(PG8_SB(0, 1), b2 + hstep, voffB);
            PG8_WAIT_V(6); PG8_BAR; PG8_MMA(1, 1, At, B1); PG8_BAR;
            PG8_LDB(B0, 1, 0); PG8_SCHED; PG8_LDA(At, 1, 0); PG8_STAGE(PG8_SA(0, 1), a2 + hstep, voffA);
            PG8_WAIT_L(8); PG8_BAR; PG8_WAIT_L(0); PG8_MMA(0, 0, At, B0); PG8_BAR; PG8_SCHED;
            PG8_LDB(B1, 1, 1); PG8_STAGE(PG8_SB(1, 0), b3, voffB);
            PG8_BAR; PG8_WAIT_L(0); PG8_MMA(0, 1, At, B1); PG8_BAR;
            PG8_LDA(At, 1, 1); PG8_STAGE(PG8_SA(1, 0), a3, voffA);
            PG8_BAR; PG8_WAIT_L(0); PG8_MMA(1, 0, At, B0); PG8_BAR; PG8_SCHED;
            PG8_STAGE(PG8_SB(1, 1), b3 + hstep, voffB);
            PG8_WAIT_V(6); PG8_BAR; PG8_MMA(1, 1, At, B1); PG8_BAR;
            }
        }
        if constexpr (ALIGN_EPI) { if (wr == 0) PG8_BAR; }
        if constexpr (!Epi::AFTER_DRAIN) { int fr2 = fr, fq2 = fq; asm volatile("" : "+v"(fr2), "+v"(fq2));
            E(acc, cur, wr, wc, fr2, fq2); S.done(cur); }
        if (!has_next) break;
#pragma unroll
        for (int a = 0; a < 2; ++a)
#pragma unroll
            for (int b = 0; b < 2; ++b)
#pragma unroll
                for (int m = 0; m < 4; ++m)
#pragma unroll
                    for (int n = 0; n < 2; ++n) acc[a][b][m][n] = (f32x4){0.f, 0.f, 0.f, 0.f};
        cur = nxt; cA = nA; cB = nB; ++ui;
        if constexpr (ALIGN_EPI) { if (wr == 1) PG8_BAR; }
    }
    PG8_WAIT_V(0);
    if constexpr (!ALIGN_EPI) { if (wr == 0) PG8_BAR; }
    PG8_BAR;
    if constexpr (Epi::AFTER_DRAIN) { E.fused(acc, cur, wr, wc, fr, fq, lds, wid, lane); S.done(cur); }
#undef PG8_SA
#undef PG8_SB
#undef PG8_STAGE
#undef PG8_LDA
#undef PG8_LDB
#undef PG8_MMA
#undef PG8_WAIT_V
#undef PG8_WAIT_L
#undef PG8_BAR
#undef PG8_SCHED
}
}


typedef unsigned short bf16_t;
typedef short bf16x8 __attribute__((ext_vector_type(8)));
typedef float f32x16 __attribute__((ext_vector_type(16)));
typedef float f32x4 __attribute__((ext_vector_type(4)));
typedef float f32x2 __attribute__((ext_vector_type(2)));
typedef unsigned u32x4 __attribute__((ext_vector_type(4)));
typedef unsigned u32x2 __attribute__((ext_vector_type(2)));
typedef __bf16 bf16x2_t __attribute__((ext_vector_type(2)));
#define DI __device__ __forceinline__
#define LAS __attribute__((address_space(3)))
#define MFMA(a, b, c) __builtin_amdgcn_mfma_f32_32x32x16_bf16((a), (b), (c), 0, 0, 0)
using pg8::Unit;

constexpr int T = 32768, SEQ = 8192, NB = 4, DM = 1024, MEMT = 1024, MEML = 256;
constexpr int DFF = 2816;
constexpr int NTHR = 512, NWV = 8;
constexpr float EPS = 1e-6f;
constexpr float LOG2E = 1.4426950408889634f;
constexpr int LDS_BYTES = 147456;
constexpr int LDS_XB = 131072 + 1024;

constexpr size_t MB = 1024 * 1024;
constexpr size_t OFF_SSQ_Q = 0;
constexpr size_t OFF_SSQ_KV = OFF_SSQ_Q + T * 4;
constexpr size_t OFF_SSQ1 = OFF_SSQ_KV + T * 4;
constexpr size_t OFF_SSQ2 = OFF_SSQ1 + T * 4;
constexpr size_t OFF_SSQ3 = OFF_SSQ2 + T * 4;
constexpr size_t OFF_RSTD0 = OFF_SSQ3 + T * 4;
constexpr size_t OFF_BAR = 832 * 1024;
constexpr size_t OFF_CS = 1 * MB;
constexpr size_t OFF_WIN = 5 * MB;
constexpr size_t OFF_WV = OFF_WIN + 7 * MB;
constexpr size_t OFF_WUQ = OFF_WV + 1 * MB;
constexpr size_t OFF_WUK = OFF_WUQ + 768 * 256 * 2;
constexpr size_t OFF_WUV = OFF_WUK + 512 * 256 * 2;
constexpr size_t OFF_WA = OFF_WUV + 512 * 256 * 2;
constexpr size_t OFF_WB = OFF_WA + 1 * MB;
constexpr size_t OFF_WO = OFF_WB + 1 * MB;
constexpr size_t OFF_WXQ = OFF_WO + 2 * MB;
constexpr size_t OFF_WXKV = OFF_WXQ + 1 * MB;
constexpr size_t OFF_WXO = OFF_WXKV + 2 * MB;
constexpr size_t OFF_WGU = OFF_WXO + 1 * MB;
constexpr size_t OFF_WD = OFF_WGU + 11 * MB;
constexpr size_t OFF_MNB = OFF_WD + 6 * MB;
constexpr size_t OFF_XK = OFF_MNB + 2 * MB;
constexpr size_t OFF_XVT = OFF_XK + 1 * MB;
constexpr size_t OFF_ACT = 48 * MB;
static_assert(OFF_XVT + 1 * MB <= OFF_ACT, "ws map");
constexpr size_t OFF_XB = OFF_ACT;
constexpr size_t OFF_OA = OFF_XB;
constexpr size_t OFF_OB = OFF_XB + 32 * MB;
constexpr size_t OFF_CQ = OFF_XB + 64 * MB;
constexpr size_t OFF_CKV = OFF_CQ + 16 * MB;
constexpr size_t OFF_KA = OFF_CKV + 16 * MB;
constexpr size_t OFF_QA = OFF_KA + 48 * MB;
constexpr size_t OFF_VTA = OFF_QA + 48 * MB;
constexpr size_t OFF_SBQ = OFF_VTA + 32 * MB;
constexpr size_t OFF_SBK = OFF_SBQ + 32 * MB;
constexpr size_t OFF_VTB = OFF_SBK + 32 * MB;
constexpr size_t OFF_SIGA = OFF_VTB + 32 * MB;
constexpr size_t OFF_SIGB = OFF_SIGA + 64 * MB;
constexpr size_t WS_END = OFF_SIGB + 64 * MB;
static_assert(WS_END <= 512 * MB, "ws map");
constexpr size_t OFF_MERGED = OFF_KA;
constexpr size_t OFF_X1B = OFF_VTA;
constexpr size_t OFF_XQ = OFF_SBK;
constexpr size_t OFF_XO = OFF_VTB;
constexpr size_t OFF_X2B = OFF_SIGA;
constexpr size_t OFF_HID = OFF_KA;

struct Params {
    const float* x; const float* mem; const int* pos;
    const float* g_mix; const float* w_in; const float* b_gate; const float* g_q_lat; const float* w_uq;
    const float* g_kv_lat; const float* w_ukv; const float* w_a; const float* w_b; const float* w_o;
    const float* g_x; const float* g_mem; const float* w_xq; const float* w_xkv; const float* w_xo;
    const float* g_ffn; const float* w_gate; const float* w_up; const float* w_down; const float* g_final;
    float* out; char* ws;
};

DI unsigned pk2(float a, float b) { f32x2 v = {a, b}; bf16x2_t r = __builtin_convertvector(v, bf16x2_t); return __builtin_bit_cast(unsigned, r); }
DI bf16_t bf1(float a) { return (bf16_t)(pk2(a, 0.f) & 0xffffu); }
DI float ex2(float x) { return __builtin_amdgcn_exp2f(x); }
DI float lg2(float x) { return __builtin_amdgcn_logf(x); }
DI float shx32(float v) { return __shfl_xor(v, 32); }
DI int lane_id_fresh() { int l; asm volatile("v_mbcnt_lo_u32_b32 %0, -1, 0\n\tv_mbcnt_hi_u32_b32 %0, -1, %0" : "=v"(l)); return l; }
DI float bflo(unsigned u) { return __uint_as_float(u << 16); }
DI float bfhi(unsigned u) { return __uint_as_float(u & 0xffff0000u); }
DI void st_bf4(bf16_t* d, float a, float b, float c, float e) { u32x2 o; o.x = pk2(a, b); o.y = pk2(c, e); *(u32x2*)d = o; }
DI void st_bf8(bf16_t* d, const f32x4& a, const f32x4& b) { u32x4 o; o.x = pk2(a[0], a[1]); o.y = pk2(a[2], a[3]); o.z = pk2(b[0], b[1]); o.w = pk2(b[2], b[3]); *(u32x4*)d = o; }

struct WT { const float* src; const float* g; bf16_t* dst; int N, sc, k0, K, drow0; float scale; };
constexpr float SBQ_SCALE = LOG2E * 0.125f;
constexpr float MLAQ_SCALE = LOG2E * 0.10206207261596577f;
constexpr float XQ_SCALE = LOG2E * 0.08838834764831845f;
constexpr int J0 = 112 * 16;
constexpr int J1 = J0 + 16 * 16;
constexpr int J2 = J1 + 24 * 4;
constexpr int J3 = J2 + 16 * 4;
constexpr int J4 = J3 + 16 * 4;
constexpr int J5 = J4 + 32 * 8;
constexpr int J6 = J5 + 32 * 8;
constexpr int J7 = J6 + 32 * 16;
constexpr int J8 = J7 + 16 * 16;
constexpr int J9 = J8 + 32 * 16;
constexpr int J10 = J9 + 32 * 8;
constexpr int J11 = J10 + 176 * 16;
constexpr int J12 = J11 + 32 * 44;
DI WT wt_desc(const Params& p, int tl) {
    char* ws = p.ws; WT d; d.g = nullptr; d.scale = 1.f; d.src = p.w_in; d.dst = (bf16_t*)(ws + OFF_WIN); d.N = 4000; d.sc = -2; d.k0 = 0; d.K = 1024; d.drow0 = 0;
    if (tl >= J12) return d;
    if (tl < J0) { const int jk = tl / 112, jn = tl - jk * 112; const int d0 = jn * 32; int sc; float s = 1.f;
        if (d0 < 416) sc = d0; else if (d0 < 512) sc = -1; else if (d0 < 1536) { sc = d0 - 96; if (d0 < 1024) s = SBQ_SCALE; } else sc = d0 + 416;
        d.sc = sc; d.k0 = jk * 64; d.drow0 = d0; d.g = p.g_mix; d.scale = s; }
    else if (tl < J1) { const int u = tl - J0; const int jk = u >> 4, jn = u & 15; d.sc = 1440 + jn * 32; d.k0 = jk * 64; d.dst = (bf16_t*)(ws + OFF_WV); d.drow0 = jn * 32; d.g = p.g_mix; }
    else if (tl < J2) { const int u = tl - J1; const int jk = u / 24, jn = u - jk * 24; d.src = p.w_uq; d.N = 768; d.sc = jn * 32; d.k0 = jk * 64; d.dst = (bf16_t*)(ws + OFF_WUQ); d.K = 256; d.drow0 = jn * 32; d.g = p.g_q_lat; d.scale = MLAQ_SCALE; }
    else if (tl < J4) { const bool isv = tl >= J3; const int u = tl - (isv ? J3 : J2); const int jk = u >> 4, jn = u & 15; const int d0 = jn * 32;
        d.src = p.w_ukv; d.N = 1024; d.sc = jk < 2 ? (d0 >> 6) * 128 + (isv ? 64 : 0) + (d0 & 63) : -1; d.k0 = jk * 64; d.dst = (bf16_t*)(ws + (isv ? OFF_WUV : OFF_WUK)); d.K = 256; d.drow0 = d0; d.g = p.g_kv_lat; }
    else if (tl < J6) { const bool isb = tl >= J5; const int u = tl - (isb ? J5 : J4); const int jk = u >> 5, jn = u & 31;
        d.src = isb ? p.w_b : p.w_a; d.N = 1024; d.sc = jn * 32; d.k0 = jk * 64; d.dst = (bf16_t*)(ws + (isb ? OFF_WB : OFF_WA)); d.K = 512; d.drow0 = jn * 32; }
    else if (tl < J7) { const int u = tl - J6; const int jk = u >> 5, jn = u & 31; d.src = p.w_o; d.N = 1024; d.sc = jn * 32; d.k0 = jk * 64; d.dst = (bf16_t*)(ws + OFF_WO); d.drow0 = jn * 32; }
    else if (tl < J8) { const int u = tl - J7; const int jk = u >> 4, jn = u & 15; d.src = p.w_xq; d.N = 512; d.sc = jn * 32; d.k0 = jk * 64; d.dst = (bf16_t*)(ws + OFF_WXQ); d.drow0 = jn * 32; d.g = p.g_x; d.scale = XQ_SCALE; }
    else if (tl < J9) { const int u = tl - J8; const int jk = u >> 5, jn = u & 31; d.src = p.w_xkv; d.N = 1024; d.sc = jn * 32; d.k0 = jk * 64; d.dst = (bf16_t*)(ws + OFF_WXKV); d.drow0 = jn * 32; }
    else if (tl < J10) { const int u = tl - J9; const int jk = u >> 5, jn = u & 31; d.src = p.w_xo; d.N = 1024; d.sc = jn * 32; d.k0 = jk * 64; d.dst = (bf16_t*)(ws + OFF_WXO); d.K = 512; d.drow0 = jn * 32; }
    else if (tl < J11) { const int u = tl - J10; const int jk = u / 176, jn = u - jk * 176; const int d0 = jn * 32; const int rem = d0 & 255;
        d.src = (rem >= 128) ? p.w_up : p.w_gate; d.N = DFF; d.sc = (d0 >> 8) * 128 + (rem & 127); d.k0 = jk * 64; d.dst = (bf16_t*)(ws + OFF_WGU); d.drow0 = d0; d.g = p.g_ffn; }
    else { const int u = tl - J11; const int jk = u >> 5, jn = u & 31; d.src = p.w_down; d.N = 1024; d.sc = jn * 32; d.k0 = jk * 64; d.dst = (bf16_t*)(ws + OFF_WD); d.K = DFF; d.drow0 = jn * 32; }
    return d;
}
DI void wt_load(const WT& d, int t, float (&v)[8], float (&gv)[8]) {
    const int nn = t & 31, kb = t >> 5;
    const bool z = d.sc < 0; const int sc = z ? 0 : d.sc, ks = z ? 0 : d.k0;
    const float* gp = d.g ? d.g + ks : d.src;
#pragma unroll
    for (int i = 0; i < 8; ++i) { const int kk = kb + 8 * i; v[i] = d.src[(size_t)(ks + kk) * d.N + sc + nn]; gv[i] = gp[kk]; }
}
DI void wt_fix(const WT& d, float (&v)[8], const float (&gv)[8]) {
    const bool z = d.sc < 0;
#pragma unroll
    for (int i = 0; i < 8; ++i) { float x = v[i] * d.scale; if (d.g) x *= gv[i]; v[i] = z ? 0.f : x; }
}
DI void wt_put(float* l, int t, const float (&v)[8]) {
    const int nn = t & 31, kb = t >> 5;
#pragma unroll
    for (int i = 0; i < 8; ++i) l[(kb + 8 * i) * 33 + nn] = v[i];
}
DI void wt_store(const WT& d, int t, const float* l) {
    if (d.sc == -2) return;
    const int kk = t & 63, nb = t >> 6;
#pragma unroll
    for (int i = 0; i < 8; ++i) { const int nn = nb + 4 * i; d.dst[(size_t)(d.drow0 + nn) * d.K + d.k0 + kk] = bf1(l[kk * 33 + nn]); }
}

DI void phase0(const Params& p, char* ldsc, const int tid) {
    char* ws = p.ws;
    const int half = tid >> 8, t = tid & 255;
    float* l0 = (float*)ldsc + half * 2 * (64 * 33 + 16);
    float* l1 = l0 + (64 * 33 + 16);
    for (int base = blockIdx.x * 4; base < J12; base += gridDim.x * 4) {
        const WT d0 = wt_desc(p, base + half * 2), d1 = wt_desc(p, base + half * 2 + 1);
        float v0[8], v1[8], g0[8], g1[8];
        wt_load(d0, t, v0, g0); wt_load(d1, t, v1, g1);
        wt_fix(d0, v0, g0); wt_fix(d1, v1, g1);
        wt_put(l0, t, v0); wt_put(l1, t, v1);
        __syncthreads();
        wt_store(d0, t, l0); wt_store(d1, t, l1);
        __syncthreads();
    }
    {
        float* z = (float*)(ws + OFF_SSQ_Q);
        for (int i = blockIdx.x * NTHR + tid; i < 5 * T; i += gridDim.x * NTHR) z[i] = 0.f;
    }
    const int lane = tid & 63, w = tid >> 6;
    for (int row0 = (blockIdx.x * NWV + w) * 4; row0 < T + MEMT; row0 += gridDim.x * NWV * 4) {
        f32x4 v[4][4];
#pragma unroll
        for (int r = 0; r < 4; ++r) { const int row = row0 + r; const float* src = row >= T ? p.mem + (size_t)(row - T) * DM : p.x + (size_t)row * DM;
#pragma unroll
            for (int i = 0; i < 4; ++i) v[r][i] = *(const f32x4*)(src + i * 256 + lane * 4); }
#pragma unroll
        for (int r = 0; r < 4; ++r) {
            const int row = row0 + r; const bool ismem = row >= T;
            float ss = 0.f;
#pragma unroll
            for (int i = 0; i < 4; ++i) ss += v[r][i][0] * v[r][i][0] + v[r][i][1] * v[r][i][1] + v[r][i][2] * v[r][i][2] + v[r][i][3] * v[r][i][3];
#pragma unroll
            for (int o = 32; o >= 1; o >>= 1) ss += __shfl_xor(ss, o);
            const float rstd = rsqrtf(ss * (1.0f / DM) + EPS);
            if (!ismem) {
                bf16_t* d = (bf16_t*)(ws + OFF_XB) + (size_t)row * DM;
#pragma unroll
                for (int i = 0; i < 4; ++i) st_bf4(d + i * 256 + lane * 4, v[r][i][0], v[r][i][1], v[r][i][2], v[r][i][3]);
                if (lane == 0) ((float*)(ws + OFF_RSTD0))[row] = rstd;
                if (lane < 16) {
                    const float invf = exp2f(-(float)(2 * lane) * (13.287712379549449f / 32.0f));
                    const float ang = (float)p.pos[row] * invf;
                    const double a = (double)ang; const double kq = rint(a * 0.15915494309189535); const float rr = (float)(a - kq * 6.283185307179586);
                    f32x2 cs; cs.x = __cosf(rr); cs.y = __sinf(rr);
                    ((f32x2*)(ws + OFF_CS))[(size_t)row * 16 + lane] = cs;
                }
            } else {
                bf16_t* d = (bf16_t*)(ws + OFF_MNB) + (size_t)(row - T) * DM;
#pragma unroll
                for (int i = 0; i < 4; ++i) { const f32x4 g = *(const f32x4*)(p.g_mem + i * 256 + lane * 4);
                    st_bf4(d + i * 256 + lane * 4, v[r][i][0] * rstd * g[0], v[r][i][1] * rstd * g[1], v[r][i][2] * rstd * g[2], v[r][i][3] * rstd * g[3]); }
            }
        }
    }
}

typedef f32x4 Acc[2][2][4][2];
DI float sq4(const f32x4& v) { return v[0] * v[0] + v[1] * v[1] + v[2] * v[2] + v[3] * v[3]; }
DI float red_fq(float s) { s += __shfl_xor(s, 16); s += __shfl_xor(s, 32); return s; }
DI float sigm(float z) { return __builtin_amdgcn_rcpf(1.f + ex2(-z * LOG2E)); }

struct Epi1 {
    static constexpr bool PERM = false, AFTER_DRAIN = false;
    char* ws; const float* b_gate;
    DI void operator()(const Acc& acc, const Unit& u, int wr, int wc, int fr, int fq) const {
        const int pn = u.pn;
        float rsv[2][4];
#pragma unroll
        for (int ai = 0; ai < 2; ++ai)
#pragma unroll
            for (int m = 0; m < 4; ++m) rsv[ai][m] = ((const float*)(ws + OFF_RSTD0))[u.pm * 256 + ai * 128 + wr * 64 + m * 16 + fr];
#pragma unroll
        for (int ai = 0; ai < 2; ++ai)
#pragma unroll
            for (int m = 0; m < 4; ++m) {
                const int tok = u.pm * 256 + ai * 128 + wr * 64 + m * 16 + fr;
                const float rs = rsv[ai][m];
                if (pn <= 1) {
                    bf16_t* d = (bf16_t*)(ws + (pn == 0 ? OFF_CQ : OFF_CKV)) + (size_t)tok * 256 + wc * 32 + fq * 4;
                    float ssq = 0.f;
#pragma unroll
                    for (int bj = 0; bj < 2; ++bj)
#pragma unroll
                        for (int n = 0; n < 2; ++n) { const f32x4 v = acc[ai][bj][m][n] * rs; if (pn == 0 || bj == 0) ssq += sq4(v); st_bf4(d + bj * 128 + n * 16, v[0], v[1], v[2], v[3]); }
                    ssq = red_fq(ssq);
                    if (fq == 0) atomicAdd((float*)(ws + (pn == 0 ? OFF_SSQ_Q : OFF_SSQ_KV)) + tok, ssq);
                    if (pn == 1 && wc == 0) {
                        const f32x4 c01 = *(const f32x4*)(ws + OFF_CS + ((size_t)tok * 16 + fq * 4) * 8), c23 = *(const f32x4*)(ws + OFF_CS + ((size_t)tok * 16 + fq * 4 + 2) * 8);
                        const f32x4 x1 = acc[ai][1][m][0] * rs, x2 = acc[ai][1][m][1] * rs;
                        const float cs_[4] = {c01[0], c01[2], c23[0], c23[2]}, sn_[4] = {c01[1], c01[3], c23[1], c23[3]};
                        float lo[4], hi[4];
#pragma unroll
                        for (int j = 0; j < 4; ++j) { lo[j] = x1[j] * cs_[j] - x2[j] * sn_[j]; hi[j] = x2[j] * cs_[j] + x1[j] * sn_[j]; }
                        bf16_t* k = (bf16_t*)(ws + OFF_KA) + (size_t)tok * 768 + 64 + fq * 4;
#pragma unroll
                        for (int h = 0; h < 8; ++h) { st_bf4(k + h * 96, lo[0], lo[1], lo[2], lo[3]); st_bf4(k + h * 96 + 16, hi[0], hi[1], hi[2], hi[3]); }
                    }
                } else if (pn < 6) {
                    bf16_t* d = (bf16_t*)(ws + (pn < 4 ? OFF_SBQ : OFF_SBK)) + (size_t)tok * 512 + ((pn & 1) * 256) + wc * 32 + fq * 4;
#pragma unroll
                    for (int bj = 0; bj < 2; ++bj)
#pragma unroll
                        for (int n = 0; n < 2; ++n) { const f32x4 v = acc[ai][bj][m][n] * rs; st_bf4(d + bj * 128 + n * 16, v[0], v[1], v[2], v[3]); }
                } else {
                    const int gi = pn >= 10; const int c0 = (pn - (gi ? 10 : 6)) * 256 + wc * 32 + fq * 4;
                    bf16_t* d = (bf16_t*)(ws + (gi ? OFF_SIGB : OFF_SIGA)) + (size_t)tok * DM + c0;
                    const float* bg = b_gate + gi * DM + c0;
#pragma unroll
                    for (int bj = 0; bj < 2; ++bj)
#pragma unroll
                        for (int n = 0; n < 2; ++n) { const f32x4 bb = *(const f32x4*)(bg + bj * 128 + n * 16); const f32x4 v = acc[ai][bj][m][n] * rs + bb;
                            st_bf4(d + bj * 128 + n * 16, sigm(v[0]), sigm(v[1]), sigm(v[2]), sigm(v[3])); }
                }
            }
    }
};

DI void ld_rstd0(const float* rstd0, const Unit& u, int wr, int fr, float (&rs)[2][4]) {
#pragma unroll
    for (int ai = 0; ai < 2; ++ai)
#pragma unroll
        for (int m = 0; m < 4; ++m) rs[ai][m] = rstd0[u.pm * 256 + ai * 128 + wr * 64 + m * 16 + fr];
}
struct EpiGate {
    static constexpr bool PERM = true, AFTER_DRAIN = false;
    char* ws; const float* b_gate;
    DI void operator()(const Acc& acc, const Unit& u, int wr, int wc, int fr, int fq) const {
        const int gi = u.pn >= 4; const int cb = (u.pn & 3) * 256 + wc * 32 + fq * 8;
        bf16_t* outp = (bf16_t*)(ws + (gi ? OFF_SIGB : OFF_SIGA));
        float rs[2][4]; ld_rstd0((const float*)(ws + OFF_RSTD0), u, wr, fr, rs);
        f32x4 bb[2][2];
#pragma unroll
        for (int bj = 0; bj < 2; ++bj) { bb[bj][0] = *(const f32x4*)(b_gate + gi * DM + cb + bj * 128); bb[bj][1] = *(const f32x4*)(b_gate + gi * DM + cb + bj * 128 + 4); }
#pragma unroll
        for (int bj = 0; bj < 2; ++bj)
#pragma unroll
            for (int ai = 0; ai < 2; ++ai)
#pragma unroll
                for (int m = 0; m < 4; ++m) {
                    const int tok = u.pm * 256 + ai * 128 + wr * 64 + m * 16 + fr;
                    f32x4 a = acc[ai][bj][m][0] * rs[ai][m] + bb[bj][0], b = acc[ai][bj][m][1] * rs[ai][m] + bb[bj][1];
#pragma unroll
                    for (int j = 0; j < 4; ++j) { a[j] = sigm(a[j]); b[j] = sigm(b[j]); }
                    st_bf8(outp + (size_t)tok * DM + cb + bj * 128, a, b);
                }
    }
};

template <int SMODE>
struct EpiVt {
    static constexpr bool PERM = true, AFTER_DRAIN = false;
    bf16_t* out; int ldo; const float* sc;
    DI void operator()(const Acc& acc, const Unit& u, int wr, int wc, int fr, int fq) const {
#pragma unroll
        for (int bj = 0; bj < 2; ++bj) {
            const int col = u.pn * 256 + bj * 128 + wc * 32 + fq * 8;
            f32x4 s0 = {1.f, 1.f, 1.f, 1.f}, s1 = s0;
            if (SMODE >= 1) { s0 = *(const f32x4*)(sc + col); s1 = *(const f32x4*)(sc + col + 4); }
            if (SMODE == 2) {
#pragma unroll
                for (int j = 0; j < 4; ++j) { s0[j] = rsqrtf(s0[j] * (1.0f / 128.0f) + EPS); s1[j] = rsqrtf(s1[j] * (1.0f / 128.0f) + EPS); }
            }
#pragma unroll
            for (int ai = 0; ai < 2; ++ai)
#pragma unroll
                for (int m = 0; m < 4; ++m) { const int row = u.pm * 256 + ai * 128 + wr * 64 + m * 16 + fr;
                    st_bf8(out + (size_t)row * ldo + col, acc[ai][bj][m][0] * s0, acc[ai][bj][m][1] * s1); }
        }
    }
};

struct Epi2q {
    static constexpr bool PERM = false, AFTER_DRAIN = false;
    char* ws;
    DI void operator()(const Acc& acc, const Unit& u, int wr, int wc, int fr, int fq) const {
        float rs[2][4]; ld_rstd0((const float*)(ws + OFF_SSQ_Q), u, wr, fr, rs);
#pragma unroll
        for (int ai = 0; ai < 2; ++ai) {
#pragma unroll
            for (int m = 0; m < 4; ++m) rs[ai][m] = rsqrtf(rs[ai][m] * (1.0f / 256.0f) + EPS);
#pragma unroll
            for (int m = 0; m < 4; ++m) {
                const int tok = u.pm * 256 + ai * 128 + wr * 64 + m * 16 + fr;
                const f32x4 c01m = *(const f32x4*)(ws + OFF_CS + ((size_t)tok * 16 + fq * 4) * 8), c23m = *(const f32x4*)(ws + OFF_CS + ((size_t)tok * 16 + fq * 4 + 2) * 8);
#pragma unroll
                for (int bj = 0; bj < 2; ++bj) {
                    const int cg0 = u.pn * 256 + bj * 128 + wc * 32;
                    bf16_t* d = (bf16_t*)(ws + OFF_QA) + (size_t)tok * 768 + cg0 + fq * 4;
                    const f32x4 x1 = acc[ai][bj][m][0] * rs[ai][m], x2 = acc[ai][bj][m][1] * rs[ai][m];
                    if (((cg0 >> 5) % 3) == 2) {
                        const f32x4 a = c01m, b = c23m;
                        const float cs_[4] = {a[0], a[2], b[0], b[2]}, sn_[4] = {a[1], a[3], b[1], b[3]};
                        float lo[4], hi[4];
#pragma unroll
                        for (int j = 0; j < 4; ++j) { lo[j] = x1[j] * cs_[j] - x2[j] * sn_[j]; hi[j] = x2[j] * cs_[j] + x1[j] * sn_[j]; }
                        st_bf4(d, lo[0], lo[1], lo[2], lo[3]); st_bf4(d + 16, hi[0], hi[1], hi[2], hi[3]);
                    } else { st_bf4(d, x1[0], x1[1], x1[2], x1[3]); st_bf4(d + 16, x2[0], x2[1], x2[2], x2[3]); }
                }
            }
        }
    }
};

template <int RMODE  , bool KA  >
struct EpiBf {
    static constexpr bool PERM = true, AFTER_DRAIN = false;
    bf16_t* out; int ldo; const float* ssq;
    DI void operator()(const Acc& acc, const Unit& u, int wr, int wc, int fr, int fq) const {
        float rs[2][4];
        if (RMODE != 0) ld_rstd0(ssq, u, wr, fr, rs);
#pragma unroll
        for (int ai = 0; ai < 2; ++ai)
#pragma unroll
            for (int m = 0; m < 4; ++m) { if (RMODE == 0) rs[ai][m] = 1.f; if (RMODE == 1) rs[ai][m] = rsqrtf(rs[ai][m] * (1.0f / 1024.0f) + EPS); if (RMODE == 2) rs[ai][m] = rsqrtf(rs[ai][m] * (1.0f / 128.0f) + EPS); }
#pragma unroll
        for (int ai = 0; ai < 2; ++ai)
#pragma unroll
            for (int m = 0; m < 4; ++m) {
                const int tok = u.pm * 256 + ai * 128 + wr * 64 + m * 16 + fr;
#pragma unroll
                for (int bj = 0; bj < 2; ++bj) { int col = u.pn * 256 + bj * 128 + wc * 32 + fq * 8; if (KA) col = (col >> 6) * 96 + (col & 63);
                    st_bf8(out + (size_t)tok * ldo + col, acc[ai][bj][m][0] * rs[ai][m], acc[ai][bj][m][1] * rs[ai][m]); }
            }
    }
};

template <int STEP>
struct Epi4 {
    static constexpr bool PERM = true, AFTER_DRAIN = false;
    const bf16_t* sig; bf16_t* ta; bf16_t* merged;
    DI void operator()(const Acc& acc, const Unit& u, int wr, int wc, int fr, int fq) const {
#pragma unroll
        for (int ai = 0; ai < 2; ++ai) {
            u32x4 sg[4][2], tv[4][2];
#pragma unroll
            for (int m = 0; m < 4; ++m)
#pragma unroll
                for (int bj = 0; bj < 2; ++bj) { const size_t off = (size_t)(u.pm * 256 + ai * 128 + wr * 64 + m * 16 + fr) * DM + u.pn * 256 + bj * 128 + wc * 32 + fq * 8;
                    sg[m][bj] = *(const u32x4*)(sig + off); if (STEP == 1) tv[m][bj] = *(const u32x4*)(ta + off); }
#pragma unroll
            for (int m = 0; m < 4; ++m)
#pragma unroll
                for (int bj = 0; bj < 2; ++bj) { const size_t off = (size_t)(u.pm * 256 + ai * 128 + wr * 64 + m * 16 + fr) * DM + u.pn * 256 + bj * 128 + wc * 32 + fq * 8;
                    const u32x4 s4 = sg[m][bj];
                    f32x4 a = acc[ai][bj][m][0], b = acc[ai][bj][m][1];
                    a[0] *= bflo(s4.x); a[1] *= bfhi(s4.x); a[2] *= bflo(s4.y); a[3] *= bfhi(s4.y); b[0] *= bflo(s4.z); b[1] *= bfhi(s4.z); b[2] *= bflo(s4.w); b[3] *= bfhi(s4.w);
                    if (STEP == 0) st_bf8(ta + off, a, b);
                    else { const u32x4 t4 = tv[m][bj]; a[0] += bflo(t4.x); a[1] += bfhi(t4.x); a[2] += bflo(t4.y); a[3] += bfhi(t4.y); b[0] += bflo(t4.z); b[1] += bfhi(t4.z); b[2] += bflo(t4.w); b[3] += bfhi(t4.w); st_bf8(merged + off, a, b); } }
        }
    }
};

struct EpiRes {
    static constexpr bool PERM = true, AFTER_DRAIN = false;
    const float* res; float* out; bf16_t* outb; float* ssq;
    DI void operator()(const Acc& acc, const Unit& u, int wr, int wc, int fr, int fq) const {
#pragma unroll
        for (int ai = 0; ai < 2; ++ai)
#pragma unroll
            for (int mh = 0; mh < 2; ++mh) {
                f32x4 rv[2][2][2];
#pragma unroll
                for (int mi = 0; mi < 2; ++mi)
#pragma unroll
                    for (int bj = 0; bj < 2; ++bj) { const size_t off = (size_t)(u.pm * 256 + ai * 128 + wr * 64 + (mh * 2 + mi) * 16 + fr) * DM + u.pn * 256 + bj * 128 + wc * 32 + fq * 8;
                        rv[mi][bj][0] = *(const f32x4*)(res + off); rv[mi][bj][1] = *(const f32x4*)(res + off + 4); }
#pragma unroll
                for (int mi = 0; mi < 2; ++mi) {
                    const int m = mh * 2 + mi; const int tok = u.pm * 256 + ai * 128 + wr * 64 + m * 16 + fr; float s = 0.f;
#pragma unroll
                    for (int bj = 0; bj < 2; ++bj) { const size_t off = (size_t)tok * DM + u.pn * 256 + bj * 128 + wc * 32 + fq * 8;
                        const f32x4 a = rv[mi][bj][0] + acc[ai][bj][m][0], b = rv[mi][bj][1] + acc[ai][bj][m][1];
                        s += sq4(a) + sq4(b);
                        *(f32x4*)(out + off) = a; *(f32x4*)(out + off + 4) = b;
                        if (outb) st_bf8(outb + off, a, b); }
                    s = red_fq(s);
                    if (fq == 0) atomicAdd(ssq + tok, s);
                }
            }
    }
};

struct Epi9 {
    static constexpr bool PERM = true, AFTER_DRAIN = false;
    bf16_t* hid; const float* ssq;
    DI void operator()(const Acc& acc, const Unit& u, int wr, int wc, int fr, int fq) const {
        float rs[2][4]; ld_rstd0(ssq, u, wr, fr, rs);
#pragma unroll
        for (int ai = 0; ai < 2; ++ai)
#pragma unroll
            for (int m = 0; m < 4; ++m) rs[ai][m] = rsqrtf(rs[ai][m] * (1.0f / 1024.0f) + EPS);
#pragma unroll
        for (int ai = 0; ai < 2; ++ai)
#pragma unroll
            for (int m = 0; m < 4; ++m) {
                const int tok = u.pm * 256 + ai * 128 + wr * 64 + m * 16 + fr;
                f32x4 o[2];
#pragma unroll
                for (int n = 0; n < 2; ++n)
#pragma unroll
                    for (int j = 0; j < 4; ++j) { const float g = acc[ai][0][m][n][j] * rs[ai][m], uu = acc[ai][1][m][n][j] * rs[ai][m]; o[n][j] = g * sigm(g) * uu; }
                st_bf8(hid + (size_t)tok * DFF + u.pn * 128 + wc * 32 + fq * 8, o[0], o[1]);
            }
    }
};

template <class Epi>
DI void run_gemm_at(LAS unsigned char* L, const int tid, int first, const bf16_t* A, const bf16_t* Bt, int M, int N, int K, const Epi& E) {
    pg8::Gemm g{A, Bt, M, N, K}; pg8::StaticOrder S; S.init(M, N, (int)gridDim.x, (int)((blockIdx.x + gridDim.x - first) % gridDim.x));
    pg8::gemm_phase<Epi, pg8::StaticOrder, true, true>(L, g, S, E, tid);
}
template <class Epi>
DI void run_gemm(LAS unsigned char* L, const int tid, const bf16_t* A, const bf16_t* Bt, int M, int N, int K, const Epi& E) {
    pg8::Gemm g{A, Bt, M, N, K}; pg8::StaticOrder S; S.init(M, N, (int)gridDim.x, (int)blockIdx.x);
    pg8::gemm_phase<Epi, pg8::StaticOrder, true, true>(L, g, S, E, tid);
}

template <int DQK> DI int ksw(int row, int c) { return DQK == 64 ? (c ^ ((row >> 1) & 7)) : DQK == 96 ? (c ^ ((row >> 2) & 3)) : (c ^ (row & 15)); }

template <int DQK, int DV, int MODE>
DI void attn_block(const bf16_t* __restrict__ Q, int ldq, const bf16_t* __restrict__ Kp, int ldk, const bf16_t* __restrict__ Vt, int ldv,
                   bf16_t* __restrict__ O, int ldo, int q0, int ntiles, char* lds, const int tid) {
    constexpr int NCK = DQK / 8, KB = 64 * DQK * 2, VB = DV * 128, STG = KB + VB, NKC = 64 * NCK, NKL = (NKC + NTHR - 1) / NTHR, NVL = DV * 8 / NTHR, NKK = DQK / 16, NDT = DV / 32;
    const int t = tid, lane = t & 63, w = t >> 6, fr = lane & 31, fh = lane >> 5;
    const int qrow = q0 + w * 32 + fr;
    const int qlo = q0 + w * 32, qhi = qlo + 31;
    unsigned* flags = (unsigned*)(lds + 2 * STG);
    bf16x8 qf[NKK];
#pragma unroll
    for (int kk = 0; kk < NKK; ++kk) qf[kk] = *(const bf16x8*)(Q + (size_t)qrow * ldq + kk * 16 + fh * 8);
    f32x16 o[NDT];
#pragma unroll
    for (int d = 0; d < NDT; ++d)
#pragma unroll
        for (int r = 0; r < 16; ++r) o[d][r] = 0.f;
    float l_run = 0.f;
    f32x16 negm;
#pragma unroll
    for (int r = 0; r < 16; ++r) negm[r] = 0.f;
    bool first = true;
    float m_run = -1e30f;
    u32x4 rk[NKL], rv[NVL];
    auto gload = [&](int kt) {
        const int key0 = kt * 64;
#pragma unroll
        for (int i = 0; i < NKL; ++i) { const int id = t + NTHR * i; if (NKC % NTHR == 0 || id < NKC) { const int row = id / NCK, c = id - row * NCK; rk[i] = *(const u32x4*)(Kp + (size_t)(key0 + row) * ldk + c * 8); } }
#pragma unroll
        for (int i = 0; i < NVL; ++i) { const int id = t + NTHR * i; const int row = id >> 3, c = id & 7; rv[i] = *(const u32x4*)(Vt + (size_t)row * ldv + key0 + c * 8); }
    };
    auto sstore = [&](char* buf) {
#pragma unroll
        for (int i = 0; i < NKL; ++i) { const int id = t + NTHR * i; if (NKC % NTHR == 0 || id < NKC) { const int row = id / NCK, c = id - row * NCK; *(u32x4*)(buf + row * (DQK * 2) + (ksw<DQK>(row, c) << 4)) = rk[i]; } }
#pragma unroll
        for (int i = 0; i < NVL; ++i) { const int id = t + NTHR * i; const int row = id >> 3, c = id & 7; const int g2 = (c >> 1) * 2, a = c & 1, sw = (row >> 1) & 7;
            char* rb_ = buf + KB + row * 128 + a * 8;
            u32x2 lo2, hi2; lo2.x = rv[i].x; lo2.y = rv[i].y; hi2.x = rv[i].z; hi2.y = rv[i].w;
            *(u32x2*)(rb_ + ((g2 ^ sw) << 4)) = lo2; *(u32x2*)(rb_ + (((g2 + 1) ^ sw) << 4)) = hi2; }
    };
    auto tile_of = [&](int it) { return MODE == 1 ? (ntiles - 1 - it) : it; };
    gload(tile_of(0)); sstore(lds); __syncthreads();
    for (int it = 0; it < ntiles; ++it) {
        const int kt = tile_of(it), key0 = kt * 64;
        const char* buf = lds + (it & 1) * STG;
        const bool more = it + 1 < ntiles;
        if (more && MODE != 2) gload(tile_of(it + 1));
        bool active;
        if (MODE == 0) active = key0 <= qhi; else if (MODE == 1) active = key0 < qhi && !(__all(l_run > 152.f) != 0); else active = true;
        if (active) {
            f32x16 s[2];
            if (MODE != 0) {
#pragma unroll
                for (int mt = 0; mt < 2; ++mt)
#pragma unroll
                    for (int r = 0; r < 16; ++r) s[mt][r] = 0.f;
            }
#pragma unroll
            for (int kk = 0; kk < NKK; ++kk)
#pragma unroll
                for (int mt = 0; mt < 2; ++mt) { const int row = mt * 32 + fr; const bf16x8 kf = *(const bf16x8*)(buf + row * (DQK * 2) + (ksw<DQK>(row, kk * 2 + fh) << 4));
                    if (MODE == 0 && kk == 0) s[mt] = MFMA(kf, qf[kk], negm); else s[mt] = MFMA(kf, qf[kk], s[mt]); }
            bf16x8 pf[4];
            if (MODE != 1) {
                if (MODE == 0 && key0 + 63 > qlo) {
#pragma unroll
                    for (int mt = 0; mt < 2; ++mt)
#pragma unroll
                        for (int r = 0; r < 16; ++r) { const int key = key0 + mt * 32 + (r >> 2) * 8 + fh * 4 + (r & 3); if (key > qrow) s[mt][r] = -1e30f; }
                }
                float mx = s[0][0];
#pragma unroll
                for (int mt = 0; mt < 2; ++mt)
#pragma unroll
                    for (int r = 0; r < 16; ++r) mx = fmaxf(mx, s[mt][r]);
                mx = fmaxf(mx, shx32(mx));
                if (MODE == 2) {
                    if (__any(mx > m_run + 8.f)) {
                        const float mnew = fmaxf(m_run, mx); const float alpha = ex2(m_run - mnew); m_run = mnew; l_run *= alpha;
#pragma unroll
                        for (int d = 0; d < NDT; ++d)
#pragma unroll
                            for (int r = 0; r < 16; ++r) o[d][r] *= alpha;
                    }
#pragma unroll
                    for (int mt = 0; mt < 2; ++mt)
#pragma unroll
                        for (int r = 0; r < 16; ++r) s[mt][r] -= m_run;
                } else
                if (first || __any(mx > 8.f)) {
                    const float delta = first ? mx : fmaxf(mx, 0.f); const float alpha = first ? 1.f : ex2(-delta); l_run *= alpha; first = false;
#pragma unroll
                    for (int d = 0; d < NDT; ++d)
#pragma unroll
                        for (int r = 0; r < 16; ++r) o[d][r] *= alpha;
#pragma unroll
                    for (int mt = 0; mt < 2; ++mt)
#pragma unroll
                        for (int r = 0; r < 16; ++r) s[mt][r] -= delta;
#pragma unroll
                    for (int r = 0; r < 16; ++r) negm[r] -= delta;
                }
                float sum = 0.f;
#pragma unroll
                for (int mt = 0; mt < 2; ++mt)
#pragma unroll
                    for (int r = 0; r < 16; ++r) { const float pv = ex2(s[mt][r]); s[mt][r] = pv; sum += pv; }
                l_run += sum;
            } else {
                const bool diag = key0 + 63 >= qlo;
                float G[8];
#pragma unroll
                for (int mt = 0; mt < 2; ++mt)
#pragma unroll
                    for (int rg = 0; rg < 4; ++rg) {
                        float g = 0.f;
#pragma unroll
                        for (int j = 3; j >= 0; --j) { const int r = rg * 4 + j; const float z = s[mt][r];
                            const float wv = lg2(1.f + ex2(-fabsf(z)));
                            float nlom = fmaxf(z, 0.f) + wv; float nl = nlom - z;
                            if (diag) { const int key = key0 + mt * 32 + rg * 8 + fh * 4 + j; if (key >= qrow) { nlom = 0.f; nl = 1e30f; } }
                            s[mt][r] = nl + g; g += nlom; }
                        G[mt * 4 + rg] = g;
                    }
                float base[8]; float run = l_run;
#pragma unroll
                for (int oc = 7; oc >= 0; --oc) { const float gp = shx32(G[oc]); base[oc] = run + (fh == 0 ? gp : 0.f); run += G[oc] + gp; }
                l_run = run;
#pragma unroll
                for (int mt = 0; mt < 2; ++mt)
#pragma unroll
                    for (int r = 0; r < 16; ++r) s[mt][r] = ex2(-(s[mt][r] + base[mt * 4 + (r >> 2)]));
            }
#pragma unroll
            for (int s4 = 0; s4 < 4; ++s4) { u32x4 pk; const int mt = s4 >> 1, rb = (s4 & 1) * 8;
                pk.x = pk2(s[mt][rb], s[mt][rb + 1]); pk.y = pk2(s[mt][rb + 2], s[mt][rb + 3]); pk.z = pk2(s[mt][rb + 4], s[mt][rb + 5]); pk.w = pk2(s[mt][rb + 6], s[mt][rb + 7]);
                pf[s4] = __builtin_bit_cast(bf16x8, pk); }
#pragma unroll
            for (int s4 = 0; s4 < 4; ++s4)
#pragma unroll
                for (int d = 0; d < NDT; ++d) { const int row = d * 32 + fr; const bf16x8 vf = *(const bf16x8*)(buf + KB + row * 128 + (((s4 * 2 + fh) ^ ((row >> 1) & 7)) << 4)); o[d] = MFMA(vf, pf[s4], o[d]); }
        }
        if (more) { if (MODE == 2) gload(tile_of(it + 1)); sstore(lds + ((it + 1) & 1) * STG); }
        if (MODE == 1) {
            const bool fin = __all(l_run > 152.f) != 0;
            if (lane == 0) flags[(it & 1) * NWV + w] = fin ? 1u : 0u;
            __syncthreads();
            const unsigned* f = flags + (it & 1) * NWV;
            if ((f[0] & f[1] & f[2] & f[3] & f[4] & f[5] & f[6] & f[7]) != 0u) break;
        } else {
            __syncthreads();
        }
    }
    float inv = 1.f;
    if (MODE != 1) { const float lt = l_run + shx32(l_run); inv = 1.f / lt; }
#pragma unroll
    for (int d = 0; d < NDT; ++d)
#pragma unroll
        for (int rg = 0; rg < 4; ++rg) st_bf4(O + (size_t)qrow * ldo + d * 32 + rg * 8 + fh * 4, o[d][rg * 4] * inv, o[d][rg * 4 + 1] * inv, o[d][rg * 4 + 2] * inv, o[d][rg * 4 + 3] * inv);
}

DI void phase3(const Params& p, char* lds, const int tid) {
    char* ws = p.ws;
    constexpr int NMLA = 32 * 16, NSB = 32 * 32;
    for (int u = blockIdx.x; u < NMLA + NSB; u += gridDim.x) {
        if (u < NMLA) {
            const int xcd = u & 7, v = u >> 3; const int pr = v & 15, bh = (v >> 4) * 8 + xcd; const int b = bh >> 3, h = bh & 7;
            const bf16_t* Q = (const bf16_t*)(ws + OFF_QA) + (size_t)b * SEQ * 768 + h * 96;
            const bf16_t* Kp = (const bf16_t*)(ws + OFF_KA) + (size_t)b * SEQ * 768 + h * 96;
            const bf16_t* Vt = (const bf16_t*)(ws + OFF_VTA) + (size_t)(h * 64) * T + (size_t)b * SEQ;
            bf16_t* O = (bf16_t*)(ws + OFF_OA) + (size_t)b * SEQ * 512 + h * 64;
#pragma unroll 1
            for (int half = 0; half < 2; ++half) { const int qb = half ? pr : 31 - pr;
                attn_block<96, 64, 0>(Q, 768, Kp, 768, Vt, T, O, 512, qb * 256, 4 * qb + 4, lds, tid); }
        } else {
            const int uu = u - NMLA; const int xcd = uu & 7, v = uu >> 3; const int qb = v & 31, bh = (v >> 5) * 8 + xcd; const int b = bh >> 3, h = bh & 7;
            const bf16_t* Q = (const bf16_t*)(ws + OFF_SBQ) + (size_t)b * SEQ * 512 + h * 64;
            const bf16_t* Kp = (const bf16_t*)(ws + OFF_SBK) + (size_t)b * SEQ * 512 + h * 64;
            const bf16_t* Vt = (const bf16_t*)(ws + OFF_VTB) + (size_t)(h * 64) * T + (size_t)b * SEQ;
            bf16_t* O = (bf16_t*)(ws + OFF_OB) + (size_t)b * SEQ * 512 + h * 64;
            attn_block<64, 64, 1>(Q, 512, Kp, 512, Vt, T, O, 512, qb * 256, 4 * qb + 4, lds, tid);
        }
    }
}

DI void phase7(const Params& p, char* lds, const int tid) {
    char* ws = p.ws;
    for (int u = blockIdx.x; u < 16 * 32; u += gridDim.x) {
        const int xcd = u & 7, v = u >> 3; const int qb = v & 31, bh = (v >> 5) * 8 + xcd; const int b = bh >> 2, h = bh & 3;
        const bf16_t* Q = (const bf16_t*)(ws + OFF_XQ) + (size_t)b * SEQ * 512 + h * 128;
        const bf16_t* Kp = (const bf16_t*)(ws + OFF_XK) + (size_t)b * MEML * 512 + h * 128;
        const bf16_t* Vt = (const bf16_t*)(ws + OFF_XVT) + (size_t)(h * 128) * MEMT + (size_t)b * MEML;
        bf16_t* O = (bf16_t*)(ws + OFF_XO) + (size_t)b * SEQ * 512 + h * 128;
        attn_block<128, 128, 2>(Q, 512, Kp, 512, Vt, MEMT, O, 512, qb * 256, 4, lds, tid);
    }
}

DI void phase11(const Params& p, const int tid) {
    const float* ssq3 = (const float*)(p.ws + OFF_SSQ3);
    const int lane = tid & 63, w = tid >> 6;
    f32x4 g[4];
#pragma unroll
    for (int i = 0; i < 4; ++i) g[i] = *(const f32x4*)(p.g_final + i * 256 + lane * 4);
    for (int row0 = (blockIdx.x * NWV + w) * 4; row0 < T; row0 += gridDim.x * NWV * 4) {
        f32x4 v[4][4]; float rs[4];
#pragma unroll
        for (int r = 0; r < 4; ++r) { rs[r] = ssq3[row0 + r];
#pragma unroll
            for (int i = 0; i < 4; ++i) v[r][i] = *(const f32x4*)(p.out + (size_t)(row0 + r) * DM + i * 256 + lane * 4); }
#pragma unroll
        for (int r = 0; r < 4; ++r) { const float s = rsqrtf(rs[r] * (1.0f / DM) + EPS);
#pragma unroll
            for (int i = 0; i < 4; ++i) { f32x4 o = v[r][i]; o[0] *= s * g[i][0]; o[1] *= s * g[i][1]; o[2] *= s * g[i][2]; o[3] *= s * g[i][3];
                *(f32x4*)(p.out + (size_t)(row0 + r) * DM + i * 256 + lane * 4) = o; } }
    }
}

#define XB_TMO      128
#define XB_XCNT(j)  (256  + 64 * (j))
#define XB_XSUB(j)  (1280 + 64 * (j))
#define XB_XGEN(j)  (2304 + 64 * (j))
#define XB_TOP      3328
#define XB_TOPGEN   3392
#define XCD_BAR_WORDS 3456
#define XB_SPIN_CAP (1u << 22)
DI unsigned xb_ld(unsigned* p) { return __hip_atomic_load(p, __ATOMIC_RELAXED, __HIP_MEMORY_SCOPE_AGENT); }
DI unsigned xb_add(unsigned* p, unsigned v) { return __hip_atomic_fetch_add(p, v, __ATOMIC_RELAXED, __HIP_MEMORY_SCOPE_AGENT); }
DI unsigned xb_xcc_id() { return (unsigned)__builtin_amdgcn_s_getreg((3 << 11) | 20) & 0xFu; }
#define XB_SPIN(cond, bar) do { unsigned _sp = 0; while (cond) { __builtin_amdgcn_s_sleep(1); \
    if ((++_sp & 255u) == 0u) { if (xb_ld(&(bar)[XB_TMO])) break; if (_sp > XB_SPIN_CAP) { atomicAdd(&(bar)[XB_TMO], 1u); break; } } } } while (0)
struct XcdBarrier { unsigned* bar; unsigned x; volatile LAS unsigned* st; };
DI XcdBarrier xcd_barrier_post(unsigned* bar, volatile LAS unsigned* st, const int tid) {
    XcdBarrier b; b.bar = bar; b.x = xb_xcc_id(); b.st = st;
    if (tid == 0) (void)xb_add(&bar[XB_XCNT(b.x)], 1u);
    return b;
}
DI void xcd_barrier_complete(unsigned* bar, unsigned x, unsigned& nloc, unsigned& nx) {
    const unsigned G = gridDim.x * gridDim.y * gridDim.z;
    unsigned sum, cnt, mine, sp = 0u;
    for (;;) {
        sum = 0u; cnt = 0u; mine = 0u;
#pragma unroll
        for (unsigned j = 0; j < 16; ++j) { const unsigned c = xb_ld(&bar[XB_XCNT(j)]); sum += c; cnt += (c > 0u) ? 1u : 0u; mine = (j == x) ? c : mine; }
        if (sum == G) break;
        __builtin_amdgcn_s_sleep(1);
        if ((++sp & 255u) == 0u) { if (xb_ld(&bar[XB_TMO])) break; if (sp > XB_SPIN_CAP) { atomicAdd(&bar[XB_TMO], 1u); break; } }
    }
    nloc = mine > 0u ? mine : 1u; nx = cnt > 0u ? cnt : 1u;
}
DI void xcd_barrier(const XcdBarrier& b, const int tid) {
    asm volatile("s_waitcnt vmcnt(0)" ::: "memory");
    __syncthreads();
    if (tid == 0) {
        unsigned* bar = b.bar;
        __builtin_amdgcn_s_waitcnt(0);
        unsigned nloc = b.st[0], nx = b.st[1];
        if (nloc == 0u) { xcd_barrier_complete(bar, b.x, nloc, nx); b.st[0] = nloc; b.st[1] = nx; }
        const unsigned old = xb_add(&bar[XB_XSUB(b.x)], 1u);
        const unsigned gen = old / nloc;
        if (old + 1u == (gen + 1u) * nloc) {
            __builtin_amdgcn_fence(__ATOMIC_RELEASE, "agent");
            asm volatile("s_waitcnt vmcnt(0)" ::: "memory");
            const unsigned og = xb_add(&bar[XB_TOP], 1u);
            const unsigned tg = og / nx;
            if (og + 1u == (tg + 1u) * nx) xb_add(&bar[XB_TOPGEN], 1u);
            else XB_SPIN(xb_ld(&bar[XB_TOPGEN]) == tg, bar);
            __builtin_amdgcn_fence(__ATOMIC_ACQUIRE, "agent");
            xb_add(&bar[XB_XGEN(b.x)], 1u);
            asm volatile("s_waitcnt vmcnt(0)" ::: "memory");
        } else {
            XB_SPIN(xb_ld(&bar[XB_XGEN(b.x)]) == gen, bar);
            __builtin_amdgcn_fence(__ATOMIC_ACQUIRE, "agent");
            asm volatile("s_waitcnt vmcnt(0)" ::: "memory");
        }
    }
    __syncthreads();
}


constexpr int NPHASE = 12;
__global__ void __launch_bounds__(NTHR, 2) mega(Params p, int ph_lo, int ph_hi, int coop) {
    extern __shared__ __attribute__((aligned(16))) unsigned char dlds[];
    LAS unsigned char* L = (LAS unsigned char*)dlds;
    char* lds = (char*)dlds;
    char* ws = p.ws;
    const int swid = __builtin_amdgcn_readfirstlane((int)(threadIdx.x >> 6));
#define MYTID (swid * 64 + lane_id_fresh())
    volatile LAS unsigned* xbw = (volatile LAS unsigned*)(L + LDS_XB);
    if (threadIdx.x < 4) xbw[threadIdx.x] = 0u;
    __syncthreads();
    XcdBarrier xb; xb.bar = (unsigned*)(ws + OFF_BAR); xb.x = 0; xb.st = xbw;
    if (coop) xb = xcd_barrier_post((unsigned*)(ws + OFF_BAR), xbw, MYTID);
    if (coop == 2) cg::this_grid().sync();
#define PH(n, call) if (ph_lo <= n && n < ph_hi) { call; } if (coop && n + 1 < NPHASE) xcd_barrier(xb, MYTID);
    PH(0, phase0(p, lds, MYTID))
    PH(1, { run_gemm(L, MYTID, (const bf16_t*)(ws + OFF_XB), (const bf16_t*)(ws + OFF_WIN), T, 1536, DM, Epi1{ws, p.b_gate});
            run_gemm(L, MYTID, (const bf16_t*)(ws + OFF_XB), (const bf16_t*)(ws + OFF_WIN) + (size_t)1536 * DM, T, 2048, DM, EpiGate{ws, p.b_gate});
            run_gemm(L, MYTID, (const bf16_t*)(ws + OFF_WV), (const bf16_t*)(ws + OFF_XB), 512, T, DM, EpiVt<1>{(bf16_t*)(ws + OFF_VTB), T, (const float*)(ws + OFF_RSTD0)}); })
    PH(2, { run_gemm(L, MYTID, (const bf16_t*)(ws + OFF_CQ), (const bf16_t*)(ws + OFF_WUQ), T, 768, 256, Epi2q{ws});
            run_gemm(L, MYTID, (const bf16_t*)(ws + OFF_CKV), (const bf16_t*)(ws + OFF_WUK), T, 512, 256, EpiBf<2, true>{(bf16_t*)(ws + OFF_KA), 768, (const float*)(ws + OFF_SSQ_KV)});
            run_gemm(L, MYTID, (const bf16_t*)(ws + OFF_WUV), (const bf16_t*)(ws + OFF_CKV), 512, T, 256, EpiVt<2>{(bf16_t*)(ws + OFF_VTA), T, (const float*)(ws + OFF_SSQ_KV)});
            run_gemm_at(L, MYTID, 128, (const bf16_t*)(ws + OFF_MNB), (const bf16_t*)(ws + OFF_WXKV), MEMT, 512, DM, EpiBf<0, false>{(bf16_t*)(ws + OFF_XK), 512, nullptr});
            run_gemm_at(L, MYTID, 144, (const bf16_t*)(ws + OFF_WXKV) + (size_t)512 * DM, (const bf16_t*)(ws + OFF_MNB), 512, MEMT, DM, EpiVt<0>{(bf16_t*)(ws + OFF_XVT), MEMT, nullptr}); })
    PH(3, phase3(p, lds, MYTID))
    PH(4, { run_gemm(L, MYTID, (const bf16_t*)(ws + OFF_OA), (const bf16_t*)(ws + OFF_WA), T, DM, 512, Epi4<0>{(const bf16_t*)(ws + OFF_SIGA), (bf16_t*)(ws + OFF_VTA), nullptr});
            run_gemm(L, MYTID, (const bf16_t*)(ws + OFF_OB), (const bf16_t*)(ws + OFF_WB), T, DM, 512, Epi4<1>{(const bf16_t*)(ws + OFF_SIGB), (bf16_t*)(ws + OFF_VTA), (bf16_t*)(ws + OFF_MERGED)}); })
    PH(5, run_gemm(L, MYTID, (const bf16_t*)(ws + OFF_MERGED), (const bf16_t*)(ws + OFF_WO), T, DM, DM, EpiRes{p.x, p.out, (bf16_t*)(ws + OFF_X1B), (float*)(ws + OFF_SSQ1)}))
    PH(6, run_gemm(L, MYTID, (const bf16_t*)(ws + OFF_X1B), (const bf16_t*)(ws + OFF_WXQ), T, 512, DM, EpiBf<1, false>{(bf16_t*)(ws + OFF_XQ), 512, (const float*)(ws + OFF_SSQ1)}))
    PH(7, phase7(p, lds, MYTID))
    PH(8, run_gemm(L, MYTID, (const bf16_t*)(ws + OFF_XO), (const bf16_t*)(ws + OFF_WXO), T, DM, 512, EpiRes{p.out, p.out, (bf16_t*)(ws + OFF_X2B), (float*)(ws + OFF_SSQ2)}))
    PH(9, run_gemm(L, MYTID, (const bf16_t*)(ws + OFF_X2B), (const bf16_t*)(ws + OFF_WGU), T, 2 * DFF, DM, Epi9{(bf16_t*)(ws + OFF_HID), (const float*)(ws + OFF_SSQ2)}))
    PH(10, run_gemm(L, MYTID, (const bf16_t*)(ws + OFF_HID), (const bf16_t*)(ws + OFF_WD), T, DM, DFF, EpiRes{p.out, p.out, nullptr, (float*)(ws + OFF_SSQ3)}))
    PH(11, phase11(p, MYTID))
}

extern "C" void kernel_launch(void* const* d_in, const int* in_sizes, int n_in, void* d_out, int out_size, void* d_ws, size_t ws_size, hipStream_t stream) {
    static int grid_blocks = 0;
    if (!grid_blocks) {
        int dev = 0, cus = 0, per_cu = 0;
        (void)hipGetDevice(&dev);
        (void)hipDeviceGetAttribute(&cus, hipDeviceAttributeMultiprocessorCount, dev);
        (void)hipFuncSetAttribute((const void*)mega, hipFuncAttributeMaxDynamicSharedMemorySize, LDS_BYTES);
        (void)hipOccupancyMaxActiveBlocksPerMultiprocessor(&per_cu, mega, NTHR, LDS_BYTES);
        if (per_cu != 1) per_cu = 1;
        grid_blocks = cus * per_cu;
    }
    Params p{};
    p.x = (const float*)d_in[0]; p.mem = (const float*)d_in[1]; p.pos = (const int*)d_in[2];
    p.g_mix = (const float*)d_in[3]; p.w_in = (const float*)d_in[4]; p.b_gate = (const float*)d_in[5]; p.g_q_lat = (const float*)d_in[6]; p.w_uq = (const float*)d_in[7];
    p.g_kv_lat = (const float*)d_in[8]; p.w_ukv = (const float*)d_in[9]; p.w_a = (const float*)d_in[10]; p.w_b = (const float*)d_in[11]; p.w_o = (const float*)d_in[12];
    p.g_x = (const float*)d_in[13]; p.g_mem = (const float*)d_in[14]; p.w_xq = (const float*)d_in[15]; p.w_xkv = (const float*)d_in[16]; p.w_xo = (const float*)d_in[17];
    p.g_ffn = (const float*)d_in[18]; p.w_gate = (const float*)d_in[19]; p.w_up = (const float*)d_in[20]; p.w_down = (const float*)d_in[21]; p.g_final = (const float*)d_in[22];
    p.out = (float*)d_out; p.ws = (char*)d_ws;
#if ONE_LAUNCH
    int lo = 0, hi = NPHASE, coop = 1;
    (void)hipMemsetAsync((char*)d_ws + OFF_BAR, 0, XCD_BAR_WORDS * sizeof(unsigned), stream);
    void* args[] = {&p, &lo, &hi, &coop};
    hipError_t e = hipLaunchCooperativeKernel((void*)mega, dim3(grid_blocks), dim3(NTHR), args, LDS_BYTES, stream);
    if (e != hipSuccess) fprintf(stderr, "cooperative launch failed: %s (grid %d)\n", hipGetErrorString(e), grid_blocks);
#else
    for (int ph = 0; ph < NPHASE; ++ph) mega<<<dim3(grid_blocks), dim3(NTHR), LDS_BYTES, stream>>>(p, ph, ph + 1, 0);
#endif
}
```

```cpp
#include <hip/hip_runtime.h>
#include <hip/hip_cooperative_groups.h>
#include <cstdio>
#include <cstdint>
namespace cg = cooperative_groups;

#ifndef ONE_LAUNCH
#define ONE_LAUNCH 1
#endif

namespace pg8 {
#define PG8_LAS __attribute__((address_space(3)))
typedef unsigned short bf16_t;
typedef short bf16x8 __attribute__((ext_vector_type(8)));
typedef float f32x4 __attribute__((ext_vector_type(4)));
typedef unsigned u32x4 __attribute__((ext_vector_type(4)));
constexpr int BM = 256, BK = 64, HALF = 128, HTB = HALF * BK * 2  , STAGE_BYTES = 8 * HTB, NXCD = 8, WGM = 8;

__host__ __device__ __forceinline__ int lds_byte(int r, int c) { const int st = (r >> 4) * 2 + (c >> 5), rr = r & 15, cc = c & 31, ob = rr * 64 + cc * 2; return st * 1024 + (ob ^ (((ob >> 9) & 1) << 5)); }
__host__ __device__ __forceinline__ void stage_rc(int b, int& R, int& C) { const int st = b / 1024, sb = b % 1024, swz = sb ^ (((sb >> 9) & 1) << 5); R = (st >> 1) * 16 + swz / 64; C = (st & 1) * 32 + (swz % 64) / 2; }
__host__ __device__ __forceinline__ int perm32(int rho) { const int n = rho >> 4, i = rho & 15; return 8 * (i >> 2) + 4 * n + (i & 3); }

struct Unit { int pm, pn; };
struct Gemm { const bf16_t* A; const bf16_t* Bt; int M, N, K; };

struct StaticOrder {
    int nM, nN, nwg, G, c;
    __host__ __device__ void init(int M, int N, int G_, int c_) { nM = M / BM; nN = N / BM; nwg = nM * nN; G = G_; c = c_; }
    __host__ __device__ bool next(int i, Unit& u) const {
        const long L = (long)i * G + c; if (L >= nwg) return false;
        int wgid = (int)L; { const int q = nwg / NXCD, r = nwg % NXCD, xcd = wgid % NXCD, off = wgid / NXCD; wgid = (xcd < r ? xcd * (q + 1) : r * (q + 1) + (xcd - r) * q) + off; }
        const int nig = WGM * nN, gid = wgid / nig, fm = gid * WGM, gsz = (nM - fm) < WGM ? (nM - fm) : WGM;
        u.pm = fm + ((wgid % nig) % gsz); u.pn = (wgid % nig) / gsz; return true;
    }
    __device__ __forceinline__ void a_ready(const Unit&) const {}
    __device__ __forceinline__ void done(const Unit&) const {}
};


template <class Epi, class Sched, bool ALIGN_EPI = false, bool SP2 = false>
__device__ __forceinline__ void gemm_phase(PG8_LAS unsigned char* lds, const Gemm g, const Sched& S, const Epi& E, const int tid_in) {
    int tid_ = tid_in; asm volatile("" : "+v"(tid_));
    const int tid = tid_, wid = __builtin_amdgcn_readfirstlane(tid >> 6), lane = tid & 63, wr = wid >> 2, wc = wid & 3, fr = lane & 15, fq = lane >> 4;
    const int K = g.K, nt = K / BK;
    unsigned voffA[2], voffB[2];
#pragma unroll
    for (int i = 0; i < 2; ++i) { int R, C; stage_rc(tid * 16 + i * 8192, R, C); const int Rb = Epi::PERM ? ((R & ~31) + perm32(R & 31)) : R;
        voffA[i] = (unsigned)(R * K + C) * 2u; voffB[i] = (unsigned)(Rb * K + C) * 2u; }
    const size_t kstep = (size_t)(BK * 2);
    const size_t hstep = (size_t)HALF * K * 2;
    const size_t tstep = 2 * hstep;
    const unsigned ldsw = (unsigned)wid * 1024u;
    const int aoff = lds_byte(wr * 64 + fr, fq * 8), boff = lds_byte(wc * 32 + fr, fq * 8);
#define PG8_SA(b, h) (((b) * 2 + (h)) * HTB)
#define PG8_SB(b, h) ((4 + (b) * 2 + (h)) * HTB)
#define PG8_STAGE(bufoff, gbase, voff) do { _Pragma("unroll") for (int _i = 0; _i < 2; ++_i) \
        __builtin_amdgcn_global_load_lds((const unsigned*)((const char*)(gbase) + (voff)[_i]), (PG8_LAS unsigned*)(lds + (bufoff) + ldsw + _i * 8192), 16, 0, 0); } while (0)
#define PG8_LDA(dst, b, h) do { _Pragma("unroll") for (int m = 0; m < 4; ++m) _Pragma("unroll") for (int k = 0; k < 2; ++k) dst[m][k] = *(const PG8_LAS bf16x8*)(lds + PG8_SA(b, h) + aoff + m * 2048 + k * 1024); } while (0)
#define PG8_LDB(dst, b, h) do { _Pragma("unroll") for (int n = 0; n < 2; ++n) _Pragma("unroll") for (int k = 0; k < 2; ++k) dst[n][k] = *(const PG8_LAS bf16x8*)(lds + PG8_SB(b, h) + boff + n * 2048 + k * 1024); } while (0)
#define PG8_MMA(ai, bj, At, Bt) do { __builtin_amdgcn_s_setprio(1); _Pragma("unroll") for (int m = 0; m < 4; ++m) _Pragma("unroll") for (int n = 0; n < 2; ++n) _Pragma("unroll") for (int k = 0; k < 2; ++k) \
        acc[ai][bj][m][n] = __builtin_amdgcn_mfma_f32_16x16x32_bf16(Bt[n][k], At[m][k], acc[ai][bj][m][n], 0, 0, 0); __builtin_amdgcn_s_setprio(0); } while (0)
#define PG8_WAIT_V(n) asm volatile("s_waitcnt vmcnt(" #n ")" ::: "memory")
#define PG8_WAIT_L(n) asm volatile("s_waitcnt lgkmcnt(" #n ")" ::: "memory")
#define PG8_BAR __builtin_amdgcn_s_barrier()
#define PG8_SCHED __builtin_amdgcn_sched_barrier(0)
    Unit cur, nxt; int ui = 0;
    if (!S.next(0, cur)) return;
    f32x4 acc[2][2][4][2];
#pragma unroll
    for (int a = 0; a < 2; ++a)
#pragma unroll
        for (int b = 0; b < 2; ++b)
#pragma unroll
            for (int m = 0; m < 4; ++m)
#pragma unroll
                for (int n = 0; n < 2; ++n) acc[a][b][m][n] = (f32x4){0.f, 0.f, 0.f, 0.f};
    bf16x8 At[4][2], B0[2][2], B1[2][2];
    const char* cA = (const char*)g.A + (size_t)cur.pm * tstep; const char* cB = (const char*)g.Bt + (size_t)cur.pn * tstep;
    S.a_ready(cur);
    if constexpr (SP2) {
        PG8_STAGE(PG8_SB(0, 0), cB, voffB); PG8_STAGE(PG8_SB(0, 1), cB + hstep, voffB); PG8_STAGE(PG8_SA(0, 0), cA, voffA); PG8_STAGE(PG8_SA(0, 1), cA + hstep, voffA);
        if (wr == 1) PG8_BAR;
        PG8_WAIT_V(2); PG8_BAR;
        PG8_STAGE(PG8_SB(1, 0), cB + kstep, voffB); PG8_STAGE(PG8_SA(1, 0), cA + kstep, voffA); PG8_STAGE(PG8_SB(1, 1), cB + hstep + kstep, voffB);
        PG8_WAIT_V(6); PG8_BAR;
    } else {
        PG8_STAGE(PG8_SB(0, 0), cB, voffB); PG8_STAGE(PG8_SA(0, 0), cA, voffA); PG8_STAGE(PG8_SB(0, 1), cB + hstep, voffB); PG8_STAGE(PG8_SA(0, 1), cA + hstep, voffA);
        if (wr == 1) PG8_BAR;
        PG8_WAIT_V(4); PG8_BAR;
        PG8_STAGE(PG8_SB(1, 0), cB + kstep, voffB); PG8_STAGE(PG8_SA(1, 0), cA + kstep, voffA); PG8_STAGE(PG8_SB(1, 1), cB + hstep + kstep, voffB);
        PG8_WAIT_V(6); PG8_BAR;
    }
    for (;;) {
        const bool has_next = S.next(ui + 1, nxt);
        const char* nA = has_next ? (const char*)g.A + (size_t)nxt.pm * tstep : cA; const char* nB = has_next ? (const char*)g.Bt + (size_t)nxt.pn * tstep : cB;
        for (int t = 0; t < nt; t += 2) {
            const bool last = (t == nt - 2);
            const char* a1 = cA + (size_t)(t + 1) * kstep;
            const char* a2 = last ? nA : cA + (size_t)(t + 2) * kstep; const char* b2 = last ? nB : cB + (size_t)(t + 2) * kstep;
            const char* a3 = a2 + kstep; const char* b3 = b2 + kstep;
            if (last && has_next) S.a_ready(nxt);
            if constexpr (SP2) {
            PG8_LDB(B0, 0, 0); PG8_LDB(B1, 0, 1); PG8_SCHED; PG8_LDA(At, 0, 0); PG8_STAGE(PG8_SA(1, 1), a1 + hstep, voffA);
            PG8_WAIT_V(8); PG8_WAIT_L(0); PG8_BAR; PG8_MMA(0, 0, At, B0); PG8_MMA(0, 1, At, B1); PG8_BAR; PG8_SCHED;
            PG8_LDA(At, 0, 1); PG8_STAGE(PG8_SB(0, 0), b2, voffB); PG8_STAGE(PG8_SB(0, 1), b2 + hstep, voffB); PG8_STAGE(PG8_SA(0, 0), a2, voffA);
            PG8_WAIT_V(8); PG8_WAIT_L(0); PG8_BAR; PG8_MMA(1, 0, At, B0); PG8_MMA(1, 1, At, B1); PG8_BAR; PG8_SCHED;
            PG8_LDB(B0, 1, 0); PG8_LDB(B1, 1, 1); PG8_SCHED; PG8_LDA(At, 1, 0); PG8_STAGE(PG8_SA(0, 1), a2 + hstep, voffA);
            PG8_WAIT_V(8); PG8_WAIT_L(0); PG8_BAR; PG8_MMA(0, 0, At, B0); PG8_MMA(0, 1, At, B1); PG8_BAR; PG8_SCHED;
            PG8_LDA(At, 1, 1); PG8_STAGE(PG8_SB(1, 0), b3, voffB); PG8_STAGE(PG8_SB(1, 1), b3 + hstep, voffB); PG8_STAGE(PG8_SA(1, 0), a3, voffA);
            PG8_WAIT_V(8); PG8_WAIT_L(0); PG8_BAR; PG8_MMA(1, 0, At, B0); PG8_MMA(1, 1, At, B1); PG8_BAR; PG8_SCHED;
            } else {
            PG8_LDB(B0, 0, 0); PG8_SCHED; PG8_LDA(At, 0, 0); PG8_STAGE(PG8_SA(1, 1), a1 + hstep, voffA);
            PG8_WAIT_L(8); PG8_BAR; PG8_WAIT_L(0); PG8_MMA(0, 0, At, B0); PG8_BAR; PG8_SCHED;
            PG8_LDB(B1, 0, 1); PG8_STAGE(PG8_SB(0, 0), b2, voffB);
            PG8_BAR; PG8_WAIT_L(0); PG8_MMA(0, 1, At, B1); PG8_BAR;
            PG8_LDA(At, 0, 1); PG8_STAGE(PG8_SA(0, 0), a2, voffA);
            PG8_BAR; PG8_WAIT_L(0); PG8_MMA(1, 0, At, B0); PG8_BAR; PG8_SCHED;
            PG8_STAGE(PG8_SB(0, 1), b2 + hstep, voffB);
            PG8_WAIT_V(6); PG8_BAR; PG8_MMA(1, 1, At, B1); PG8_BAR;
            PG8_LDB(B0, 1, 0); PG8_SCHED; PG8_LDA(At, 1, 0); PG8_STAGE(PG8_SA(0, 1), a2 + hstep, voffA);
            PG8_WAIT_L(8); PG8_BAR; PG8_WAIT_L(0); PG8_MMA(0, 0, At, B0); PG8_BAR; PG8_SCHED;
            PG8_LDB(B1, 1, 1); PG8_STAGE(PG8_SB(1, 0), b3, voffB);
            PG8_BAR; PG8_WAIT_L(0); PG8_MMA(0, 1, At, B1); PG8_BAR;
            PG8_LDA(At, 1, 1); PG8_STAGE(PG8_SA(1, 0), a3, voffA);
            PG8_BAR; PG8_WAIT_L(0); PG8_MMA(1, 0, At, B0); PG8_BAR; PG8_SCHED;
            PG8_STAGE(PG8_SB(1, 1), b3 + hstep, voffB);
            PG8_WAIT_V(6); PG8_BAR; PG8_MMA(1, 1, At, B1); PG8_BAR;
            }
        }
        if constexpr (ALIGN_EPI) { if (wr == 0) PG8_BAR; }
        if constexpr (!Epi::AFTER_DRAIN) { int fr2 = fr, fq2 = fq; asm volatile("" : "+v"(fr2), "+v"(fq2));
            E(acc, cur, wr, wc, fr2, fq2); S.done(cur); }
        if (!has_next) break;
#pragma unroll
        for (int a = 0; a < 2; ++a)
#pragma unroll
            for (int b = 0; b < 2; ++b)
#pragma unroll
                for (int m = 0; m < 4; ++m)
#pragma unroll
                    for (int n = 0; n < 2; ++n) acc[a][b][m][n] = (f32x4){0.f, 0.f, 0.f, 0.f};
        cur = nxt; cA = nA; cB = nB; ++ui;
        if constexpr (ALIGN_EPI) { if (wr == 1) PG8_BAR; }
    }
    PG8_WAIT_V(0);
    if constexpr (!ALIGN_EPI) { if (wr == 0) PG8_BAR; }
    PG8_BAR;
    if constexpr (Epi::AFTER_DRAIN) { E.fused(acc, cur, wr, wc, fr, fq, lds, wid, lane); S.done(cur); }
#undef PG8_SA
#undef PG8_SB
#undef PG8_STAGE
#undef PG8_LDA
#undef PG8_LDB
#undef PG8_MMA
#undef PG8_WAIT_V
#undef PG8_WAIT_L
#undef PG8_BAR
#undef PG8_SCHED
}
}


typedef unsigned short bf16_t;
typedef short bf16x8 __attribute__((ext_vector_type(8)));
typedef float f32x16 __attribute__((ext_vector_type(16)));
typedef float f32x4 __attribute__((ext_vector_type(4)));
typedef float f32x2 __attribute__((ext_vector_type(2)));
typedef unsigned u32x4 __attribute__((ext_vector_type(4)));
typedef unsigned u32x2 __attribute__((ext_vector_type(2)));
typedef __bf16 bf16x2_t __attribute__((ext_vector_type(2)));
#define DI __device__ __forceinline__
#define LAS __attribute__((address_space(3)))
#define MFMA(a, b, c) __builtin_amdgcn_mfma_f32_32x32x16_bf16((a), (b), (c), 0, 0, 0)
using pg8::Unit;

constexpr int T = 32768, SEQ = 8192, NB = 4, DM = 1024, MEMT = 1024, MEML = 256;
constexpr int DFF = 2816;
constexpr int NTHR = 512, NWV = 8;
constexpr float EPS = 1e-6f;
constexpr float LOG2E = 1.4426950408889634f;
constexpr int LDS_BYTES = 147456;
constexpr int LDS_XB = 131072 + 1024;

constexpr size_t MB = 1024 * 1024;
constexpr size_t OFF_SSQ_Q = 0;
constexpr size_t OFF_SSQ_KV = OFF_SSQ_Q + T * 4;
constexpr size_t OFF_SSQ1 = OFF_SSQ_KV + T * 4;
constexpr size_t OFF_SSQ2 = OFF_SSQ1 + T * 4;
constexpr size_t OFF_SSQ3 = OFF_SSQ2 + T * 4;
constexpr size_t OFF_RSTD0 = OFF_SSQ3 + T * 4;
constexpr size_t OFF_BAR = 832 * 1024;
constexpr size_t OFF_CS = 1 * MB;
constexpr size_t OFF_WIN = 5 * MB;
constexpr size_t OFF_WV = OFF_WIN + 7 * MB;
constexpr size_t OFF_WUQ = OFF_WV + 1 * MB;
constexpr size_t OFF_WUK = OFF_WUQ + 768 * 256 * 2;
constexpr size_t OFF_WUV = OFF_WUK + 512 * 256 * 2;
constexpr size_t OFF_WA = OFF_WUV + 512 * 256 * 2;
constexpr size_t OFF_WB = OFF_WA + 1 * MB;
constexpr size_t OFF_WO = OFF_WB + 1 * MB;
constexpr size_t OFF_WXQ = OFF_WO + 2 * MB;
constexpr size_t OFF_WXKV = OFF_WXQ + 1 * MB;
constexpr size_t OFF_WXO = OFF_WXKV + 2 * MB;
constexpr size_t OFF_WGU = OFF_WXO + 1 * MB;
constexpr size_t OFF_WD = OFF_WGU + 11 * MB;
constexpr size_t OFF_MNB = OFF_WD + 6 * MB;
constexpr size_t OFF_XK = OFF_MNB + 2 * MB;
constexpr size_t OFF_XVT = OFF_XK + 1 * MB;
constexpr size_t OFF_ACT = 48 * MB;
static_assert(OFF_XVT + 1 * MB <= OFF_ACT, "ws map");
constexpr size_t OFF_XB = OFF_ACT;
constexpr size_t OFF_OA = OFF_XB;
constexpr size_t OFF_OB = OFF_XB + 32 * MB;
constexpr size_t OFF_CQ = OFF_XB + 64 * MB;
constexpr size_t OFF_CKV = OFF_CQ + 16 * MB;
constexpr size_t OFF_KA = OFF_CKV + 16 * MB;
constexpr size_t OFF_QA = OFF_KA + 48 * MB;
constexpr size_t OFF_VTA = OFF_QA + 48 * MB;
constexpr size_t OFF_SBQ = OFF_VTA + 32 * MB;
constexpr size_t OFF_SBK = OFF_SBQ + 32 * MB;
constexpr size_t OFF_VTB = OFF_SBK + 32 * MB;
constexpr size_t OFF_SIGA = OFF_VTB + 32 * MB;
constexpr size_t OFF_SIGB = OFF_SIGA + 64 * MB;
constexpr size_t WS_END = OFF_SIGB + 64 * MB;
static_assert(WS_END <= 512 * MB, "ws map");
constexpr size_t OFF_MERGED = OFF_KA;
constexpr size_t OFF_X1B = OFF_VTA;
constexpr size_t OFF_XQ = OFF_SBK;
constexpr size_t OFF_XO = OFF_VTB;
constexpr size_t OFF_X2B = OFF_SIGA;
constexpr size_t OFF_HID = OFF_KA;

struct Params {
    const float* x; const float* mem; const int* pos;
    const float* g_mix; const float* w_in; const float* b_gate; const float* g_q_lat; const float* w_uq;
    const float* g_kv_lat; const float* w_ukv; const float* w_a; const float* w_b; const float* w_o;
    const float* g_x; const float* g_mem; const float* w_xq; const float* w_xkv; const float* w_xo;
    const float* g_ffn; const float* w_gate; const float* w_up; const float* w_down; const float* g_final;
    float* out; char* ws;
};

DI unsigned pk2(float a, float b) { f32x2 v = {a, b}; bf16x2_t r = __builtin_convertvector(v, bf16x2_t); return __builtin_bit_cast(unsigned, r); }
DI bf16_t bf1(float a) { return (bf16_t)(pk2(a, 0.f) & 0xffffu); }
DI float ex2(float x) { return __builtin_amdgcn_exp2f(x); }
DI float lg2(float x) { return __builtin_amdgcn_logf(x); }
DI float shx32(float v) { return __shfl_xor(v, 32); }
DI int lane_id_fresh() { int l; asm volatile("v_mbcnt_lo_u32_b32 %0, -1, 0\n\tv_mbcnt_hi_u32_b32 %0, -1, %0" : "=v"(l)); return l; }
DI float bflo(unsigned u) { return __uint_as_float(u << 16); }
DI float bfhi(unsigned u) { return __uint_as_float(u & 0xffff0000u); }
DI void st_bf4(bf16_t* d, float a, float b, float c, float e) { u32x2 o; o.x = pk2(a, b); o.y = pk2(c, e); *(u32x2*)d = o; }
DI void st_bf8(bf16_t* d, const f32x4& a, const f32x4& b) { u32x4 o; o.x = pk2(a[0], a[1]); o.y = pk2(a[2], a[3]); o.z = pk2(b[0], b[1]); o.w = pk2(b[2], b[3]); *(u32x4*)d = o; }

struct WT { const float* src; const float* g; bf16_t* dst; int N, sc, k0, K, drow0; float scale; };
constexpr float SBQ_SCALE = LOG2E * 0.125f;
constexpr float MLAQ_SCALE = LOG2E * 0.10206207261596577f;
constexpr float XQ_SCALE = LOG2E * 0.08838834764831845f;
constexpr int J0 = 112 * 16;
constexpr int J1 = J0 + 16 * 16;
constexpr int J2 = J1 + 24 * 4;
constexpr int J3 = J2 + 16 * 4;
constexpr int J4 = J3 + 16 * 4;
constexpr int J5 = J4 + 32 * 8;
constexpr int J6 = J5 + 32 * 8;
constexpr int J7 = J6 + 32 * 16;
constexpr int J8 = J7 + 16 * 16;
constexpr int J9 = J8 + 32 * 16;
constexpr int J10 = J9 + 32 * 8;
constexpr int J11 = J10 + 176 * 16;
constexpr int J12 = J11 + 32 * 44;
DI WT wt_desc(const Params& p, int tl) {
    char* ws = p.ws; WT d; d.g = nullptr; d.scale = 1.f; d.src = p.w_in; d.dst = (bf16_t*)(ws + OFF_WIN); d.N = 4000; d.sc = -2; d.k0 = 0; d.K = 1024; d.drow0 = 0;
    if (tl >= J12) return d;
    if (tl < J0) { const int jk = tl / 112, jn = tl - jk * 112; const int d0 = jn * 32; int sc; float s = 1.f;
        if (d0 < 416) sc = d0; else if (d0 < 512) sc = -1; else if (d0 < 1536) { sc = d0 - 96; if (d0 < 1024) s = SBQ_SCALE; } else sc = d0 + 416;
        d.sc = sc; d.k0 = jk * 64; d.drow0 = d0; d.g = p.g_mix; d.scale = s; }
    else if (tl < J1) { const int u = tl - J0; const int jk = u >> 4, jn = u & 15; d.sc = 1440 + jn * 32; d.k0 = jk * 64; d.dst = (bf16_t*)(ws + OFF_WV); d.drow0 = jn * 32; d.g = p.g_mix; }
    else if (tl < J2) { const int u = tl - J1; const int jk = u / 24, jn = u - jk * 24; d.src = p.w_uq; d.N = 768; d.sc = jn * 32; d.k0 = jk * 64; d.dst = (bf16_t*)(ws + OFF_WUQ); d.K = 256; d.drow0 = jn * 32; d.g = p.g_q_lat; d.scale = MLAQ_SCALE; }
    else if (tl < J4) { const bool isv = tl >= J3; const int u = tl - (isv ? J3 : J2); const int jk = u >> 4, jn = u & 15; const int d0 = jn * 32;
        d.src = p.w_ukv; d.N = 1024; d.sc = jk < 2 ? (d0 >> 6) * 128 + (isv ? 64 : 0) + (d0 & 63) : -1; d.k0 = jk * 64; d.dst = (bf16_t*)(ws + (isv ? OFF_WUV : OFF_WUK)); d.K = 256; d.drow0 = d0; d.g = p.g_kv_lat; }
    else if (tl < J6) { const bool isb = tl >= J5; const int u = tl - (isb ? J5 : J4); const int jk = u >> 5, jn = u & 31;
        d.src = isb ? p.w_b : p.w_a; d.N = 1024; d.sc = jn * 32; d.k0 = jk * 64; d.dst = (bf16_t*)(ws + (isb ? OFF_WB : OFF_WA)); d.K = 512; d.drow0 = jn * 32; }
    else if (tl < J7) { const int u = tl - J6; const int jk = u >> 5, jn = u & 31; d.src = p.w_o; d.N = 1024; d.sc = jn * 32; d.k0 = jk * 64; d.dst = (bf16_t*)(ws + OFF_WO); d.drow0 = jn * 32; }
    else if (tl < J8) { const int u = tl - J7; const int jk = u >> 4, jn = u & 15; d.src = p.w_xq; d.N = 512; d.sc = jn * 32; d.k0 = jk * 64; d.dst = (bf16_t*)(ws + OFF_WXQ); d.drow0 = jn * 32; d.g = p.g_x; d.scale = XQ_SCALE; }
    else if (tl < J9) { const int u = tl - J8; const int jk = u >> 5, jn = u & 31; d.src = p.w_xkv; d.N = 1024; d.sc = jn * 32; d.k0 = jk * 64; d.dst = (bf16_t*)(ws + OFF_WXKV); d.drow0 = jn * 32; }
    else if (tl < J10) { const int u = tl - J9; const int jk = u >> 5, jn = u & 31; d.src = p.w_xo; d.N = 1024; d.sc = jn * 32; d.k0 = jk * 64; d.dst = (bf16_t*)(ws + OFF_WXO); d.K = 512; d.drow0 = jn * 32; }
    else if (tl < J11) { const int u = tl - J10; const int jk = u / 176, jn = u - jk * 176; const int d0 = jn * 32; const int rem = d0 & 255;
        d.src = (rem >= 128) ? p.w_up : p.w_gate; d.N = DFF; d.sc = (d0 >> 8) * 128 + (rem & 127); d.k0 = jk * 64; d.dst = (bf16_t*)(ws + OFF_WGU); d.drow0 = d0; d.g = p.g_ffn; }
    else { const int u = tl - J11; const int jk = u >> 5, jn = u & 31; d.src = p.w_down; d.N = 1024; d.sc = jn * 32; d.k0 = jk * 64; d.dst = (bf16_t*)(ws + OFF_WD); d.K = DFF; d.drow0 = jn * 32; }
    return d;
}
DI void wt_load(const WT& d, int t, float (&v)[8], float (&gv)[8]) {
    const int nn = t & 31, kb = t >> 5;
    const bool z = d.sc < 0; const int sc = z ? 0 : d.sc, ks = z ? 0 : d.k0;
    const float* gp = d.g ? d.g + ks : d.src;
#pragma unroll
    for (int i = 0; i < 8; ++i) { const int kk = kb + 8 * i; v[i] = d.src[(size_t)(ks + kk) * d.N + sc + nn]; gv[i] = gp[kk]; }
}
DI void wt_fix(const WT& d, float (&v)[8], const float (&gv)[8]) {
    const bool z = d.sc < 0;
#pragma unroll
    for (int i = 0; i < 8; ++i) { float x = v[i] * d.scale; if (d.g) x *= gv[i]; v[i] = z ? 0.f : x; }
}
DI void wt_put(float* l, int t, const float (&v)[8]) {
    const int nn = t & 31, kb = t >> 5;
#pragma unroll
    for (int i = 0; i < 8; ++i) l[(kb + 8 * i) * 33 + nn] = v[i];
}
DI void wt_store(const WT& d, int t, const float* l) {
    if (d.sc == -2) return;
    const int kk = t & 63, nb = t >> 6;
#pragma unroll
    for (int i = 0; i < 8; ++i) { const int nn = nb + 4 * i; d.dst[(size_t)(d.drow0 + nn) * d.K + d.k0 + kk] = bf1(l[kk * 33 + nn]); }
}

DI void phase0(const Params& p, char* ldsc, const int tid) {
    char* ws = p.ws;
    const int half = tid >> 8, t = tid & 255;
    float* l0 = (float*)ldsc + half * 2 * (64 * 33 + 16);
    float* l1 = l0 + (64 * 33 + 16);
    {
        int base = blockIdx.x * 4;
        WT d0 = wt_desc(p, base + half * 2), d1 = wt_desc(p, base + half * 2 + 1);
        float v0[8], v1[8], g0[8], g1[8];
        wt_load(d0, t, v0, g0); wt_load(d1, t, v1, g1);
        for (; base < J12; base += gridDim.x * 4) {
            wt_fix(d0, v0, g0); wt_fix(d1, v1, g1);
            wt_put(l0, t, v0); wt_put(l1, t, v1);
            __syncthreads();
            const WT c0 = d0, c1 = d1;
            const int nb = base + gridDim.x * 4;
            d0 = wt_desc(p, nb + half * 2); d1 = wt_desc(p, nb + half * 2 + 1);
            wt_load(d0, t, v0, g0); wt_load(d1, t, v1, g1);
            wt_store(c0, t, l0); wt_store(c1, t, l1);
            __syncthreads();
        }
    }
    {
        float* z = (float*)(ws + OFF_SSQ_Q);
        for (int i = blockIdx.x * NTHR + tid; i < 5 * T; i += gridDim.x * NTHR) z[i] = 0.f;
    }
    const int lane = tid & 63, w = tid >> 6;
    for (int row0 = (blockIdx.x * NWV + w) * 4; row0 < T + MEMT; row0 += gridDim.x * NWV * 4) {
        f32x4 v[4][4];
#pragma unroll
        for (int r = 0; r < 4; ++r) { const int row = row0 + r; const float* src = row >= T ? p.mem + (size_t)(row - T) * DM : p.x + (size_t)row * DM;
#pragma unroll
            for (int i = 0; i < 4; ++i) v[r][i] = *(const f32x4*)(src + i * 256 + lane * 4); }
#pragma unroll
        for (int r = 0; r < 4; ++r) {
            const int row = row0 + r; const bool ismem = row >= T;
            float ss = 0.f;
#pragma unroll
            for (int i = 0; i < 4; ++i) ss += v[r][i][0] * v[r][i][0] + v[r][i][1] * v[r][i][1] + v[r][i][2] * v[r][i][2] + v[r][i][3] * v[r][i][3];
#pragma unroll
            for (int o = 32; o >= 1; o >>= 1) ss += __shfl_xor(ss, o);
            const float rstd = rsqrtf(ss * (1.0f / DM) + EPS);
            if (!ismem) {
                bf16_t* d = (bf16_t*)(ws + OFF_XB) + (size_t)row * DM;
#pragma unroll
                for (int i = 0; i < 4; ++i) st_bf4(d + i * 256 + lane * 4, v[r][i][0], v[r][i][1], v[r][i][2], v[r][i][3]);
                if (lane == 0) ((float*)(ws + OFF_RSTD0))[row] = rstd;
                if (lane < 16) {
                    const float invf = exp2f(-(float)(2 * lane) * (13.287712379549449f / 32.0f));
                    const float ang = (float)p.pos[row] * invf;
                    const double a = (double)ang; const double kq = rint(a * 0.15915494309189535); const float rr = (float)(a - kq * 6.283185307179586);
                    f32x2 cs; cs.x = __cosf(rr); cs.y = __sinf(rr);
                    ((f32x2*)(ws + OFF_CS))[(size_t)row * 16 + lane] = cs;
                }
            } else {
                bf16_t* d = (bf16_t*)(ws + OFF_MNB) + (size_t)(row - T) * DM;
#pragma unroll
                for (int i = 0; i < 4; ++i) { const f32x4 g = *(const f32x4*)(p.g_mem + i * 256 + lane * 4);
                    st_bf4(d + i * 256 + lane * 4, v[r][i][0] * rstd * g[0], v[r][i][1] * rstd * g[1], v[r][i][2] * rstd * g[2], v[r][i][3] * rstd * g[3]); }
            }
        }
    }
}

typedef f32x4 Acc[2][2][4][2];
DI float sq4(const f32x4& v) { return v[0] * v[0] + v[1] * v[1] + v[2] * v[2] + v[3] * v[3]; }
DI float red_fq(float s) { s += __shfl_xor(s, 16); s += __shfl_xor(s, 32); return s; }
DI float sigm(float z) { return __builtin_amdgcn_rcpf(1.f + ex2(-z * LOG2E)); }

struct Epi1 {
    static constexpr bool PERM = false, AFTER_DRAIN = false;
    char* ws; const float* b_gate;
    DI void operator()(const Acc& acc, const Unit& u, int wr, int wc, int fr, int fq) const {
        const int pn = u.pn;
        float rsv[2][4];
#pragma unroll
        for (int ai = 0; ai < 2; ++ai)
#pragma unroll
            for (int m = 0; m < 4; ++m) rsv[ai][m] = ((const float*)(ws + OFF_RSTD0))[u.pm * 256 + ai * 128 + wr * 64 + m * 16 + fr];
#pragma unroll
        for (int ai = 0; ai < 2; ++ai)
#pragma unroll
            for (int m = 0; m < 4; ++m) {
                const int tok = u.pm * 256 + ai * 128 + wr * 64 + m * 16 + fr;
                const float rs = rsv[ai][m];
                if (pn <= 1) {
                    bf16_t* d = (bf16_t*)(ws + (pn == 0 ? OFF_CQ : OFF_CKV)) + (size_t)tok * 256 + wc * 32 + fq * 4;
                    float ssq = 0.f;
#pragma unroll
                    for (int bj = 0; bj < 2; ++bj)
#pragma unroll
                        for (int n = 0; n < 2; ++n) { const f32x4 v = acc[ai][bj][m][n] * rs; if (pn == 0 || bj == 0) ssq += sq4(v); st_bf4(d + bj * 128 + n * 16, v[0], v[1], v[2], v[3]); }
                    ssq = red_fq(ssq);
                    if (fq == 0) atomicAdd((float*)(ws + (pn == 0 ? OFF_SSQ_Q : OFF_SSQ_KV)) + tok, ssq);
                    if (pn == 1 && wc == 0) {
                        const f32x4 c01 = *(const f32x4*)(ws + OFF_CS + ((size_t)tok * 16 + fq * 4) * 8), c23 = *(const f32x4*)(ws + OFF_CS + ((size_t)tok * 16 + fq * 4 + 2) * 8);
                        const f32x4 x1 = acc[ai][1][m][0] * rs, x2 = acc[ai][1][m][1] * rs;
                        const float cs_[4] = {c01[0], c01[2], c23[0], c23[2]}, sn_[4] = {c01[1], c01[3], c23[1], c23[3]};
                        float lo[4], hi[4];
#pragma unroll
                        for (int j = 0; j < 4; ++j) { lo[j] = x1[j] * cs_[j] - x2[j] * sn_[j]; hi[j] = x2[j] * cs_[j] + x1[j] * sn_[j]; }
                        bf16_t* k = (bf16_t*)(ws + OFF_KA) + (size_t)tok * 768 + 64 + fq * 4;
#pragma unroll
                        for (int h = 0; h < 8; ++h) { st_bf4(k + h * 96, lo[0], lo[1], lo[2], lo[3]); st_bf4(k + h * 96 + 16, hi[0], hi[1], hi[2], hi[3]); }
                    }
                } else if (pn < 6) {
                    bf16_t* d = (bf16_t*)(ws + (pn < 4 ? OFF_SBQ : OFF_SBK)) + (size_t)tok * 512 + ((pn & 1) * 256) + wc * 32 + fq * 4;
#pragma unroll
                    for (int bj = 0; bj < 2; ++bj)
#pragma unroll
                        for (int n = 0; n < 2; ++n) { const f32x4 v = acc[ai][bj][m][n] * rs; st_bf4(d + bj * 128 + n * 16, v[0], v[1], v[2], v[3]); }
                } else {
                    const int gi = pn >= 10; const int c0 = (pn - (gi ? 10 : 6)) * 256 + wc * 32 + fq * 4;
                    bf16_t* d = (bf16_t*)(ws + (gi ? OFF_SIGB : OFF_SIGA)) + (size_t)tok * DM + c0;
                    const float* bg = b_gate + gi * DM + c0;
#pragma unroll
                    for (int bj = 0; bj < 2; ++bj)
#pragma unroll
                        for (int n = 0; n < 2; ++n) { const f32x4 bb = *(const f32x4*)(bg + bj * 128 + n * 16); const f32x4 v = acc[ai][bj][m][n] * rs + bb;
                            st_bf4(d + bj * 128 + n * 16, sigm(v[0]), sigm(v[1]), sigm(v[2]), sigm(v[3])); }
                }
            }
    }
};

DI void ld_rstd0(const float* rstd0, const Unit& u, int wr, int fr, float (&rs)[2][4]) {
#pragma unroll
    for (int ai = 0; ai < 2; ++ai)
#pragma unroll
        for (int m = 0; m < 4; ++m) rs[ai][m] = rstd0[u.pm * 256 + ai * 128 + wr * 64 + m * 16 + fr];
}
struct EpiGate {
    static constexpr bool PERM = true, AFTER_DRAIN = false;
    char* ws; const float* b_gate;
    DI void operator()(const Acc& acc, const Unit& u, int wr, int wc, int fr, int fq) const {
        const int gi = u.pn >= 4; const int cb = (u.pn & 3) * 256 + wc * 32 + fq * 8;
        bf16_t* outp = (bf16_t*)(ws + (gi ? OFF_SIGB : OFF_SIGA));
        float rs[2][4]; ld_rstd0((const float*)(ws + OFF_RSTD0), u, wr, fr, rs);
        f32x4 bb[2][2];
#pragma unroll
        for (int bj = 0; bj < 2; ++bj) { bb[bj][0] = *(const f32x4*)(b_gate + gi * DM + cb + bj * 128); bb[bj][1] = *(const f32x4*)(b_gate + gi * DM + cb + bj * 128 + 4); }
#pragma unroll
        for (int bj = 0; bj < 2; ++bj)
#pragma unroll
            for (int ai = 0; ai < 2; ++ai)
#pragma unroll
                for (int m = 0; m < 4; ++m) {
                    const int tok = u.pm * 256 + ai * 128 + wr * 64 + m * 16 + fr;
                    f32x4 a = acc[ai][bj][m][0] * rs[ai][m] + bb[bj][0], b = acc[ai][bj][m][1] * rs[ai][m] + bb[bj][1];
#pragma unroll
                    for (int j = 0; j < 4; ++j) { a[j] = sigm(a[j]); b[j] = sigm(b[j]); }
                    st_bf8(outp + (size_t)tok * DM + cb + bj * 128, a, b);
                }
    }
};

template <int SMODE>
struct EpiVt {
    static constexpr bool PERM = true, AFTER_DRAIN = false;
    bf16_t* out; int ldo; const float* sc;
    DI void operator()(const Acc& acc, const Unit& u, int wr, int wc, int fr, int fq) const {
#pragma unroll
        for (int bj = 0; bj < 2; ++bj) {
            const int col = u.pn * 256 + bj * 128 + wc * 32 + fq * 8;
            f32x4 s0 = {1.f, 1.f, 1.f, 1.f}, s1 = s0;
            if (SMODE >= 1) { s0 = *(const f32x4*)(sc + col); s1 = *(const f32x4*)(sc + col + 4); }
            if (SMODE == 2) {
#pragma unroll
                for (int j = 0; j < 4; ++j) { s0[j] = rsqrtf(s0[j] * (1.0f / 128.0f) + EPS); s1[j] = rsqrtf(s1[j] * (1.0f / 128.0f) + EPS); }
            }
#pragma unroll
            for (int ai = 0; ai < 2; ++ai)
#pragma unroll
                for (int m = 0; m < 4; ++m) { const int row = u.pm * 256 + ai * 128 + wr * 64 + m * 16 + fr;
                    st_bf8(out + (size_t)row * ldo + col, acc[ai][bj][m][0] * s0, acc[ai][bj][m][1] * s1); }
        }
    }
};

struct Epi2q {
    static constexpr bool PERM = false, AFTER_DRAIN = false;
    char* ws;
    DI void operator()(const Acc& acc, const Unit& u, int wr, int wc, int fr, int fq) const {
        float rs[2][4]; ld_rstd0((const float*)(ws + OFF_SSQ_Q), u, wr, fr, rs);
#pragma unroll
        for (int ai = 0; ai < 2; ++ai) {
#pragma unroll
            for (int m = 0; m < 4; ++m) rs[ai][m] = rsqrtf(rs[ai][m] * (1.0f / 256.0f) + EPS);
#pragma unroll
            for (int m = 0; m < 4; ++m) {
                const int tok = u.pm * 256 + ai * 128 + wr * 64 + m * 16 + fr;
                const f32x4 c01m = *(const f32x4*)(ws + OFF_CS + ((size_t)tok * 16 + fq * 4) * 8), c23m = *(const f32x4*)(ws + OFF_CS + ((size_t)tok * 16 + fq * 4 + 2) * 8);
#pragma unroll
                for (int bj = 0; bj < 2; ++bj) {
                    const int cg0 = u.pn * 256 + bj * 128 + wc * 32;
                    bf16_t* d = (bf16_t*)(ws + OFF_QA) + (size_t)tok * 768 + cg0 + fq * 4;
                    const f32x4 x1 = acc[ai][bj][m][0] * rs[ai][m], x2 = acc[ai][bj][m][1] * rs[ai][m];
                    if (((cg0 >> 5) % 3) == 2) {
                        const f32x4 a = c01m, b = c23m;
                        const float cs_[4] = {a[0], a[2], b[0], b[2]}, sn_[4] = {a[1], a[3], b[1], b[3]};
                        float lo[4], hi[4];
#pragma unroll
                        for (int j = 0; j < 4; ++j) { lo[j] = x1[j] * cs_[j] - x2[j] * sn_[j]; hi[j] = x2[j] * cs_[j] + x1[j] * sn_[j]; }
                        st_bf4(d, lo[0], lo[1], lo[2], lo[3]); st_bf4(d + 16, hi[0], hi[1], hi[2], hi[3]);
                    } else { st_bf4(d, x1[0], x1[1], x1[2], x1[3]); st_bf4(d + 16, x2[0], x2[1], x2[2], x2[3]); }
                }
            }
        }
    }
};

template <int RMODE  , bool KA  >
struct EpiBf {
    static constexpr bool PERM = true, AFTER_DRAIN = false;
    bf16_t* out; int ldo; const float* ssq;
    DI void operator()(const Acc& acc, const Unit& u, int wr, int wc, int fr, int fq) const {
        float rs[2][4];
        if (RMODE != 0) ld_rstd0(ssq, u, wr, fr, rs);
#pragma unroll
        for (int ai = 0; ai < 2; ++ai)
#pragma unroll
            for (int m = 0; m < 4; ++m) { if (RMODE == 0) rs[ai][m] = 1.f; if (RMODE == 1) rs[ai][m] = rsqrtf(rs[ai][m] * (1.0f / 1024.0f) + EPS); if (RMODE == 2) rs[ai][m] = rsqrtf(rs[ai][m] * (1.0f / 128.0f) + EPS); }
#pragma unroll
        for (int ai = 0; ai < 2; ++ai)
#pragma unroll
            for (int m = 0; m < 4; ++m) {
                const int tok = u.pm * 256 + ai * 128 + wr * 64 + m * 16 + fr;
#pragma unroll
                for (int bj = 0; bj < 2; ++bj) { int col = u.pn * 256 + bj * 128 + wc * 32 + fq * 8; if (KA) col = (col >> 6) * 96 + (col & 63);
                    st_bf8(out + (size_t)tok * ldo + col, acc[ai][bj][m][0] * rs[ai][m], acc[ai][bj][m][1] * rs[ai][m]); }
            }
    }
};

template <int STEP>
struct Epi4 {
    static constexpr bool PERM = true, AFTER_DRAIN = false;
    const bf16_t* sig; bf16_t* ta; bf16_t* merged;
    DI void operator()(const Acc& acc, const Unit& u, int wr, int wc, int fr, int fq) const {
#pragma unroll
        for (int ai = 0; ai < 2; ++ai) {
            u32x4 sg[4][2], tv[4][2];
#pragma unroll
            for (int m = 0; m < 4; ++m)
#pragma unroll
                for (int bj = 0; bj < 2; ++bj) { const size_t off = (size_t)(u.pm * 256 + ai * 128 + wr * 64 + m * 16 + fr) * DM + u.pn * 256 + bj * 128 + wc * 32 + fq * 8;
                    sg[m][bj] = *(const u32x4*)(sig + off); if (STEP == 1) tv[m][bj] = *(const u32x4*)(ta + off); }
#pragma unroll
            for (int m = 0; m < 4; ++m)
#pragma unroll
                for (int bj = 0; bj < 2; ++bj) { const size_t off = (size_t)(u.pm * 256 + ai * 128 + wr * 64 + m * 16 + fr) * DM + u.pn * 256 + bj * 128 + wc * 32 + fq * 8;
                    const u32x4 s4 = sg[m][bj];
                    f32x4 a = acc[ai][bj][m][0], b = acc[ai][bj][m][1];
                    a[0] *= bflo(s4.x); a[1] *= bfhi(s4.x); a[2] *= bflo(s4.y); a[3] *= bfhi(s4.y); b[0] *= bflo(s4.z); b[1] *= bfhi(s4.z); b[2] *= bflo(s4.w); b[3] *= bfhi(s4.w);
                    if (STEP == 0) st_bf8(ta + off, a, b);
                    else { const u32x4 t4 = tv[m][bj]; a[0] += bflo(t4.x); a[1] += bfhi(t4.x); a[2] += bflo(t4.y); a[3] += bfhi(t4.y); b[0] += bflo(t4.z); b[1] += bfhi(t4.z); b[2] += bflo(t4.w); b[3] += bfhi(t4.w); st_bf8(merged + off, a, b); } }
        }
    }
};

struct EpiRes {
    static constexpr bool PERM = true, AFTER_DRAIN = false;
    const float* res; float* out; bf16_t* outb; float* ssq;
    DI void operator()(const Acc& acc, const Unit& u, int wr, int wc, int fr, int fq) const {
#pragma unroll
        for (int ai = 0; ai < 2; ++ai)
#pragma unroll
            for (int mh = 0; mh < 2; ++mh) {
                f32x4 rv[2][2][2];
#pragma unroll
                for (int mi = 0; mi < 2; ++mi)
#pragma unroll
                    for (int bj = 0; bj < 2; ++bj) { const size_t off = (size_t)(u.pm * 256 + ai * 128 + wr * 64 + (mh * 2 + mi) * 16 + fr) * DM + u.pn * 256 + bj * 128 + wc * 32 + fq * 8;
                        rv[mi][bj][0] = *(const f32x4*)(res + off); rv[mi][bj][1] = *(const f32x4*)(res + off + 4); }
#pragma unroll
                for (int mi = 0; mi < 2; ++mi) {
                    const int m = mh * 2 + mi; const int tok = u.pm * 256 + ai * 128 + wr * 64 + m * 16 + fr; float s = 0.f;
#pragma unroll
                    for (int bj = 0; bj < 2; ++bj) { const size_t off = (size_t)tok * DM + u.pn * 256 + bj * 128 + wc * 32 + fq * 8;
                        const f32x4 a = rv[mi][bj][0] + acc[ai][bj][m][0], b = rv[mi][bj][1] + acc[ai][bj][m][1];
                        s += sq4(a) + sq4(b);
                        *(f32x4*)(out + off) = a; *(f32x4*)(out + off + 4) = b;
                        if (outb) st_bf8(outb + off, a, b); }
                    s = red_fq(s);
                    if (fq == 0) atomicAdd(ssq + tok, s);
                }
            }
    }
};

struct Epi9 {
    static constexpr bool PERM = true, AFTER_DRAIN = false;
    bf16_t* hid; const float* ssq;
    DI void operator()(const Acc& acc, const Unit& u, int wr, int wc, int fr, int fq) const {
        float rs[2][4]; ld_rstd0(ssq, u, wr, fr, rs);
#pragma unroll
        for (int ai = 0; ai < 2; ++ai)
#pragma unroll
            for (int m = 0; m < 4; ++m) rs[ai][m] = rsqrtf(rs[ai][m] * (1.0f / 1024.0f) + EPS);
#pragma unroll
        for (int ai = 0; ai < 2; ++ai)
#pragma unroll
            for (int m = 0; m < 4; ++m) {
                const int tok = u.pm * 256 + ai * 128 + wr * 64 + m * 16 + fr;
                f32x4 o[2];
#pragma unroll
                for (int n = 0; n < 2; ++n)
#pragma unroll
                    for (int j = 0; j < 4; ++j) { const float g = acc[ai][0][m][n][j] * rs[ai][m], uu = acc[ai][1][m][n][j] * rs[ai][m]; o[n][j] = g * sigm(g) * uu; }
                st_bf8(hid + (size_t)tok * DFF + u.pn * 128 + wc * 32 + fq * 8, o[0], o[1]);
            }
    }
};

template <class Epi>
DI void run_gemm_at(LAS unsigned char* L, const int tid, int first, const bf16_t* A, const bf16_t* Bt, int M, int N, int K, const Epi& E) {
    pg8::Gemm g{A, Bt, M, N, K}; pg8::StaticOrder S; S.init(M, N, (int)gridDim.x, (int)((blockIdx.x + gridDim.x - first) % gridDim.x));
    pg8::gemm_phase<Epi, pg8::StaticOrder, true, true>(L, g, S, E, tid);
}
template <class Epi>
DI void run_gemm(LAS unsigned char* L, const int tid, const bf16_t* A, const bf16_t* Bt, int M, int N, int K, const Epi& E) {
    pg8::Gemm g{A, Bt, M, N, K}; pg8::StaticOrder S; S.init(M, N, (int)gridDim.x, (int)blockIdx.x);
    pg8::gemm_phase<Epi, pg8::StaticOrder, true, true>(L, g, S, E, tid);
}

template <int DQK> DI int ksw(int row, int c) { return DQK == 64 ? (c ^ ((row >> 1) & 7)) : DQK == 96 ? (c ^ ((row >> 2) & 3)) : (c ^ (row & 15)); }

template <int DQK, int DV, int MODE>
DI void attn_block(const bf16_t* __restrict__ Q, int ldq, const bf16_t* __restrict__ Kp, int ldk, const bf16_t* __restrict__ Vt, int ldv,
                   bf16_t* __restrict__ O, int ldo, int q0, int ntiles, char* lds, const int tid) {
    constexpr int NCK = DQK / 8, KB = 64 * DQK * 2, VB = DV * 128, STG = KB + VB, NKC = 64 * NCK, NKL = (NKC + NTHR - 1) / NTHR, NVL = DV * 8 / NTHR, NKK = DQK / 16, NDT = DV / 32;
    const int t = tid, lane = t & 63, w = t >> 6, fr = lane & 31, fh = lane >> 5;
    const int qrow = q0 + w * 32 + fr;
    const int qlo = q0 + w * 32, qhi = qlo + 31;
    unsigned* flags = (unsigned*)(lds + 2 * STG);
    bf16x8 qf[NKK];
#pragma unroll
    for (int kk = 0; kk < NKK; ++kk) qf[kk] = *(const bf16x8*)(Q + (size_t)qrow * ldq + kk * 16 + fh * 8);
    f32x16 o[NDT];
#pragma unroll
    for (int d = 0; d < NDT; ++d)
#pragma unroll
        for (int r = 0; r < 16; ++r) o[d][r] = 0.f;
    float l_run = 0.f;
    f32x16 negm;
#pragma unroll
    for (int r = 0; r < 16; ++r) negm[r] = 0.f;
    bool first = true;
    float m_run = -1e30f;
    u32x4 rk[NKL], rv[NVL];
    auto gload = [&](int kt) {
        const int key0 = kt * 64;
#pragma unroll
        for (int i = 0; i < NKL; ++i) { const int id = t + NTHR * i; if (NKC % NTHR == 0 || id < NKC) { const int row = id / NCK, c = id - row * NCK; rk[i] = *(const u32x4*)(Kp + (size_t)(key0 + row) * ldk + c * 8); } }
#pragma unroll
        for (int i = 0; i < NVL; ++i) { const int id = t + NTHR * i; const int row = id >> 3, c = id & 7; rv[i] = *(const u32x4*)(Vt + (size_t)row * ldv + key0 + c * 8); }
    };
    auto sstore = [&](char* buf) {
#pragma unroll
        for (int i = 0; i < NKL; ++i) { const int id = t + NTHR * i; if (NKC % NTHR == 0 || id < NKC) { const int row = id / NCK, c = id - row * NCK; *(u32x4*)(buf + row * (DQK * 2) + (ksw<DQK>(row, c) << 4)) = rk[i]; } }
#pragma unroll
        for (int i = 0; i < NVL; ++i) { const int id = t + NTHR * i; const int row = id >> 3, c = id & 7; const int g2 = (c >> 1) * 2, a = c & 1, sw = (row >> 1) & 7;
            char* rb_ = buf + KB + row * 128 + a * 8;
            u32x2 lo2, hi2; lo2.x = rv[i].x; lo2.y = rv[i].y; hi2.x = rv[i].z; hi2.y = rv[i].w;
            *(u32x2*)(rb_ + ((g2 ^ sw) << 4)) = lo2; *(u32x2*)(rb_ + (((g2 + 1) ^ sw) << 4)) = hi2; }
    };
    auto tile_of = [&](int it) { return MODE == 1 ? (ntiles - 1 - it) : it; };
    gload(tile_of(0)); sstore(lds); __syncthreads();
    for (int it = 0; it < ntiles; ++it) {
        const int kt = tile_of(it), key0 = kt * 64;
        const char* buf = lds + (it & 1) * STG;
        const bool more = it + 1 < ntiles;
        if (more && MODE != 2) gload(tile_of(it + 1));
        bool active;
        if (MODE == 0) active = key0 <= qhi; else if (MODE == 1) active = key0 < qhi && !(__all(l_run > 152.f) != 0); else active = true;
        if (active) {
            f32x16 s[2];
            if (MODE != 0) {
#pragma unroll
                for (int mt = 0; mt < 2; ++mt)
#pragma unroll
                    for (int r = 0; r < 16; ++r) s[mt][r] = 0.f;
            }
#pragma unroll
            for (int kk = 0; kk < NKK; ++kk)
#pragma unroll
                for (int mt = 0; mt < 2; ++mt) { const int row = mt * 32 + fr; const bf16x8 kf = *(const bf16x8*)(buf + row * (DQK * 2) + (ksw<DQK>(row, kk * 2 + fh) << 4));
                    if (MODE == 0 && kk == 0) s[mt] = MFMA(kf, qf[kk], negm); else s[mt] = MFMA(kf, qf[kk], s[mt]); }
            bf16x8 pf[4];
            if (MODE != 1) {
                if (MODE == 0 && key0 + 63 > qlo) {
#pragma unroll
                    for (int mt = 0; mt < 2; ++mt)
#pragma unroll
                        for (int r = 0; r < 16; ++r) { const int key = key0 + mt * 32 + (r >> 2) * 8 + fh * 4 + (r & 3); if (key > qrow) s[mt][r] = -1e30f; }
                }
                float mx = s[0][0];
#pragma unroll
                for (int mt = 0; mt < 2; ++mt)
#pragma unroll
                    for (int r = 0; r < 16; ++r) mx = fmaxf(mx, s[mt][r]);
                mx = fmaxf(mx, shx32(mx));
                if (MODE == 2) {
                    if (__any(mx > m_run + 8.f)) {
                        const float mnew = fmaxf(m_run, mx); const float alpha = ex2(m_run - mnew); m_run = mnew; l_run *= alpha;
#pragma unroll
                        for (int d = 0; d < NDT; ++d)
#pragma unroll
                            for (int r = 0; r < 16; ++r) o[d][r] *= alpha;
                    }
#pragma unroll
                    for (int mt = 0; mt < 2; ++mt)
#pragma unroll
                        for (int r = 0; r < 16; ++r) s[mt][r] -= m_run;
                } else
                if (first || __any(mx > 8.f)) {
                    const float delta = first ? mx : fmaxf(mx, 0.f); const float alpha = first ? 1.f : ex2(-delta); l_run *= alpha; first = false;
#pragma unroll
                    for (int d = 0; d < NDT; ++d)
#pragma unroll
                        for (int r = 0; r < 16; ++r) o[d][r] *= alpha;
#pragma unroll
                    for (int mt = 0; mt < 2; ++mt)
#pragma unroll
                        for (int r = 0; r < 16; ++r) s[mt][r] -= delta;
#pragma unroll
                    for (int r = 0; r < 16; ++r) negm[r] -= delta;
                }
                float sum = 0.f;
#pragma unroll
                for (int mt = 0; mt < 2; ++mt)
#pragma unroll
                    for (int r = 0; r < 16; ++r) { const float pv = ex2(s[mt][r]); s[mt][r] = pv; sum += pv; }
                l_run += sum;
            } else {
                const bool diag = key0 + 63 >= qlo;
                float G[8];
#pragma unroll
                for (int mt = 0; mt < 2; ++mt)
#pragma unroll
                    for (int rg = 0; rg < 4; ++rg) {
                        float g = 0.f;
#pragma unroll
                        for (int j = 3; j >= 0; --j) { const int r = rg * 4 + j; const float z = s[mt][r];
                            const float wv = lg2(1.f + ex2(-fabsf(z)));
                            float nlom = fmaxf(z, 0.f) + wv; float nl = nlom - z;
                            if (diag) { const int key = key0 + mt * 32 + rg * 8 + fh * 4 + j; if (key >= qrow) { nlom = 0.f; nl = 1e30f; } }
                            s[mt][r] = nl + g; g += nlom; }
                        G[mt * 4 + rg] = g;
                    }
                float base[8]; float run = l_run;
#pragma unroll
                for (int oc = 7; oc >= 0; --oc) { const float gp = shx32(G[oc]); base[oc] = run + (fh == 0 ? gp : 0.f); run += G[oc] + gp; }
                l_run = run;
#pragma unroll
                for (int mt = 0; mt < 2; ++mt)
#pragma unroll
                    for (int r = 0; r < 16; ++r) s[mt][r] = ex2(-(s[mt][r] + base[mt * 4 + (r >> 2)]));
            }
#pragma unroll
            for (int s4 = 0; s4 < 4; ++s4) { u32x4 pk; const int mt = s4 >> 1, rb = (s4 & 1) * 8;
                pk.x = pk2(s[mt][rb], s[mt][rb + 1]); pk.y = pk2(s[mt][rb + 2], s[mt][rb + 3]); pk.z = pk2(s[mt][rb + 4], s[mt][rb + 5]); pk.w = pk2(s[mt][rb + 6], s[mt][rb + 7]);
                pf[s4] = __builtin_bit_cast(bf16x8, pk); }
#pragma unroll
            for (int s4 = 0; s4 < 4; ++s4)
#pragma unroll
                for (int d = 0; d < NDT; ++d) { const int row = d * 32 + fr; const bf16x8 vf = *(const bf16x8*)(buf + KB + row * 128 + (((s4 * 2 + fh) ^ ((row >> 1) & 7)) << 4)); o[d] = MFMA(vf, pf[s4], o[d]); }
        }
        if (more) { if (MODE == 2) gload(tile_of(it + 1)); sstore(lds + ((it + 1) & 1) * STG); }
        if (MODE == 1) {
            const bool fin = __all(l_run > 152.f) != 0;
            if (lane == 0) flags[(it & 1) * NWV + w] = fin ? 1u : 0u;
            __syncthreads();
            const unsigned* f = flags + (it & 1) * NWV;
            if ((f[0] & f[1] & f[2] & f[3] & f[4] & f[5] & f[6] & f[7]) != 0u) break;
        } else {
            __syncthreads();
        }
    }
    float inv = 1.f;
    if (MODE != 1) { const float lt = l_run + shx32(l_run); inv = 1.f / lt; }
#pragma unroll
    for (int d = 0; d < NDT; ++d)
#pragma unroll
        for (int rg = 0; rg < 4; ++rg) st_bf4(O + (size_t)qrow * ldo + d * 32 + rg * 8 + fh * 4, o[d][rg * 4] * inv, o[d][rg * 4 + 1] * inv, o[d][rg * 4 + 2] * inv, o[d][rg * 4 + 3] * inv);
}

DI void phase3(const Params& p, char* lds, const int tid) {
    char* ws = p.ws;
    constexpr int NMLA = 32 * 16, NSB = 32 * 32;
    for (int u = blockIdx.x; u < NMLA + NSB; u += gridDim.x) {
        if (u < NMLA) {
            const int xcd = u & 7, v = u >> 3; const int pr = v & 15, bh = (v >> 4) * 8 + xcd; const int b = bh >> 3, h = bh & 7;
            const bf16_t* Q = (const bf16_t*)(ws + OFF_QA) + (size_t)b * SEQ * 768 + h * 96;
            const bf16_t* Kp = (const bf16_t*)(ws + OFF_KA) + (size_t)b * SEQ * 768 + h * 96;
            const bf16_t* Vt = (const bf16_t*)(ws + OFF_VTA) + (size_t)(h * 64) * T + (size_t)b * SEQ;
            bf16_t* O = (bf16_t*)(ws + OFF_OA) + (size_t)b * SEQ * 512 + h * 64;
#pragma unroll 1
            for (int half = 0; half < 2; ++half) { const int qb = half ? pr : 31 - pr;
                attn_block<96, 64, 0>(Q, 768, Kp, 768, Vt, T, O, 512, qb * 256, 4 * qb + 4, lds, tid); }
        } else {
            const int uu = u - NMLA; const int xcd = uu & 7, v = uu >> 3; const int qb = v & 31, bh = (v >> 5) * 8 + xcd; const int b = bh >> 3, h = bh & 7;
            const bf16_t* Q = (const bf16_t*)(ws + OFF_SBQ) + (size_t)b * SEQ * 512 + h * 64;
            const bf16_t* Kp = (const bf16_t*)(ws + OFF_SBK) + (size_t)b * SEQ * 512 + h * 64;
            const bf16_t* Vt = (const bf16_t*)(ws + OFF_VTB) + (size_t)(h * 64) * T + (size_t)b * SEQ;
            bf16_t* O = (bf16_t*)(ws + OFF_OB) + (size_t)b * SEQ * 512 + h * 64;
            attn_block<64, 64, 1>(Q, 512, Kp, 512, Vt, T, O, 512, qb * 256, 4 * qb + 4, lds, tid);
        }
    }
}

DI void phase7(const Params& p, char* lds, const int tid) {
    char* ws = p.ws;
    for (int u = blockIdx.x; u < 16 * 32; u += gridDim.x) {
        const int xcd = u & 7, v = u >> 3; const int qb = v & 31, bh = (v >> 5) * 8 + xcd; const int b = bh >> 2, h = bh & 3;
        const bf16_t* Q = (const bf16_t*)(ws + OFF_XQ) + (size_t)b * SEQ * 512 + h * 128;
        const bf16_t* Kp = (const bf16_t*)(ws + OFF_XK) + (size_t)b * MEML * 512 + h * 128;
        const bf16_t* Vt = (const bf16_t*)(ws + OFF_XVT) + (size_t)(h * 128) * MEMT + (size_t)b * MEML;
        bf16_t* O = (bf16_t*)(ws + OFF_XO) + (size_t)b * SEQ * 512 + h * 128;
        attn_block<128, 128, 2>(Q, 512, Kp, 512, Vt, MEMT, O, 512, qb * 256, 4, lds, tid);
    }
}

DI void phase11(const Params& p, const int tid) {
    const float* ssq3 = (const float*)(p.ws + OFF_SSQ3);
    const int lane = tid & 63, w = tid >> 6;
    f32x4 g[4];
#pragma unroll
    for (int i = 0; i < 4; ++i) g[i] = *(const f32x4*)(p.g_final + i * 256 + lane * 4);
    for (int row0 = (blockIdx.x * NWV + w) * 4; row0 < T; row0 += gridDim.x * NWV * 4) {
        f32x4 v[4][4]; float rs[4];
#pragma unroll
        for (int r = 0; r < 4; ++r) { rs[r] = ssq3[row0 + r];
#pragma unroll
            for (int i = 0; i < 4; ++i) v[r][i] = *(const f32x4*)(p.out + (size_t)(row0 + r) * DM + i * 256 + lane * 4); }
#pragma unroll
        for (int r = 0; r < 4; ++r) { const float s = rsqrtf(rs[r] * (1.0f / DM) + EPS);
#pragma unroll
            for (int i = 0; i < 4; ++i) { f32x4 o = v[r][i]; o[0] *= s * g[i][0]; o[1] *= s * g[i][1]; o[2] *= s * g[i][2]; o[3] *= s * g[i][3];
                *(f32x4*)(p.out + (size_t)(row0 + r) * DM + i * 256 + lane * 4) = o; } }
    }
}

#define XB_TMO      128
#define XB_XCNT(j)  (256  + 64 * (j))
#define XB_XSUB(j)  (1280 + 64 * (j))
#define XB_XGEN(j)  (2304 + 64 * (j))
#define XB_TOP      3328
#define XB_TOPGEN   3392
#define XCD_BAR_WORDS 3456
#define XB_SPIN_CAP (1u << 22)
DI unsigned xb_ld(unsigned* p) { return __hip_atomic_load(p, __ATOMIC_RELAXED, __HIP_MEMORY_SCOPE_AGENT); }
DI unsigned xb_add(unsigned* p, unsigned v) { return __hip_atomic_fetch_add(p, v, __ATOMIC_RELAXED, __HIP_MEMORY_SCOPE_AGENT); }
DI unsigned xb_xcc_id() { return (unsigned)__builtin_amdgcn_s_getreg((3 << 11) | 20) & 0xFu; }
#define XB_SPIN(cond, bar) do { unsigned _sp = 0; while (cond) { __builtin_amdgcn_s_sleep(1); \
    if ((++_sp & 255u) == 0u) { if (xb_ld(&(bar)[XB_TMO])) break; if (_sp > XB_SPIN_CAP) { atomicAdd(&(bar)[XB_TMO], 1u); break; } } } } while (0)
struct XcdBarrier { unsigned* bar; unsigned x; volatile LAS unsigned* st; };
DI XcdBarrier xcd_barrier_post(unsigned* bar, volatile LAS unsigned* st, const int tid) {
    XcdBarrier b; b.bar = bar; b.x = xb_xcc_id(); b.st = st;
    if (tid == 0) (void)xb_add(&bar[XB_XCNT(b.x)], 1u);
    return b;
}
DI void xcd_barrier_complete(unsigned* bar, unsigned x, unsigned& nloc, unsigned& nx) {
    const unsigned G = gridDim.x * gridDim.y * gridDim.z;
    unsigned sum, cnt, mine, sp = 0u;
    for (;;) {
        sum = 0u; cnt = 0u; mine = 0u;
#pragma unroll
        for (unsigned j = 0; j < 16; ++j) { const unsigned c = xb_ld(&bar[XB_XCNT(j)]); sum += c; cnt += (c > 0u) ? 1u : 0u; mine = (j == x) ? c : mine; }
        if (sum == G) break;
        __builtin_amdgcn_s_sleep(1);
        if ((++sp & 255u) == 0u) { if (xb_ld(&bar[XB_TMO])) break; if (sp > XB_SPIN_CAP) { atomicAdd(&bar[XB_TMO], 1u); break; } }
    }
    nloc = mine > 0u ? mine : 1u; nx = cnt > 0u ? cnt : 1u;
}
DI void xcd_barrier(const XcdBarrier& b, const int tid) {
    asm volatile("s_waitcnt vmcnt(0)" ::: "memory");
    __syncthreads();
    if (tid == 0) {
        unsigned* bar = b.bar;
        __builtin_amdgcn_s_waitcnt(0);
        unsigned nloc = b.st[0], nx = b.st[1];
        if (nloc == 0u) { xcd_barrier_complete(bar, b.x, nloc, nx); b.st[0] = nloc; b.st[1] = nx; }
        const unsigned old = xb_add(&bar[XB_XSUB(b.x)], 1u);
        const unsigned gen = old / nloc;
        if (old + 1u == (gen + 1u) * nloc) {
            __builtin_amdgcn_fence(__ATOMIC_RELEASE, "agent");
            asm volatile("s_waitcnt vmcnt(0)" ::: "memory");
            const unsigned og = xb_add(&bar[XB_TOP], 1u);
            const unsigned tg = og / nx;
            if (og + 1u == (tg + 1u) * nx) xb_add(&bar[XB_TOPGEN], 1u);
            else XB_SPIN(xb_ld(&bar[XB_TOPGEN]) == tg, bar);
            __builtin_amdgcn_fence(__ATOMIC_ACQUIRE, "agent");
            xb_add(&bar[XB_XGEN(b.x)], 1u);
            asm volatile("s_waitcnt vmcnt(0)" ::: "memory");
        } else {
            XB_SPIN(xb_ld(&bar[XB_XGEN(b.x)]) == gen, bar);
            __builtin_amdgcn_fence(__ATOMIC_ACQUIRE, "agent");
            asm volatile("s_waitcnt vmcnt(0)" ::: "memory");
        }
    }
    __syncthreads();
}


constexpr int NPHASE = 12;
__global__ void __launch_bounds__(NTHR, 2) mega(Params p, int ph_lo, int ph_hi, int coop) {
    extern __shared__ __attribute__((aligned(16))) unsigned char dlds[];
    LAS unsigned char* L = (LAS unsigned char*)dlds;
    char* lds = (char*)dlds;
    char* ws = p.ws;
    const int swid = __builtin_amdgcn_readfirstlane((int)(threadIdx.x >> 6));
#define MYTID (swid * 64 + lane_id_fresh())
    volatile LAS unsigned* xbw = (volatile LAS unsigned*)(L + LDS_XB);
    if (threadIdx.x < 4) xbw[threadIdx.x] = 0u;
    __syncthreads();
    XcdBarrier xb; xb.bar = (unsigned*)(ws + OFF_BAR); xb.x = 0; xb.st = xbw;
    if (coop) xb = xcd_barrier_post((unsigned*)(ws + OFF_BAR), xbw, MYTID);
    if (coop == 2) cg::this_grid().sync();
#define PH(n, call) if (ph_lo <= n && n < ph_hi) { call; } if (coop && n + 1 < NPHASE) xcd_barrier(xb, MYTID);
    PH(0, phase0(p, lds, MYTID))
    PH(1, { run_gemm(L, MYTID, (const bf16_t*)(ws + OFF_XB), (const bf16_t*)(ws + OFF_WIN), T, 1536, DM, Epi1{ws, p.b_gate});
            run_gemm(L, MYTID, (const bf16_t*)(ws + OFF_XB), (const bf16_t*)(ws + OFF_WIN) + (size_t)1536 * DM, T, 2048, DM, EpiGate{ws, p.b_gate});
            run_gemm(L, MYTID, (const bf16_t*)(ws + OFF_WV), (const bf16_t*)(ws + OFF_XB), 512, T, DM, EpiVt<1>{(bf16_t*)(ws + OFF_VTB), T, (const float*)(ws + OFF_RSTD0)}); })
    PH(2, { run_gemm(L, MYTID, (const bf16_t*)(ws + OFF_CQ), (const bf16_t*)(ws + OFF_WUQ), T, 768, 256, Epi2q{ws});
            run_gemm(L, MYTID, (const bf16_t*)(ws + OFF_CKV), (const bf16_t*)(ws + OFF_WUK), T, 512, 256, EpiBf<2, true>{(bf16_t*)(ws + OFF_KA), 768, (const float*)(ws + OFF_SSQ_KV)});
            run_gemm(L, MYTID, (const bf16_t*)(ws + OFF_WUV), (const bf16_t*)(ws + OFF_CKV), 512, T, 256, EpiVt<2>{(bf16_t*)(ws + OFF_VTA), T, (const float*)(ws + OFF_SSQ_KV)});
            run_gemm_at(L, MYTID, 128, (const bf16_t*)(ws + OFF_MNB), (const bf16_t*)(ws + OFF_WXKV), MEMT, 512, DM, EpiBf<0, false>{(bf16_t*)(ws + OFF_XK), 512, nullptr});
            run_gemm_at(L, MYTID, 144, (const bf16_t*)(ws + OFF_WXKV) + (size_t)512 * DM, (const bf16_t*)(ws + OFF_MNB), 512, MEMT, DM, EpiVt<0>{(bf16_t*)(ws + OFF_XVT), MEMT, nullptr}); })
    PH(3, phase3(p, lds, MYTID))
    PH(4, { run_gemm(L, MYTID, (const bf16_t*)(ws + OFF_OA), (const bf16_t*)(ws + OFF_WA), T, DM, 512, Epi4<0>{(const bf16_t*)(ws + OFF_SIGA), (bf16_t*)(ws + OFF_VTA), nullptr});
            run_gemm(L, MYTID, (const bf16_t*)(ws + OFF_OB), (const bf16_t*)(ws + OFF_WB), T, DM, 512, Epi4<1>{(const bf16_t*)(ws + OFF_SIGB), (bf16_t*)(ws + OFF_VTA), (bf16_t*)(ws + OFF_MERGED)}); })
    PH(5, run_gemm(L, MYTID, (const bf16_t*)(ws + OFF_MERGED), (const bf16_t*)(ws + OFF_WO), T, DM, DM, EpiRes{p.x, p.out, (bf16_t*)(ws + OFF_X1B), (float*)(ws + OFF_SSQ1)}))
    PH(6, run_gemm(L, MYTID, (const bf16_t*)(ws + OFF_X1B), (const bf16_t*)(ws + OFF_WXQ), T, 512, DM, EpiBf<1, false>{(bf16_t*)(ws + OFF_XQ), 512, (const float*)(ws + OFF_SSQ1)}))
    PH(7, phase7(p, lds, MYTID))
    PH(8, run_gemm(L, MYTID, (const bf16_t*)(ws + OFF_XO), (const bf16_t*)(ws + OFF_WXO), T, DM, 512, EpiRes{p.out, p.out, (bf16_t*)(ws + OFF_X2B), (float*)(ws + OFF_SSQ2)}))
    PH(9, run_gemm(L, MYTID, (const bf16_t*)(ws + OFF_X2B), (const bf16_t*)(ws + OFF_WGU), T, 2 * DFF, DM, Epi9{(bf16_t*)(ws + OFF_HID), (const float*)(ws + OFF_SSQ2)}))
    PH(10, run_gemm(L, MYTID, (const bf16_t*)(ws + OFF_HID), (const bf16_t*)(ws + OFF_WD), T, DM, DFF, EpiRes{p.out, p.out, nullptr, (float*)(ws + OFF_SSQ3)}))
    PH(11, phase11(p, MYTID))
}

extern "C" void kernel_launch(void* const* d_in, const int* in_sizes, int n_in, void* d_out, int out_size, void* d_ws, size_t ws_size, hipStream_t stream) {
    static int grid_blocks = 0;
    if (!grid_blocks) {
        int dev = 0, cus = 0, per_cu = 0;
        (void)hipGetDevice(&dev);
        (void)hipDeviceGetAttribute(&cus, hipDeviceAttributeMultiprocessorCount, dev);
        (void)hipFuncSetAttribute((const void*)mega, hipFuncAttributeMaxDynamicSharedMemorySize, LDS_BYTES);
        (void)hipOccupancyMaxActiveBlocksPerMultiprocessor(&per_cu, mega, NTHR, LDS_BYTES);
        if (per_cu != 1) per_cu = 1;
        grid_blocks = cus * per_cu;
    }
    Params p{};
    p.x = (const float*)d_in[0]; p.mem = (const float*)d_in[1]; p.pos = (const int*)d_in[2];
    p.g_mix = (const float*)d_in[3]; p.w_in = (const float*)d_in[4]; p.b_gate = (const float*)d_in[5]; p.g_q_lat = (const float*)d_in[6]; p.w_uq = (const float*)d_in[7];
    p.g_kv_lat = (const float*)d_in[8]; p.w_ukv = (const float*)d_in[9]; p.w_a = (const float*)d_in[10]; p.w_b = (const float*)d_in[11]; p.w_o = (const float*)d_in[12];
    p.g_x = (const float*)d_in[13]; p.g_mem = (const float*)d_in[14]; p.w_xq = (const float*)d_in[15]; p.w_xkv = (const float*)d_in[16]; p.w_xo = (const float*)d_in[17];
    p.g_ffn = (const float*)d_in[18]; p.w_gate = (const float*)d_in[19]; p.w_up = (const float*)d_in[20]; p.w_down = (const float*)d_in[21]; p.g_final = (const float*)d_in[22];
    p.out = (float*)d_out; p.ws = (char*)d_ws;
#if ONE_LAUNCH
    int lo = 0, hi = NPHASE, coop = 1;
    (void)hipMemsetAsync((char*)d_ws + OFF_BAR, 0, XCD_BAR_WORDS * sizeof(unsigned), stream);
    void* args[] = {&p, &lo, &hi, &coop};
    hipError_t e = hipLaunchCooperativeKernel((void*)mega, dim3(grid_blocks), dim3(NTHR), args, LDS_BYTES, stream);
    if (e != hipSuccess) fprintf(stderr, "cooperative launch failed: %s (grid %d)\n", hipGetErrorString(e), grid_blocks);
#else
    for (int ph = 0; ph < NPHASE; ++ph) mega<<<dim3(grid_blocks), dim3(NTHR), LDS_BYTES, stream>>>(p, ph, ph + 1, 0);
#endif
}
```

```cpp
#include <hip/hip_runtime.h>
#include <hip/hip_cooperative_groups.h>
#include <cstdio>
#include <cstdint>
namespace cg = cooperative_groups;

#ifndef ONE_LAUNCH
#define ONE_LAUNCH 1
#endif

namespace pg8 {
#define PG8_LAS __attribute__((address_space(3)))
typedef unsigned short bf16_t;
typedef short bf16x8 __attribute__((ext_vector_type(8)));
typedef float f32x4 __attribute__((ext_vector_type(4)));
typedef unsigned u32x4 __attribute__((ext_vector_type(4)));
constexpr int BM = 256, BK = 64, HALF = 128, HTB = HALF * BK * 2  , STAGE_BYTES = 8 * HTB, NXCD = 8, WGM = 8;

__host__ __device__ __forceinline__ int lds_byte(int r, int c) { const int st = (r >> 4) * 2 + (c >> 5), rr = r & 15, cc = c & 31, ob = rr * 64 + cc * 2; return st * 1024 + (ob ^ (((ob >> 9) & 1) << 5)); }
__host__ __device__ __forceinline__ void stage_rc(int b, int& R, int& C) { const int st = b / 1024, sb = b % 1024, swz = sb ^ (((sb >> 9) & 1) << 5); R = (st >> 1) * 16 + swz / 64; C = (st & 1) * 32 + (swz % 64) / 2; }
__host__ __device__ __forceinline__ int perm32(int rho) { const int n = rho >> 4, i = rho & 15; return 8 * (i >> 2) + 4 * n + (i & 3); }

struct Unit { int pm, pn; };
struct Gemm { const bf16_t* A; const bf16_t* Bt; int M, N, K; };

struct StaticOrder {
    int nM, nN, nwg, G, c;
    __host__ __device__ void init(int M, int N, int G_, int c_) { nM = M / BM; nN = N / BM; nwg = nM * nN; G = G_; c = c_; }
    __host__ __device__ bool next(int i, Unit& u) const {
        const long L = (long)i * G + c; if (L >= nwg) return false;
        int wgid = (int)L; { const int q = nwg / NXCD, r = nwg % NXCD, xcd = wgid % NXCD, off = wgid / NXCD; wgid = (xcd < r ? xcd * (q + 1) : r * (q + 1) + (xcd - r) * q) + off; }
        const int nig = WGM * nN, gid = wgid / nig, fm = gid * WGM, gsz = (nM - fm) < WGM ? (nM - fm) : WGM;
        u.pm = fm + ((wgid % nig) % gsz); u.pn = (wgid % nig) / gsz; return true;
    }
    __device__ __forceinline__ void a_ready(const Unit&) const {}
    __device__ __forceinline__ void done(const Unit&) const {}
};


template <class Epi, class Sched, bool ALIGN_EPI = false, bool SP2 = false>
__device__ __forceinline__ void gemm_phase(PG8_LAS unsigned char* lds, const Gemm g, const Sched& S, const Epi& E, const int tid_in) {
    int tid_ = tid_in; asm volatile("" : "+v"(tid_));
    const int tid = tid_, wid = __builtin_amdgcn_readfirstlane(tid >> 6), lane = tid & 63, wr = wid >> 2, wc = wid & 3, fr = lane & 15, fq = lane >> 4;
    const int K = g.K, nt = K / BK;
    unsigned voffA[2], voffB[2];
#pragma unroll
    for (int i = 0; i < 2; ++i) { int R, C; stage_rc(tid * 16 + i * 8192, R, C); const int Rb = Epi::PERM ? ((R & ~31) + perm32(R & 31)) : R;
        voffA[i] = (unsigned)(R * K + C) * 2u; voffB[i] = (unsigned)(Rb * K + C) * 2u; }
    const size_t kstep = (size_t)(BK * 2);
    const size_t hstep = (size_t)HALF * K * 2;
    const size_t tstep = 2 * hstep;
    const unsigned ldsw = (unsigned)wid * 1024u;
    const int aoff = lds_byte(wr * 64 + fr, fq * 8), boff = lds_byte(wc * 32 + fr, fq * 8);
#define PG8_SA(b, h) (((b) * 2 + (h)) * HTB)
#define PG8_SB(b, h) ((4 + (b) * 2 + (h)) * HTB)
#define PG8_STAGE(bufoff, gbase, voff) do { _Pragma("unroll") for (int _i = 0; _i < 2; ++_i) \
        __builtin_amdgcn_global_load_lds((const unsigned*)((const char*)(gbase) + (voff)[_i]), (PG8_LAS unsigned*)(lds + (bufoff) + ldsw + _i * 8192), 16, 0, 0); } while (0)
#define PG8_LDA(dst, b, h) do { _Pragma("unroll") for (int m = 0; m < 4; ++m) _Pragma("unroll") for (int k = 0; k < 2; ++k) dst[m][k] = *(const PG8_LAS bf16x8*)(lds + PG8_SA(b, h) + aoff + m * 2048 + k * 1024); } while (0)
#define PG8_LDB(dst, b, h) do { _Pragma("unroll") for (int n = 0; n < 2; ++n) _Pragma("unroll") for (int k = 0; k < 2; ++k) dst[n][k] = *(const PG8_LAS bf16x8*)(lds + PG8_SB(b, h) + boff + n * 2048 + k * 1024); } while (0)
#define PG8_MMA(ai, bj, At, Bt) do { __builtin_amdgcn_s_setprio(1); _Pragma("unroll") for (int m = 0; m < 4; ++m) _Pragma("unroll") for (int n = 0; n < 2; ++n) _Pragma("unroll") for (int k = 0; k < 2; ++k) \
        acc[ai][bj][m][n] = __builtin_amdgcn_mfma_f32_16x16x32_bf16(Bt[n][k], At[m][k], acc[ai][bj][m][n], 0, 0, 0); __builtin_amdgcn_s_setprio(0); } while (0)
#define PG8_WAIT_V(n) asm volatile("s_waitcnt vmcnt(" #n ")" ::: "memory")
#define PG8_WAIT_L(n) asm volatile("s_waitcnt lgkmcnt(" #n ")" ::: "memory")
#define PG8_BAR __builtin_amdgcn_s_barrier()
#define PG8_SCHED __builtin_amdgcn_sched_barrier(0)
    Unit cur, nxt; int ui = 0;
    if (!S.next(0, cur)) return;
    f32x4 acc[2][2][4][2];
#pragma unroll
    for (int a = 0; a < 2; ++a)
#pragma unroll
        for (int b = 0; b < 2; ++b)
#pragma unroll
            for (int m = 0; m < 4; ++m)
#pragma unroll
                for (int n = 0; n < 2; ++n) acc[a][b][m][n] = (f32x4){0.f, 0.f, 0.f, 0.f};
    bf16x8 At[4][2], B0[2][2], B1[2][2];
    const char* cA = (const char*)g.A + (size_t)cur.pm * tstep; const char* cB = (const char*)g.Bt + (size_t)cur.pn * tstep;
    S.a_ready(cur);
    if constexpr (SP2) {
        PG8_STAGE(PG8_SB(0, 0), cB, voffB); PG8_STAGE(PG8_SB(0, 1), cB + hstep, voffB); PG8_STAGE(PG8_SA(0, 0), cA, voffA); PG8_STAGE(PG8_SA(0, 1), cA + hstep, voffA);
        if (wr == 1) PG8_BAR;
        PG8_WAIT_V(2); PG8_BAR;
        PG8_STAGE(PG8_SB(1, 0), cB + kstep, voffB); PG8_STAGE(PG8_SA(1, 0), cA + kstep, voffA); PG8_STAGE(PG8_SB(1, 1), cB + hstep + kstep, voffB);
        PG8_WAIT_V(6); PG8_BAR;
    } else {
        PG8_STAGE(PG8_SB(0, 0), cB, voffB); PG8_STAGE(PG8_SA(0, 0), cA, voffA); PG8_STAGE(PG8_SB(0, 1), cB + hstep, voffB); PG8_STAGE(PG8_SA(0, 1), cA + hstep, voffA);
        if (wr == 1) PG8_BAR;
        PG8_WAIT_V(4); PG8_BAR;
        PG8_STAGE(PG8_SB(1, 0), cB + kstep, voffB); PG8_STAGE(PG8_SA(1, 0), cA + kstep, voffA); PG8_STAGE(PG8_SB(1, 1), cB + hstep + kstep, voffB);
        PG8_WAIT_V(6); PG8_BAR;
    }
    for (;;) {
        const bool has_next = S.next(ui + 1, nxt);
        const char* nA = has_next ? (const char*)g.A + (size_t)nxt.pm * tstep : cA; const char* nB = has_next ? (const char*)g.Bt + (size_t)nxt.pn * tstep : cB;
        for (int t = 0; t < nt; t += 2) {
            if constexpr (Epi::MID) { if (t == nt / 2) { int fr3 = fr, fq3 = fq; asm volatile("" : "+v"(fr3), "+v"(fq3)); E.mid(acc, cur, wr, wc, fr3, fq3); } }
            const bool last = (t == nt - 2);
            const char* a1 = cA + (size_t)(t + 1) * kstep;
            const char* a2 = last ? nA : cA + (size_t)(t + 2) * kstep; const char* b2 = last ? nB : cB + (size_t)(t + 2) * kstep;
            const char* a3 = a2 + kstep; const char* b3 = b2 + kstep;
            if (last && has_next) S.a_ready(nxt);
            if constexpr (SP2) {
            PG8_LDB(B0, 0, 0); PG8_LDB(B1, 0, 1); PG8_SCHED; PG8_LDA(At, 0, 0); PG8_STAGE(PG8_SA(1, 1), a1 + hstep, voffA);
            PG8_WAIT_V(8); PG8_WAIT_L(0); PG8_BAR; PG8_MMA(0, 0, At, B0); PG8_MMA(0, 1, At, B1); PG8_BAR; PG8_SCHED;
            PG8_LDA(At, 0, 1); PG8_STAGE(PG8_SB(0, 0), b2, voffB); PG8_STAGE(PG8_SB(0, 1), b2 + hstep, voffB); PG8_STAGE(PG8_SA(0, 0), a2, voffA);
            PG8_WAIT_V(8); PG8_WAIT_L(0); PG8_BAR; PG8_MMA(1, 0, At, B0); PG8_MMA(1, 1, At, B1); PG8_BAR; PG8_SCHED;
            PG8_LDB(B0, 1, 0); PG8_LDB(B1, 1, 1); PG8_SCHED; PG8_LDA(At, 1, 0); PG8_STAGE(PG8_SA(0, 1), a2 + hstep, voffA);
            PG8_WAIT_V(8); PG8_WAIT_L(0); PG8_BAR; PG8_MMA(0, 0, At, B0); PG8_MMA(0, 1, At, B1); PG8_BAR; PG8_SCHED;
            PG8_LDA(At, 1, 1); PG8_STAGE(PG8_SB(1, 0), b3, voffB); PG8_STAGE(PG8_SB(1, 1), b3 + hstep, voffB); PG8_STAGE(PG8_SA(1, 0), a3, voffA);
            PG8_WAIT_V(8); PG8_WAIT_L(0); PG8_BAR; PG8_MMA(1, 0, At, B0); PG8_MMA(1, 1, At, B1); PG8_BAR; PG8_SCHED;
            } else {
            PG8_LDB(B0, 0, 0); PG8_SCHED; PG8_LDA(At, 0, 0); PG8_STAGE(PG8_SA(1, 1), a1 + hstep, voffA);
            PG8_WAIT_L(8); PG8_BAR; PG8_WAIT_L(0); PG8_MMA(0, 0, At, B0); PG8_BAR; PG8_SCHED;
            PG8_LDB(B1, 0, 1); PG8_STAGE(PG8_SB(0, 0), b2, voffB);
            PG8_BAR; PG8_WAIT_L(0); PG8_MMA(0, 1, At, B1); PG8_BAR;
            PG8_LDA(At, 0, 1); PG8_STAGE(PG8_SA(0, 0), a2, voffA);
            PG8_BAR; PG8_WAIT_L(0); PG8_MMA(1, 0, At, B0); PG8_BAR; PG8_SCHED;
            PG8_STAGE(PG8_SB(0, 1), b2 + hstep, voffB);
            PG8_WAIT_V(6); PG8_BAR; PG8_MMA(1, 1, At, B1); PG8_BAR;
            PG8_LDB(B0, 1, 0); PG8_SCHED; PG8_LDA(At, 1, 0); PG8_STAGE(PG8_SA(0, 1), a2 + hstep, voffA);
            PG8_WAIT_L(8); PG8_BAR; PG8_WAIT_L(0); PG8_MMA(0, 0, At, B0); PG8_BAR; PG8_SCHED;
            PG8_LDB(B1, 1, 1); PG8_STAGE(PG8_SB(1, 0), b3, voffB);
            PG8_BAR; PG8_WAIT_L(0); PG8_MMA(0, 1, At, B1); PG8_BAR;
            PG8_LDA(At, 1, 1); PG8_STAGE(PG8_SA(1, 0), a3, voffA);
            PG8_BAR; PG8_WAIT_L(0); PG8_MMA(1, 0, At, B0); PG8_BAR; PG8_SCHED;
            PG8_STAGE(PG8_SB(1, 1), b3 + hstep, voffB);
            PG8_WAIT_V(6); PG8_BAR; PG8_MMA(1, 1, At, B1); PG8_BAR;
            }
        }
        if constexpr (ALIGN_EPI) { if (wr == 0) PG8_BAR; }
        if constexpr (!Epi::AFTER_DRAIN) { int fr2 = fr, fq2 = fq; asm volatile("" : "+v"(fr2), "+v"(fq2));
            E(acc, cur, wr, wc, fr2, fq2); S.done(cur); }
        if (!has_next) break;
#pragma unroll
        for (int a = 0; a < 2; ++a)
#pragma unroll
            for (int b = 0; b < 2; ++b)
#pragma unroll
                for (int m = 0; m < 4; ++m)
#pragma unroll
                    for (int n = 0; n < 2; ++n) acc[a][b][m][n] = (f32x4){0.f, 0.f, 0.f, 0.f};
        cur = nxt; cA = nA; cB = nB; ++ui;
        if constexpr (ALIGN_EPI) { if (wr == 1) PG8_BAR; }
    }
    PG8_WAIT_V(0);
    if constexpr (!ALIGN_EPI) { if (wr == 0) PG8_BAR; }
    PG8_BAR;
    if constexpr (Epi::AFTER_DRAIN) { E.fused(acc, cur, wr, wc, fr, fq, lds, wid, lane); S.done(cur); }
#undef PG8_SA
#undef PG8_SB
#undef PG8_STAGE
#undef PG8_LDA
#undef PG8_LDB
#undef PG8_MMA
#undef PG8_WAIT_V
#undef PG8_WAIT_L
#undef PG8_BAR
#undef PG8_SCHED
}
}


typedef unsigned short bf16_t;
typedef short bf16x8 __attribute__((ext_vector_type(8)));
typedef float f32x16 __attribute__((ext_vector_type(16)));
typedef float f32x4 __attribute__((ext_vector_type(4)));
typedef float f32x2 __attribute__((ext_vector_type(2)));
typedef unsigned u32x4 __attribute__((ext_vector_type(4)));
typedef unsigned u32x2 __attribute__((ext_vector_type(2)));
typedef __bf16 bf16x2_t __attribute__((ext_vector_type(2)));
#define DI __device__ __forceinline__
#define LAS __attribute__((address_space(3)))
#define MFMA(a, b, c) __builtin_amdgcn_mfma_f32_32x32x16_bf16((a), (b), (c), 0, 0, 0)
using pg8::Unit;

constexpr int T = 32768, SEQ = 8192, NB = 4, DM = 1024, MEMT = 1024, MEML = 256;
constexpr int DFF = 2816;
constexpr int NTHR = 512, NWV = 8;
constexpr float EPS = 1e-6f;
constexpr float LOG2E = 1.4426950408889634f;
constexpr int LDS_BYTES = 147456;
constexpr int LDS_XB = 131072 + 1024;

constexpr size_t MB = 1024 * 1024;
constexpr size_t OFF_SSQ_Q = 0;
constexpr size_t OFF_SSQ_KV = OFF_SSQ_Q + T * 4;
constexpr size_t OFF_SSQ1 = OFF_SSQ_KV + T * 4;
constexpr size_t OFF_SSQ2 = OFF_SSQ1 + T * 4;
constexpr size_t OFF_SSQ3 = OFF_SSQ2 + T * 4;
constexpr size_t OFF_RSTD0 = OFF_SSQ3 + T * 4;
constexpr size_t OFF_BAR = 832 * 1024;
constexpr size_t OFF_CS = 1 * MB;
constexpr size_t OFF_WIN = 5 * MB;
constexpr size_t OFF_WV = OFF_WIN + 7 * MB;
constexpr size_t OFF_WUQ = OFF_WV + 1 * MB;
constexpr size_t OFF_WUK = OFF_WUQ + 768 * 256 * 2;
constexpr size_t OFF_WUV = OFF_WUK + 512 * 256 * 2;
constexpr size_t OFF_WA = OFF_WUV + 512 * 256 * 2;
constexpr size_t OFF_WB = OFF_WA + 1 * MB;
constexpr size_t OFF_WO = OFF_WB + 1 * MB;
constexpr size_t OFF_WXQ = OFF_WO + 2 * MB;
constexpr size_t OFF_WXKV = OFF_WXQ + 1 * MB;
constexpr size_t OFF_WXO = OFF_WXKV + 2 * MB;
constexpr size_t OFF_WGU = OFF_WXO + 1 * MB;
constexpr size_t OFF_WD = OFF_WGU + 11 * MB;
constexpr size_t OFF_MNB = OFF_WD + 6 * MB;
constexpr size_t OFF_XK = OFF_MNB + 2 * MB;
constexpr size_t OFF_XVT = OFF_XK + 1 * MB;
constexpr size_t OFF_ACT = 48 * MB;
static_assert(OFF_XVT + 1 * MB <= OFF_ACT, "ws map");
constexpr size_t OFF_XB = OFF_ACT;
constexpr size_t OFF_OA = OFF_XB;
constexpr size_t OFF_OB = OFF_XB + 32 * MB;
constexpr size_t OFF_CQ = OFF_XB + 64 * MB;
constexpr size_t OFF_CKV = OFF_CQ + 16 * MB;
constexpr size_t OFF_KA = OFF_CKV + 16 * MB;
constexpr size_t OFF_QA = OFF_KA + 48 * MB;
constexpr size_t OFF_VTA = OFF_QA + 48 * MB;
constexpr size_t OFF_SBQ = OFF_VTA + 32 * MB;
constexpr size_t OFF_SBK = OFF_SBQ + 32 * MB;
constexpr size_t OFF_VTB = OFF_SBK + 32 * MB;
constexpr size_t OFF_SIGA = OFF_VTB + 32 * MB;
constexpr size_t OFF_SIGB = OFF_SIGA + 64 * MB;
constexpr size_t WS_END = OFF_SIGB + 64 * MB;
static_assert(WS_END <= 512 * MB, "ws map");
constexpr size_t OFF_MERGED = OFF_KA;
constexpr size_t OFF_X1B = OFF_VTA;
constexpr size_t OFF_XQ = OFF_SBK;
constexpr size_t OFF_XO = OFF_VTB;
constexpr size_t OFF_X2B = OFF_SIGA;
constexpr size_t OFF_HID = OFF_KA;

struct Params {
    const float* x; const float* mem; const int* pos;
    const float* g_mix; const float* w_in; const float* b_gate; const float* g_q_lat; const float* w_uq;
    const float* g_kv_lat; const float* w_ukv; const float* w_a; const float* w_b; const float* w_o;
    const float* g_x; const float* g_mem; const float* w_xq; const float* w_xkv; const float* w_xo;
    const float* g_ffn; const float* w_gate; const float* w_up; const float* w_down; const float* g_final;
    float* out; char* ws;
};

DI unsigned pk2(float a, float b) { f32x2 v = {a, b}; bf16x2_t r = __builtin_convertvector(v, bf16x2_t); return __builtin_bit_cast(unsigned, r); }
DI bf16_t bf1(float a) { return (bf16_t)(pk2(a, 0.f) & 0xffffu); }
DI float ex2(float x) { return __builtin_amdgcn_exp2f(x); }
DI float lg2(float x) { return __builtin_amdgcn_logf(x); }
DI float shx32(float v) { return __shfl_xor(v, 32); }
DI int lane_id_fresh() { int l; asm volatile("v_mbcnt_lo_u32_b32 %0, -1, 0\n\tv_mbcnt_hi_u32_b32 %0, -1, %0" : "=v"(l)); return l; }
DI float bflo(unsigned u) { return __uint_as_float(u << 16); }
DI float bfhi(unsigned u) { return __uint_as_float(u & 0xffff0000u); }
DI void st_bf4(bf16_t* d, float a, float b, float c, float e) { u32x2 o; o.x = pk2(a, b); o.y = pk2(c, e); *(u32x2*)d = o; }
DI void st_bf8(bf16_t* d, const f32x4& a, const f32x4& b) { u32x4 o; o.x = pk2(a[0], a[1]); o.y = pk2(a[2], a[3]); o.z = pk2(b[0], b[1]); o.w = pk2(b[2], b[3]); *(u32x4*)d = o; }

struct WT { const float* src; const float* g; bf16_t* dst; int N, sc, k0, ks, K, drow0; float scale; };
constexpr float SBQ_SCALE = LOG2E * 0.125f;
constexpr float MLAQ_SCALE = LOG2E * 0.10206207261596577f;
constexpr float XQ_SCALE = LOG2E * 0.08838834764831845f;
constexpr int J0 = 112 * 16;
constexpr int J1 = J0 + 16 * 16;
constexpr int J2 = J1 + 24 * 4;
constexpr int J3 = J2 + 16 * 4;
constexpr int J4 = J3 + 16 * 4;
constexpr int J5 = J4 + 32 * 8;
constexpr int J6 = J5 + 32 * 8;
constexpr int J7 = J6 + 32 * 16;
constexpr int J8 = J7 + 16 * 16;
constexpr int J9 = J8 + 32 * 16;
constexpr int J10 = J9 + 32 * 8;
constexpr int J11 = J10 + 176 * 16;
constexpr int J12 = J11 + 32 * 44;
DI WT wt_desc(const Params& p, int tl) {
    char* ws = p.ws; WT d; d.g = nullptr; d.scale = 1.f; d.src = p.w_in; d.dst = (bf16_t*)(ws + OFF_WIN); d.N = 4000; d.sc = -2; d.k0 = 0; d.K = 1024; d.drow0 = 0;
    d.ks = 0;
    if (tl >= J12) return d;
    if (tl < J0) { const int jk = tl / 112, jn = tl - jk * 112; const int d0 = jn * 32; int sc; float s = 1.f;
        if (d0 < 416) sc = d0; else if (d0 < 512) sc = -1; else if (d0 < 1536) { sc = d0 - 96; if (d0 < 1024) s = SBQ_SCALE; } else sc = d0 + 416;
        d.sc = sc; d.k0 = jk * 64; d.drow0 = d0; d.g = p.g_mix; d.scale = s; }
    else if (tl < J1) { const int u = tl - J0; const int jk = u >> 4, jn = u & 15; d.sc = 1440 + jn * 32; d.k0 = jk * 64; d.dst = (bf16_t*)(ws + OFF_WV); d.drow0 = jn * 32; d.g = p.g_mix; }
    else if (tl < J2) { const int u = tl - J1; const int jk = u / 24, jn = u - jk * 24; d.src = p.w_uq; d.N = 768; d.sc = jn * 32; d.k0 = jk * 64; d.dst = (bf16_t*)(ws + OFF_WUQ); d.K = 256; d.drow0 = jn * 32; d.g = p.g_q_lat; d.scale = MLAQ_SCALE; }
    else if (tl < J4) { const bool isv = tl >= J3; const int u = tl - (isv ? J3 : J2); const int jk = u >> 4, jn = u & 15; const int d0 = jn * 32;
        d.src = p.w_ukv; d.N = 1024; d.sc = jk < 2 ? (d0 >> 6) * 128 + (isv ? 64 : 0) + (d0 & 63) : -1; d.k0 = jk * 64; d.dst = (bf16_t*)(ws + (isv ? OFF_WUV : OFF_WUK)); d.K = 256; d.drow0 = d0; d.g = p.g_kv_lat; }
    else if (tl < J6) { const bool isb = tl >= J5; const int u = tl - (isb ? J5 : J4); const int jk = u >> 5, jn = u & 31;
        d.src = isb ? p.w_b : p.w_a; d.N = 1024; d.sc = jn * 32; d.k0 = (isb ? 512 : 0) + jk * 64; d.ks = jk * 64; d.dst = (bf16_t*)(ws + OFF_WA); d.K = 1024; d.drow0 = jn * 32; return d; }
    else if (tl < J7) { const int u = tl - J6; const int jk = u >> 5, jn = u & 31; d.src = p.w_o; d.N = 1024; d.sc = jn * 32; d.k0 = jk * 64; d.dst = (bf16_t*)(ws + OFF_WO); d.drow0 = jn * 32; }
    else if (tl < J8) { const int u = tl - J7; const int jk = u >> 4, jn = u & 15; d.src = p.w_xq; d.N = 512; d.sc = jn * 32; d.k0 = jk * 64; d.dst = (bf16_t*)(ws + OFF_WXQ); d.drow0 = jn * 32; d.g = p.g_x; d.scale = XQ_SCALE; }
    else if (tl < J9) { const int u = tl - J8; const int jk = u >> 5, jn = u & 31; d.src = p.w_xkv; d.N = 1024; d.sc = jn * 32; d.k0 = jk * 64; d.dst = (bf16_t*)(ws + OFF_WXKV); d.drow0 = jn * 32; }
    else if (tl < J10) { const int u = tl - J9; const int jk = u >> 5, jn = u & 31; d.src = p.w_xo; d.N = 1024; d.sc = jn * 32; d.k0 = jk * 64; d.dst = (bf16_t*)(ws + OFF_WXO); d.K = 512; d.drow0 = jn * 32; }
    else if (tl < J11) { const int u = tl - J10; const int jk = u / 176, jn = u - jk * 176; const int d0 = jn * 32; const int rem = d0 & 255;
        d.src = (rem >= 128) ? p.w_up : p.w_gate; d.N = DFF; d.sc = (d0 >> 8) * 128 + (rem & 127); d.k0 = jk * 64; d.dst = (bf16_t*)(ws + OFF_WGU); d.drow0 = d0; d.g = p.g_ffn; }
    else { const int u = tl - J11; const int jk = u >> 5, jn = u & 31; d.src = p.w_down; d.N = 1024; d.sc = jn * 32; d.k0 = jk * 64; d.dst = (bf16_t*)(ws + OFF_WD); d.K = DFF; d.drow0 = jn * 32; }
    d.ks = d.k0;
    return d;
}
DI void wt_load(const WT& d, int t, float (&v)[8], float (&gv)[8]) {
    const int nn = t & 31, kb = t >> 5;
    const bool z = d.sc < 0; const int sc = z ? 0 : d.sc, ks = z ? 0 : d.ks;
    const float* gp = d.g ? d.g + ks : d.src;
#pragma unroll
    for (int i = 0; i < 8; ++i) { const int kk = kb + 8 * i; v[i] = d.src[(size_t)(ks + kk) * d.N + sc + nn]; gv[i] = gp[kk]; }
}
DI void wt_fix(const WT& d, float (&v)[8], const float (&gv)[8]) {
    const bool z = d.sc < 0;
#pragma unroll
    for (int i = 0; i < 8; ++i) { float x = v[i] * d.scale; if (d.g) x *= gv[i]; v[i] = z ? 0.f : x; }
}
DI void wt_put(float* l, int t, const float (&v)[8]) {
    const int nn = t & 31, kb = t >> 5;
#pragma unroll
    for (int i = 0; i < 8; ++i) l[(kb + 8 * i) * 33 + nn] = v[i];
}
DI void wt_store(const WT& d, int t, const float* l) {
    if (d.sc == -2) return;
    const int kk = t & 63, nb = t >> 6;
#pragma unroll
    for (int i = 0; i < 8; ++i) { const int nn = nb + 4 * i; d.dst[(size_t)(d.drow0 + nn) * d.K + d.k0 + kk] = bf1(l[kk * 33 + nn]); }
}

DI void phase0(const Params& p, char* ldsc, const int tid) {
    char* ws = p.ws;
    const int half = tid >> 8, t = tid & 255;
    float* l0 = (float*)ldsc + half * 2 * (64 * 33 + 16);
    float* l1 = l0 + (64 * 33 + 16);
    {
        int base = blockIdx.x * 4;
        WT d0 = wt_desc(p, base + half * 2), d1 = wt_desc(p, base + half * 2 + 1);
        float v0[8], v1[8], g0[8], g1[8];
        wt_load(d0, t, v0, g0); wt_load(d1, t, v1, g1);
        for (; base < J12; base += gridDim.x * 4) {
            wt_fix(d0, v0, g0); wt_fix(d1, v1, g1);
            wt_put(l0, t, v0); wt_put(l1, t, v1);
            __syncthreads();
            const WT c0 = d0, c1 = d1;
            const int nb = base + gridDim.x * 4;
            d0 = wt_desc(p, nb + half * 2); d1 = wt_desc(p, nb + half * 2 + 1);
            wt_load(d0, t, v0, g0); wt_load(d1, t, v1, g1);
            wt_store(c0, t, l0); wt_store(c1, t, l1);
            __syncthreads();
        }
    }
    {
        float* z = (float*)(ws + OFF_SSQ_Q);
        for (int i = blockIdx.x * NTHR + tid; i < 5 * T; i += gridDim.x * NTHR) z[i] = 0.f;
    }
    const int lane = tid & 63, w = tid >> 6;
    for (int row0 = (blockIdx.x * NWV + w) * 4; row0 < T + MEMT; row0 += gridDim.x * NWV * 4) {
        f32x4 v[4][4];
#pragma unroll
        for (int r = 0; r < 4; ++r) { const int row = row0 + r; const float* src = row >= T ? p.mem + (size_t)(row - T) * DM : p.x + (size_t)row * DM;
#pragma unroll
            for (int i = 0; i < 4; ++i) v[r][i] = *(const f32x4*)(src + i * 256 + lane * 4); }
#pragma unroll
        for (int r = 0; r < 4; ++r) {
            const int row = row0 + r; const bool ismem = row >= T;
            float ss = 0.f;
#pragma unroll
            for (int i = 0; i < 4; ++i) ss += v[r][i][0] * v[r][i][0] + v[r][i][1] * v[r][i][1] + v[r][i][2] * v[r][i][2] + v[r][i][3] * v[r][i][3];
#pragma unroll
            for (int o = 32; o >= 1; o >>= 1) ss += __shfl_xor(ss, o);
            const float rstd = rsqrtf(ss * (1.0f / DM) + EPS);
            if (!ismem) {
                bf16_t* d = (bf16_t*)(ws + OFF_XB) + (size_t)row * DM;
#pragma unroll
                for (int i = 0; i < 4; ++i) st_bf4(d + i * 256 + lane * 4, v[r][i][0], v[r][i][1], v[r][i][2], v[r][i][3]);
                if (lane == 0) ((float*)(ws + OFF_RSTD0))[row] = rstd;
                if (lane < 16) {
                    const float invf = exp2f(-(float)(2 * lane) * (13.287712379549449f / 32.0f));
                    const float ang = (float)p.pos[row] * invf;
                    const double a = (double)ang; const double kq = rint(a * 0.15915494309189535); const float rr = (float)(a - kq * 6.283185307179586);
                    f32x2 cs; cs.x = __cosf(rr); cs.y = __sinf(rr);
                    ((f32x2*)(ws + OFF_CS))[(size_t)row * 16 + lane] = cs;
                }
            } else {
                bf16_t* d = (bf16_t*)(ws + OFF_MNB) + (size_t)(row - T) * DM;
#pragma unroll
                for (int i = 0; i < 4; ++i) { const f32x4 g = *(const f32x4*)(p.g_mem + i * 256 + lane * 4);
                    st_bf4(d + i * 256 + lane * 4, v[r][i][0] * rstd * g[0], v[r][i][1] * rstd * g[1], v[r][i][2] * rstd * g[2], v[r][i][3] * rstd * g[3]); }
            }
        }
    }
}

typedef f32x4 Acc[2][2][4][2];
DI float sq4(const f32x4& v) { return v[0] * v[0] + v[1] * v[1] + v[2] * v[2] + v[3] * v[3]; }
DI float red_fq(float s) { s += __shfl_xor(s, 16); s += __shfl_xor(s, 32); return s; }
DI float sigm(float z) { return __builtin_amdgcn_rcpf(1.f + ex2(-z * LOG2E)); }

struct Epi1 {
    static constexpr bool PERM = false, AFTER_DRAIN = false, MID = false;
    char* ws; const float* b_gate;
    DI void operator()(const Acc& acc, const Unit& u, int wr, int wc, int fr, int fq) const {
        const int pn = u.pn;
        float rsv[2][4];
#pragma unroll
        for (int ai = 0; ai < 2; ++ai)
#pragma unroll
            for (int m = 0; m < 4; ++m) rsv[ai][m] = ((const float*)(ws + OFF_RSTD0))[u.pm * 256 + ai * 128 + wr * 64 + m * 16 + fr];
#pragma unroll
        for (int ai = 0; ai < 2; ++ai)
#pragma unroll
            for (int m = 0; m < 4; ++m) {
                const int tok = u.pm * 256 + ai * 128 + wr * 64 + m * 16 + fr;
                const float rs = rsv[ai][m];
                if (pn <= 1) {
                    bf16_t* d = (bf16_t*)(ws + (pn == 0 ? OFF_CQ : OFF_CKV)) + (size_t)tok * 256 + wc * 32 + fq * 4;
                    float ssq = 0.f;
#pragma unroll
                    for (int bj = 0; bj < 2; ++bj)
#pragma unroll
                        for (int n = 0; n < 2; ++n) { const f32x4 v = acc[ai][bj][m][n] * rs; if (pn == 0 || bj == 0) ssq += sq4(v); st_bf4(d + bj * 128 + n * 16, v[0], v[1], v[2], v[3]); }
                    ssq = red_fq(ssq);
                    if (fq == 0) atomicAdd((float*)(ws + (pn == 0 ? OFF_SSQ_Q : OFF_SSQ_KV)) + tok, ssq);
                    if (pn == 1 && wc == 0) {
                        const f32x4 c01 = *(const f32x4*)(ws + OFF_CS + ((size_t)tok * 16 + fq * 4) * 8), c23 = *(const f32x4*)(ws + OFF_CS + ((size_t)tok * 16 + fq * 4 + 2) * 8);
                        const f32x4 x1 = acc[ai][1][m][0] * rs, x2 = acc[ai][1][m][1] * rs;
                        const float cs_[4] = {c01[0], c01[2], c23[0], c23[2]}, sn_[4] = {c01[1], c01[3], c23[1], c23[3]};
                        float lo[4], hi[4];
#pragma unroll
                        for (int j = 0; j < 4; ++j) { lo[j] = x1[j] * cs_[j] - x2[j] * sn_[j]; hi[j] = x2[j] * cs_[j] + x1[j] * sn_[j]; }
                        bf16_t* k = (bf16_t*)(ws + OFF_KA) + (size_t)tok * 768 + 64 + fq * 4;
#pragma unroll
                        for (int h = 0; h < 8; ++h) { st_bf4(k + h * 96, lo[0], lo[1], lo[2], lo[3]); st_bf4(k + h * 96 + 16, hi[0], hi[1], hi[2], hi[3]); }
                    }
                } else if (pn < 6) {
                    bf16_t* d = (bf16_t*)(ws + (pn < 4 ? OFF_SBQ : OFF_SBK)) + (size_t)tok * 512 + ((pn & 1) * 256) + wc * 32 + fq * 4;
#pragma unroll
                    for (int bj = 0; bj < 2; ++bj)
#pragma unroll
                        for (int n = 0; n < 2; ++n) { const f32x4 v = acc[ai][bj][m][n] * rs; st_bf4(d + bj * 128 + n * 16, v[0], v[1], v[2], v[3]); }
                } else {
                    const int gi = pn >= 10; const int c0 = (pn - (gi ? 10 : 6)) * 256 + wc * 32 + fq * 4;
                    bf16_t* d = (bf16_t*)(ws + (gi ? OFF_SIGB : OFF_SIGA)) + (size_t)tok * DM + c0;
                    const float* bg = b_gate + gi * DM + c0;
#pragma unroll
                    for (int bj = 0; bj < 2; ++bj)
#pragma unroll
                        for (int n = 0; n < 2; ++n) { const f32x4 bb = *(const f32x4*)(bg + bj * 128 + n * 16); const f32x4 v = acc[ai][bj][m][n] * rs + bb;
                            st_bf4(d + bj * 128 + n * 16, sigm(v[0]), sigm(v[1]), sigm(v[2]), sigm(v[3])); }
                }
            }
    }
};

DI void ld_rstd0(const float* rstd0, const Unit& u, int wr, int fr, float (&rs)[2][4]) {
#pragma unroll
    for (int ai = 0; ai < 2; ++ai)
#pragma unroll
        for (int m = 0; m < 4; ++m) rs[ai][m] = rstd0[u.pm * 256 + ai * 128 + wr * 64 + m * 16 + fr];
}
struct EpiGate {
    static constexpr bool PERM = true, AFTER_DRAIN = false, MID = false;
    char* ws; const float* b_gate;
    DI void operator()(const Acc& acc, const Unit& u, int wr, int wc, int fr, int fq) const {
        const int gi = u.pn >= 4; const int cb = (u.pn & 3) * 256 + wc * 32 + fq * 8;
        bf16_t* outp = (bf16_t*)(ws + (gi ? OFF_SIGB : OFF_SIGA));
        float rs[2][4]; ld_rstd0((const float*)(ws + OFF_RSTD0), u, wr, fr, rs);
        f32x4 bb[2][2];
#pragma unroll
        for (int bj = 0; bj < 2; ++bj) { bb[bj][0] = *(const f32x4*)(b_gate + gi * DM + cb + bj * 128); bb[bj][1] = *(const f32x4*)(b_gate + gi * DM + cb + bj * 128 + 4); }
#pragma unroll
        for (int bj = 0; bj < 2; ++bj)
#pragma unroll
            for (int ai = 0; ai < 2; ++ai)
#pragma unroll
                for (int m = 0; m < 4; ++m) {
                    const int tok = u.pm * 256 + ai * 128 + wr * 64 + m * 16 + fr;
                    f32x4 a = acc[ai][bj][m][0] * rs[ai][m] + bb[bj][0], b = acc[ai][bj][m][1] * rs[ai][m] + bb[bj][1];
#pragma unroll
                    for (int j = 0; j < 4; ++j) { a[j] = sigm(a[j]); b[j] = sigm(b[j]); }
                    st_bf8(outp + (size_t)tok * DM + cb + bj * 128, a, b);
                }
    }
};

template <int SMODE>
struct EpiVt {
    static constexpr bool PERM = true, AFTER_DRAIN = false, MID = false;
    bf16_t* out; int ldo; const float* sc;
    DI void operator()(const Acc& acc, const Unit& u, int wr, int wc, int fr, int fq) const {
#pragma unroll
        for (int bj = 0; bj < 2; ++bj) {
            const int col = u.pn * 256 + bj * 128 + wc * 32 + fq * 8;
            f32x4 s0 = {1.f, 1.f, 1.f, 1.f}, s1 = s0;
            if (SMODE >= 1) { s0 = *(const f32x4*)(sc + col); s1 = *(const f32x4*)(sc + col + 4); }
            if (SMODE == 2) {
#pragma unroll
                for (int j = 0; j < 4; ++j) { s0[j] = rsqrtf(s0[j] * (1.0f / 128.0f) + EPS); s1[j] = rsqrtf(s1[j] * (1.0f / 128.0f) + EPS); }
            }
#pragma unroll
            for (int ai = 0; ai < 2; ++ai)
#pragma unroll
                for (int m = 0; m < 4; ++m) { const int row = u.pm * 256 + ai * 128 + wr * 64 + m * 16 + fr;
                    st_bf8(out + (size_t)row * ldo + col, acc[ai][bj][m][0] * s0, acc[ai][bj][m][1] * s1); }
        }
    }
};

struct Epi2q {
    static constexpr bool PERM = false, AFTER_DRAIN = false, MID = false;
    char* ws;
    DI void operator()(const Acc& acc, const Unit& u, int wr, int wc, int fr, int fq) const {
        float rs[2][4]; ld_rstd0((const float*)(ws + OFF_SSQ_Q), u, wr, fr, rs);
#pragma unroll
        for (int ai = 0; ai < 2; ++ai) {
#pragma unroll
            for (int m = 0; m < 4; ++m) rs[ai][m] = rsqrtf(rs[ai][m] * (1.0f / 256.0f) + EPS);
#pragma unroll
            for (int m = 0; m < 4; ++m) {
                const int tok = u.pm * 256 + ai * 128 + wr * 64 + m * 16 + fr;
                const f32x4 c01m = *(const f32x4*)(ws + OFF_CS + ((size_t)tok * 16 + fq * 4) * 8), c23m = *(const f32x4*)(ws + OFF_CS + ((size_t)tok * 16 + fq * 4 + 2) * 8);
#pragma unroll
                for (int bj = 0; bj < 2; ++bj) {
                    const int cg0 = u.pn * 256 + bj * 128 + wc * 32;
                    bf16_t* d = (bf16_t*)(ws + OFF_QA) + (size_t)tok * 768 + cg0 + fq * 4;
                    const f32x4 x1 = acc[ai][bj][m][0] * rs[ai][m], x2 = acc[ai][bj][m][1] * rs[ai][m];
                    if (((cg0 >> 5) % 3) == 2) {
                        const f32x4 a = c01m, b = c23m;
                        const float cs_[4] = {a[0], a[2], b[0], b[2]}, sn_[4] = {a[1], a[3], b[1], b[3]};
                        float lo[4], hi[4];
#pragma unroll
                        for (int j = 0; j < 4; ++j) { lo[j] = x1[j] * cs_[j] - x2[j] * sn_[j]; hi[j] = x2[j] * cs_[j] + x1[j] * sn_[j]; }
                        st_bf4(d, lo[0], lo[1], lo[2], lo[3]); st_bf4(d + 16, hi[0], hi[1], hi[2], hi[3]);
                    } else { st_bf4(d, x1[0], x1[1], x1[2], x1[3]); st_bf4(d + 16, x2[0], x2[1], x2[2], x2[3]); }
                }
            }
        }
    }
};

template <int RMODE  , bool KA  >
struct EpiBf {
    static constexpr bool PERM = true, AFTER_DRAIN = false, MID = false;
    bf16_t* out; int ldo; const float* ssq;
    DI void operator()(const Acc& acc, const Unit& u, int wr, int wc, int fr, int fq) const {
        float rs[2][4];
        if (RMODE != 0) ld_rstd0(ssq, u, wr, fr, rs);
#pragma unroll
        for (int ai = 0; ai < 2; ++ai)
#pragma unroll
            for (int m = 0; m < 4; ++m) { if (RMODE == 0) rs[ai][m] = 1.f; if (RMODE == 1) rs[ai][m] = rsqrtf(rs[ai][m] * (1.0f / 1024.0f) + EPS); if (RMODE == 2) rs[ai][m] = rsqrtf(rs[ai][m] * (1.0f / 128.0f) + EPS); }
#pragma unroll
        for (int ai = 0; ai < 2; ++ai)
#pragma unroll
            for (int m = 0; m < 4; ++m) {
                const int tok = u.pm * 256 + ai * 128 + wr * 64 + m * 16 + fr;
#pragma unroll
                for (int bj = 0; bj < 2; ++bj) { int col = u.pn * 256 + bj * 128 + wc * 32 + fq * 8; if (KA) col = (col >> 6) * 96 + (col & 63);
                    st_bf8(out + (size_t)tok * ldo + col, acc[ai][bj][m][0] * rs[ai][m], acc[ai][bj][m][1] * rs[ai][m]); }
            }
    }
};

template <int STEP>
struct Epi4 {
    static constexpr bool PERM = true, AFTER_DRAIN = false, MID = false;
    const bf16_t* sig; bf16_t* ta; bf16_t* merged;
    DI void operator()(const Acc& acc, const Unit& u, int wr, int wc, int fr, int fq) const {
#pragma unroll
        for (int ai = 0; ai < 2; ++ai) {
            u32x4 sg[4][2], tv[4][2];
#pragma unroll
            for (int m = 0; m < 4; ++m)
#pragma unroll
                for (int bj = 0; bj < 2; ++bj) { const size_t off = (size_t)(u.pm * 256 + ai * 128 + wr * 64 + m * 16 + fr) * DM + u.pn * 256 + bj * 128 + wc * 32 + fq * 8;
                    sg[m][bj] = *(const u32x4*)(sig + off); if (STEP == 1) tv[m][bj] = *(const u32x4*)(ta + off); }
#pragma unroll
            for (int m = 0; m < 4; ++m)
#pragma unroll
                for (int bj = 0; bj < 2; ++bj) { const size_t off = (size_t)(u.pm * 256 + ai * 128 + wr * 64 + m * 16 + fr) * DM + u.pn * 256 + bj * 128 + wc * 32 + fq * 8;
                    const u32x4 s4 = sg[m][bj];
                    f32x4 a = acc[ai][bj][m][0], b = acc[ai][bj][m][1];
                    a[0] *= bflo(s4.x); a[1] *= bfhi(s4.x); a[2] *= bflo(s4.y); a[3] *= bfhi(s4.y); b[0] *= bflo(s4.z); b[1] *= bfhi(s4.z); b[2] *= bflo(s4.w); b[3] *= bfhi(s4.w);
                    if (STEP == 0) st_bf8(ta + off, a, b);
                    else { const u32x4 t4 = tv[m][bj]; a[0] += bflo(t4.x); a[1] += bfhi(t4.x); a[2] += bflo(t4.y); a[3] += bfhi(t4.y); b[0] += bflo(t4.z); b[1] += bfhi(t4.z); b[2] += bflo(t4.w); b[3] += bfhi(t4.w); st_bf8(merged + off, a, b); } }
        }
    }
};

struct Epi4f {
    static constexpr bool PERM = true, AFTER_DRAIN = false, MID = true;
    const bf16_t* siga; const bf16_t* sigb; bf16_t* merged;
    DI void mid(Acc& acc, const Unit& u, int wr, int wc, int fr, int fq) const {
#pragma unroll
        for (int ai = 0; ai < 2; ++ai) {
            u32x4 sa[4][2], sb[4][2];
#pragma unroll
            for (int m = 0; m < 4; ++m)
#pragma unroll
                for (int bj = 0; bj < 2; ++bj) { const size_t off = (size_t)(u.pm * 256 + ai * 128 + wr * 64 + m * 16 + fr) * DM + u.pn * 256 + bj * 128 + wc * 32 + fq * 8;
                    sa[m][bj] = *(const u32x4*)(siga + off); sb[m][bj] = *(const u32x4*)(sigb + off); }
#pragma unroll
            for (int m = 0; m < 4; ++m)
#pragma unroll
                for (int bj = 0; bj < 2; ++bj) { const u32x4 a4 = sa[m][bj], b4 = sb[m][bj];
                    const float an[8] = {bflo(a4.x), bfhi(a4.x), bflo(a4.y), bfhi(a4.y), bflo(a4.z), bfhi(a4.z), bflo(a4.w), bfhi(a4.w)};
                    const float bn[8] = {bflo(b4.x), bfhi(b4.x), bflo(b4.y), bfhi(b4.y), bflo(b4.z), bfhi(b4.z), bflo(b4.w), bfhi(b4.w)};
#pragma unroll
                    for (int j = 0; j < 4; ++j) { acc[ai][bj][m][0][j] *= an[j] * __builtin_amdgcn_rcpf(fmaxf(bn[j], 1e-30f)); acc[ai][bj][m][1][j] *= an[4 + j] * __builtin_amdgcn_rcpf(fmaxf(bn[4 + j], 1e-30f)); } }
        }
    }
    DI void operator()(const Acc& acc, const Unit& u, int wr, int wc, int fr, int fq) const {
#pragma unroll
        for (int ai = 0; ai < 2; ++ai) {
            u32x4 sb[4][2];
#pragma unroll
            for (int m = 0; m < 4; ++m)
#pragma unroll
                for (int bj = 0; bj < 2; ++bj) { const size_t off = (size_t)(u.pm * 256 + ai * 128 + wr * 64 + m * 16 + fr) * DM + u.pn * 256 + bj * 128 + wc * 32 + fq * 8; sb[m][bj] = *(const u32x4*)(sigb + off); }
#pragma unroll
            for (int m = 0; m < 4; ++m)
#pragma unroll
                for (int bj = 0; bj < 2; ++bj) { const size_t off = (size_t)(u.pm * 256 + ai * 128 + wr * 64 + m * 16 + fr) * DM + u.pn * 256 + bj * 128 + wc * 32 + fq * 8; const u32x4 b4 = sb[m][bj];
                    f32x4 a = acc[ai][bj][m][0], b = acc[ai][bj][m][1];
                    a[0] *= fmaxf(bflo(b4.x), 1e-30f); a[1] *= fmaxf(bfhi(b4.x), 1e-30f); a[2] *= fmaxf(bflo(b4.y), 1e-30f); a[3] *= fmaxf(bfhi(b4.y), 1e-30f);
                    b[0] *= fmaxf(bflo(b4.z), 1e-30f); b[1] *= fmaxf(bfhi(b4.z), 1e-30f); b[2] *= fmaxf(bflo(b4.w), 1e-30f); b[3] *= fmaxf(bfhi(b4.w), 1e-30f);
                    st_bf8(merged + off, a, b); }
        }
    }
};

struct EpiRes {
    static constexpr bool PERM = true, AFTER_DRAIN = false, MID = false;
    const float* res; float* out; bf16_t* outb; float* ssq;
    DI void operator()(const Acc& acc, const Unit& u, int wr, int wc, int fr, int fq) const {
#pragma unroll
        for (int ai = 0; ai < 2; ++ai)
#pragma unroll
            for (int mh = 0; mh < 2; ++mh) {
                f32x4 rv[2][2][2];
#pragma unroll
                for (int mi = 0; mi < 2; ++mi)
#pragma unroll
                    for (int bj = 0; bj < 2; ++bj) { const size_t off = (size_t)(u.pm * 256 + ai * 128 + wr * 64 + (mh * 2 + mi) * 16 + fr) * DM + u.pn * 256 + bj * 128 + wc * 32 + fq * 8;
                        rv[mi][bj][0] = *(const f32x4*)(res + off); rv[mi][bj][1] = *(const f32x4*)(res + off + 4); }
#pragma unroll
                for (int mi = 0; mi < 2; ++mi) {
                    const int m = mh * 2 + mi; const int tok = u.pm * 256 + ai * 128 + wr * 64 + m * 16 + fr; float s = 0.f;
#pragma unroll
                    for (int bj = 0; bj < 2; ++bj) { const size_t off = (size_t)tok * DM + u.pn * 256 + bj * 128 + wc * 32 + fq * 8;
                        const f32x4 a = rv[mi][bj][0] + acc[ai][bj][m][0], b = rv[mi][bj][1] + acc[ai][bj][m][1];
                        s += sq4(a) + sq4(b);
                        *(f32x4*)(out + off) = a; *(f32x4*)(out + off + 4) = b;
                        if (outb) st_bf8(outb + off, a, b); }
                    s = red_fq(s);
                    if (fq == 0) atomicAdd(ssq + tok, s);
                }
            }
    }
};

struct Epi9 {
    static constexpr bool PERM = true, AFTER_DRAIN = false, MID = false;
    bf16_t* hid; const float* ssq;
    DI void operator()(const Acc& acc, const Unit& u, int wr, int wc, int fr, int fq) const {
        float rs[2][4]; ld_rstd0(ssq, u, wr, fr, rs);
#pragma unroll
        for (int ai = 0; ai < 2; ++ai)
#pragma unroll
            for (int m = 0; m < 4; ++m) rs[ai][m] = rsqrtf(rs[ai][m] * (1.0f / 1024.0f) + EPS);
#pragma unroll
        for (int ai = 0; ai < 2; ++ai)
#pragma unroll
            for (int m = 0; m < 4; ++m) {
                const int tok = u.pm * 256 + ai * 128 + wr * 64 + m * 16 + fr;
                f32x4 o[2];
#pragma unroll
                for (int n = 0; n < 2; ++n)
#pragma unroll
                    for (int j = 0; j < 4; ++j) { const float g = acc[ai][0][m][n][j] * rs[ai][m], uu = acc[ai][1][m][n][j] * rs[ai][m]; o[n][j] = g * sigm(g) * uu; }
                st_bf8(hid + (size_t)tok * DFF + u.pn * 128 + wc * 32 + fq * 8, o[0], o[1]);
            }
    }
};

template <class Epi>
DI void run_gemm_at(LAS unsigned char* L, const int tid, int first, const bf16_t* A, const bf16_t* Bt, int M, int N, int K, const Epi& E) {
    pg8::Gemm g{A, Bt, M, N, K}; pg8::StaticOrder S; S.init(M, N, (int)gridDim.x, (int)((blockIdx.x + gridDim.x - first) % gridDim.x));
    pg8::gemm_phase<Epi, pg8::StaticOrder, true, true>(L, g, S, E, tid);
}
template <class Epi>
DI void run_gemm(LAS unsigned char* L, const int tid, const bf16_t* A, const bf16_t* Bt, int M, int N, int K, const Epi& E) {
    pg8::Gemm g{A, Bt, M, N, K}; pg8::StaticOrder S; S.init(M, N, (int)gridDim.x, (int)blockIdx.x);
    pg8::gemm_phase<Epi, pg8::StaticOrder, true, true>(L, g, S, E, tid);
}

template <int DQK> DI int ksw(int row, int c) { return DQK == 64 ? (c ^ ((row >> 1) & 7)) : DQK == 96 ? (c ^ ((row >> 2) & 3)) : (c ^ (row & 15)); }

template <int DQK, int DV, int MODE>
DI void attn_block(const bf16_t* __restrict__ Q, int ldq, const bf16_t* __restrict__ Kp, int ldk, const bf16_t* __restrict__ Vt, int ldv,
                   bf16_t* __restrict__ O, int ldo, int q0, int ntiles, char* lds, const int tid) {
    constexpr int NCK = DQK / 8, KB = 64 * DQK * 2, VB = DV * 128, STG = KB + VB, NKC = 64 * NCK, NKL = (NKC + NTHR - 1) / NTHR, NVL = DV * 8 / NTHR, NKK = DQK / 16, NDT = DV / 32;
    const int t = tid, lane = t & 63, w = t >> 6, fr = lane & 31, fh = lane >> 5;
    const int qrow = q0 + w * 32 + fr;
    const int qlo = q0 + w * 32, qhi = qlo + 31;
    unsigned* flags = (unsigned*)(lds + 2 * STG);
    bf16x8 qf[NKK];
#pragma unroll
    for (int kk = 0; kk < NKK; ++kk) qf[kk] = *(const bf16x8*)(Q + (size_t)qrow * ldq + kk * 16 + fh * 8);
    f32x16 o[NDT];
#pragma unroll
    for (int d = 0; d < NDT; ++d)
#pragma unroll
        for (int r = 0; r < 16; ++r) o[d][r] = 0.f;
    float l_run = 0.f;
    f32x16 negm;
#pragma unroll
    for (int r = 0; r < 16; ++r) negm[r] = 0.f;
    bool first = true;
    float m_run = -1e30f;
    u32x4 rk[NKL], rv[NVL];
    auto gload = [&](int kt) {
        const int key0 = kt * 64;
#pragma unroll
        for (int i = 0; i < NKL; ++i) { const int id = t + NTHR * i; if (NKC % NTHR == 0 || id < NKC) { const int row = id / NCK, c = id - row * NCK; rk[i] = *(const u32x4*)(Kp + (size_t)(key0 + row) * ldk + c * 8); } }
#pragma unroll
        for (int i = 0; i < NVL; ++i) { const int id = t + NTHR * i; const int row = id >> 3, c = id & 7; rv[i] = *(const u32x4*)(Vt + (size_t)row * ldv + key0 + c * 8); }
    };
    auto sstore = [&](char* buf) {
#pragma unroll
        for (int i = 0; i < NKL; ++i) { const int id = t + NTHR * i; if (NKC % NTHR == 0 || id < NKC) { const int row = id / NCK, c = id - row * NCK; *(u32x4*)(buf + row * (DQK * 2) + (ksw<DQK>(row, c) << 4)) = rk[i]; } }
#pragma unroll
        for (int i = 0; i < NVL; ++i) { const int id = t + NTHR * i; const int row = id >> 3, c = id & 7; const int g2 = (c >> 1) * 2, a = c & 1, sw = (row >> 1) & 7;
            char* rb_ = buf + KB + row * 128 + a * 8;
            u32x2 lo2, hi2; lo2.x = rv[i].x; lo2.y = rv[i].y; hi2.x = rv[i].z; hi2.y = rv[i].w;
            *(u32x2*)(rb_ + ((g2 ^ sw) << 4)) = lo2; *(u32x2*)(rb_ + (((g2 + 1) ^ sw) << 4)) = hi2; }
    };
    auto tile_of = [&](int it) { return MODE == 1 ? (ntiles - 1 - it) : it; };
    gload(tile_of(0)); sstore(lds); __syncthreads();
    for (int it = 0; it < ntiles; ++it) {
        const int kt = tile_of(it), key0 = kt * 64;
        const char* buf = lds + (it & 1) * STG;
        const bool more = it + 1 < ntiles;
        if (more && MODE != 2) gload(tile_of(it + 1));
        bool active;
        if (MODE == 0) active = key0 <= qhi; else if (MODE == 1) active = key0 < qhi && !(__all(l_run > 152.f) != 0); else active = true;
        if (active) {
            f32x16 s[2];
            if (MODE != 0) {
#pragma unroll
                for (int mt = 0; mt < 2; ++mt)
#pragma unroll
                    for (int r = 0; r < 16; ++r) s[mt][r] = 0.f;
            }
#pragma unroll
            for (int kk = 0; kk < NKK; ++kk)
#pragma unroll
                for (int mt = 0; mt < 2; ++mt) { const int row = mt * 32 + fr; const bf16x8 kf = *(const bf16x8*)(buf + row * (DQK * 2) + (ksw<DQK>(row, kk * 2 + fh) << 4));
                    if (MODE == 0 && kk == 0) s[mt] = MFMA(kf, qf[kk], negm); else s[mt] = MFMA(kf, qf[kk], s[mt]); }
            bf16x8 pf[4];
            if (MODE != 1) {
                if (MODE == 0 && key0 + 63 > qlo) {
#pragma unroll
                    for (int mt = 0; mt < 2; ++mt)
#pragma unroll
                        for (int r = 0; r < 16; ++r) { const int key = key0 + mt * 32 + (r >> 2) * 8 + fh * 4 + (r & 3); if (key > qrow) s[mt][r] = -1e30f; }
                }
                float mx = s[0][0];
#pragma unroll
                for (int mt = 0; mt < 2; ++mt)
#pragma unroll
                    for (int r = 0; r < 16; ++r) mx = fmaxf(mx, s[mt][r]);
                mx = fmaxf(mx, shx32(mx));
                if (MODE == 2) {
                    if (__any(mx > m_run + 8.f)) {
                        const float mnew = fmaxf(m_run, mx); const float alpha = ex2(m_run - mnew); m_run = mnew; l_run *= alpha;
#pragma unroll
                        for (int d = 0; d < NDT; ++d)
#pragma unroll
                            for (int r = 0; r < 16; ++r) o[d][r] *= alpha;
                    }
#pragma unroll
                    for (int mt = 0; mt < 2; ++mt)
#pragma unroll
                        for (int r = 0; r < 16; ++r) s[mt][r] -= m_run;
                } else
                if (first || __any(mx > 8.f)) {
                    const float delta = first ? mx : fmaxf(mx, 0.f); const float alpha = first ? 1.f : ex2(-delta); l_run *= alpha; first = false;
#pragma unroll
                    for (int d = 0; d < NDT; ++d)
#pragma unroll
                        for (int r = 0; r < 16; ++r) o[d][r] *= alpha;
#pragma unroll
                    for (int mt = 0; mt < 2; ++mt)
#pragma unroll
                        for (int r = 0; r < 16; ++r) s[mt][r] -= delta;
#pragma unroll
                    for (int r = 0; r < 16; ++r) negm[r] -= delta;
                }
                float sum = 0.f;
#pragma unroll
                for (int mt = 0; mt < 2; ++mt)
#pragma unroll
                    for (int r = 0; r < 16; ++r) { const float pv = ex2(s[mt][r]); s[mt][r] = pv; sum += pv; }
                l_run += sum;
            } else {
                const bool diag = key0 + 63 >= qlo;
                float G[8];
#pragma unroll
                for (int mt = 0; mt < 2; ++mt)
#pragma unroll
                    for (int rg = 0; rg < 4; ++rg) {
                        float g = 0.f;
#pragma unroll
                        for (int j = 3; j >= 0; --j) { const int r = rg * 4 + j; const float z = s[mt][r];
                            const float wv = lg2(1.f + ex2(-fabsf(z)));
                            float nlom = fmaxf(z, 0.f) + wv; float nl = nlom - z;
                            if (diag) { const int key = key0 + mt * 32 + rg * 8 + fh * 4 + j; if (key >= qrow) { nlom = 0.f; nl = 1e30f; } }
                            s[mt][r] = nl + g; g += nlom; }
                        G[mt * 4 + rg] = g;
                    }
                float base[8]; float run = l_run;
#pragma unroll
                for (int oc = 7; oc >= 0; --oc) { const float gp = shx32(G[oc]); base[oc] = run + (fh == 0 ? gp : 0.f); run += G[oc] + gp; }
                l_run = run;
#pragma unroll
                for (int mt = 0; mt < 2; ++mt)
#pragma unroll
                    for (int r = 0; r < 16; ++r) s[mt][r] = ex2(-(s[mt][r] + base[mt * 4 + (r >> 2)]));
            }
#pragma unroll
            for (int s4 = 0; s4 < 4; ++s4) { u32x4 pk; const int mt = s4 >> 1, rb = (s4 & 1) * 8;
                pk.x = pk2(s[mt][rb], s[mt][rb + 1]); pk.y = pk2(s[mt][rb + 2], s[mt][rb + 3]); pk.z = pk2(s[mt][rb + 4], s[mt][rb + 5]); pk.w = pk2(s[mt][rb + 6], s[mt][rb + 7]);
                pf[s4] = __builtin_bit_cast(bf16x8, pk); }
#pragma unroll
            for (int s4 = 0; s4 < 4; ++s4)
#pragma unroll
                for (int d = 0; d < NDT; ++d) { const int row = d * 32 + fr; const bf16x8 vf = *(const bf16x8*)(buf + KB + row * 128 + (((s4 * 2 + fh) ^ ((row >> 1) & 7)) << 4)); o[d] = MFMA(vf, pf[s4], o[d]); }
        }
        if (more) { if (MODE == 2) gload(tile_of(it + 1)); sstore(lds + ((it + 1) & 1) * STG); }
        if (MODE == 1) {
            const bool fin = __all(l_run > 152.f) != 0;
            if (lane == 0) flags[(it & 1) * NWV + w] = fin ? 1u : 0u;
            __syncthreads();
            const unsigned* f = flags + (it & 1) * NWV;
            if ((f[0] & f[1] & f[2] & f[3] & f[4] & f[5] & f[6] & f[7]) != 0u) break;
        } else {
            __syncthreads();
        }
    }
    float inv = 1.f;
    if (MODE != 1) { const float lt = l_run + shx32(l_run); inv = 1.f / lt; }
#pragma unroll
    for (int d = 0; d < NDT; ++d)
#pragma unroll
        for (int rg = 0; rg < 4; ++rg) st_bf4(O + (size_t)qrow * ldo + d * 32 + rg * 8 + fh * 4, o[d][rg * 4] * inv, o[d][rg * 4 + 1] * inv, o[d][rg * 4 + 2] * inv, o[d][rg * 4 + 3] * inv);
}

DI void phase3(const Params& p, char* lds, const int tid) {
    char* ws = p.ws;
    constexpr int NMLA = 32 * 16, NSB = 32 * 32;
    for (int u = blockIdx.x; u < NMLA + NSB; u += gridDim.x) {
        if (u < NMLA) {
            const int xcd = u & 7, v = u >> 3; const int pr = v & 15, bh = (v >> 4) * 8 + xcd; const int b = bh >> 3, h = bh & 7;
            const bf16_t* Q = (const bf16_t*)(ws + OFF_QA) + (size_t)b * SEQ * 768 + h * 96;
            const bf16_t* Kp = (const bf16_t*)(ws + OFF_KA) + (size_t)b * SEQ * 768 + h * 96;
            const bf16_t* Vt = (const bf16_t*)(ws + OFF_VTA) + (size_t)(h * 64) * T + (size_t)b * SEQ;
            bf16_t* O = (bf16_t*)(ws + OFF_OA) + (size_t)b * SEQ * 1024 + h * 64;
#pragma unroll 1
            for (int half = 0; half < 2; ++half) { const int qb = half ? pr : 31 - pr;
                attn_block<96, 64, 0>(Q, 768, Kp, 768, Vt, T, O, 1024, qb * 256, 4 * qb + 4, lds, tid); }
        } else {
            const int uu = u - NMLA; const int xcd = uu & 7, v = uu >> 3; const int qb = v & 31, bh = (v >> 5) * 8 + xcd; const int b = bh >> 3, h = bh & 7;
            const bf16_t* Q = (const bf16_t*)(ws + OFF_SBQ) + (size_t)b * SEQ * 512 + h * 64;
            const bf16_t* Kp = (const bf16_t*)(ws + OFF_SBK) + (size_t)b * SEQ * 512 + h * 64;
            const bf16_t* Vt = (const bf16_t*)(ws + OFF_VTB) + (size_t)(h * 64) * T + (size_t)b * SEQ;
            bf16_t* O = (bf16_t*)(ws + OFF_OA) + (size_t)b * SEQ * 1024 + 512 + h * 64;
            attn_block<64, 64, 1>(Q, 512, Kp, 512, Vt, T, O, 1024, qb * 256, 4 * qb + 4, lds, tid);
        }
    }
}

DI void phase7(const Params& p, char* lds, const int tid) {
    char* ws = p.ws;
    for (int u = blockIdx.x; u < 16 * 32; u += gridDim.x) {
        const int xcd = u & 7, v = u >> 3; const int qb = v & 31, bh = (v >> 5) * 8 + xcd; const int b = bh >> 2, h = bh & 3;
        const bf16_t* Q = (const bf16_t*)(ws + OFF_XQ) + (size_t)b * SEQ * 512 + h * 128;
        const bf16_t* Kp = (const bf16_t*)(ws + OFF_XK) + (size_t)b * MEML * 512 + h * 128;
        const bf16_t* Vt = (const bf16_t*)(ws + OFF_XVT) + (size_t)(h * 128) * MEMT + (size_t)b * MEML;
        bf16_t* O = (bf16_t*)(ws + OFF_XO) + (size_t)b * SEQ * 512 + h * 128;
        attn_block<128, 128, 2>(Q, 512, Kp, 512, Vt, MEMT, O, 512, qb * 256, 4, lds, tid);
    }
}

DI void phase11(const Params& p, const int tid) {
    const float* ssq3 = (const float*)(p.ws + OFF_SSQ3);
    const int lane = tid & 63, w = tid >> 6;
    f32x4 g[4];
#pragma unroll
    for (int i = 0; i < 4; ++i) g[i] = *(const f32x4*)(p.g_final + i * 256 + lane * 4);
    for (int row0 = (blockIdx.x * NWV + w) * 4; row0 < T; row0 += gridDim.x * NWV * 4) {
        f32x4 v[4][4]; float rs[4];
#pragma unroll
        for (int r = 0; r < 4; ++r) { rs[r] = ssq3[row0 + r];
#pragma unroll
            for (int i = 0; i < 4; ++i) v[r][i] = *(const f32x4*)(p.out + (size_t)(row0 + r) * DM + i * 256 + lane * 4); }
#pragma unroll
        for (int r = 0; r < 4; ++r) { const float s = rsqrtf(rs[r] * (1.0f / DM) + EPS);
#pragma unroll
            for (int i = 0; i < 4; ++i) { f32x4 o = v[r][i]; o[0] *= s * g[i][0]; o[1] *= s * g[i][1]; o[2] *= s * g[i][2]; o[3] *= s * g[i][3];
                *(f32x4*)(p.out + (size_t)(row0 + r) * DM + i * 256 + lane * 4) = o; } }
    }
}

#define XB_TMO      128
#define XB_XCNT(j)  (256  + 64 * (j))
#define XB_XSUB(j)  (1280 + 64 * (j))
#define XB_XGEN(j)  (2304 + 64 * (j))
#define XB_TOP      3328
#define XB_TOPGEN   3392
#define XCD_BAR_WORDS 3456
#define XB_SPIN_CAP (1u << 22)
DI unsigned xb_ld(unsigned* p) { return __hip_atomic_load(p, __ATOMIC_RELAXED, __HIP_MEMORY_SCOPE_AGENT); }
DI unsigned xb_add(unsigned* p, unsigned v) { return __hip_atomic_fetch_add(p, v, __ATOMIC_RELAXED, __HIP_MEMORY_SCOPE_AGENT); }
DI unsigned xb_xcc_id() { return (unsigned)__builtin_amdgcn_s_getreg((3 << 11) | 20) & 0xFu; }
#define XB_SPIN(cond, bar) do { unsigned _sp = 0; while (cond) { __builtin_amdgcn_s_sleep(1); \
    if ((++_sp & 255u) == 0u) { if (xb_ld(&(bar)[XB_TMO])) break; if (_sp > XB_SPIN_CAP) { atomicAdd(&(bar)[XB_TMO], 1u); break; } } } } while (0)
struct XcdBarrier { unsigned* bar; unsigned x; volatile LAS unsigned* st; };
DI XcdBarrier xcd_barrier_post(unsigned* bar, volatile LAS unsigned* st, const int tid) {
    XcdBarrier b; b.bar = bar; b.x = xb_xcc_id(); b.st = st;
    if (tid == 0) (void)xb_add(&bar[XB_XCNT(b.x)], 1u);
    return b;
}
DI void xcd_barrier_complete(unsigned* bar, unsigned x, unsigned& nloc, unsigned& nx) {
    const unsigned G = gridDim.x * gridDim.y * gridDim.z;
    unsigned sum, cnt, mine, sp = 0u;
    for (;;) {
        sum = 0u; cnt = 0u; mine = 0u;
#pragma unroll
        for (unsigned j = 0; j < 16; ++j) { const unsigned c = xb_ld(&bar[XB_XCNT(j)]); sum += c; cnt += (c > 0u) ? 1u : 0u; mine = (j == x) ? c : mine; }
        if (sum == G) break;
        __builtin_amdgcn_s_sleep(1);
        if ((++sp & 255u) == 0u) { if (xb_ld(&bar[XB_TMO])) break; if (sp > XB_SPIN_CAP) { atomicAdd(&bar[XB_TMO], 1u); break; } }
    }
    nloc = mine > 0u ? mine : 1u; nx = cnt > 0u ? cnt : 1u;
}
DI void xcd_barrier(const XcdBarrier& b, const int tid) {
    asm volatile("s_waitcnt vmcnt(0)" ::: "memory");
    __syncthreads();
    if (tid == 0) {
        unsigned* bar = b.bar;
        __builtin_amdgcn_s_waitcnt(0);
        unsigned nloc = b.st[0], nx = b.st[1];
        if (nloc == 0u) { xcd_barrier_complete(bar, b.x, nloc, nx); b.st[0] = nloc; b.st[1] = nx; }
        const unsigned old = xb_add(&bar[XB_XSUB(b.x)], 1u);
        const unsigned gen = old / nloc;
        if (old + 1u == (gen + 1u) * nloc) {
            __builtin_amdgcn_fence(__ATOMIC_RELEASE, "agent");
            asm volatile("s_waitcnt vmcnt(0)" ::: "memory");
            const unsigned og = xb_add(&bar[XB_TOP], 1u);
            const unsigned tg = og / nx;
            if (og + 1u == (tg + 1u) * nx) xb_add(&bar[XB_TOPGEN], 1u);
            else XB_SPIN(xb_ld(&bar[XB_TOPGEN]) == tg, bar);
            __builtin_amdgcn_fence(__ATOMIC_ACQUIRE, "agent");
            xb_add(&bar[XB_XGEN(b.x)], 1u);
            asm volatile("s_waitcnt vmcnt(0)" ::: "memory");
        } else {
            XB_SPIN(xb_ld(&bar[XB_XGEN(b.x)]) == gen, bar);
            __builtin_amdgcn_fence(__ATOMIC_ACQUIRE, "agent");
            asm volatile("s_waitcnt vmcnt(0)" ::: "memory");
        }
    }
    __syncthreads();
}


constexpr int NPHASE = 12;
__global__ void __launch_bounds__(NTHR, 2) mega(Params p, int ph_lo, int ph_hi, int coop) {
    extern __shared__ __attribute__((aligned(16))) unsigned char dlds[];
    LAS unsigned char* L = (LAS unsigned char*)dlds;
    char* lds = (char*)dlds;
    char* ws = p.ws;
    const int swid = __builtin_amdgcn_readfirstlane((int)(threadIdx.x >> 6));
#define MYTID (swid * 64 + lane_id_fresh())
    volatile LAS unsigned* xbw = (volatile LAS unsigned*)(L + LDS_XB);
    if (threadIdx.x < 4) xbw[threadIdx.x] = 0u;
    __syncthreads();
    XcdBarrier xb; xb.bar = (unsigned*)(ws + OFF_BAR); xb.x = 0; xb.st = xbw;
    if (coop) xb = xcd_barrier_post((unsigned*)(ws + OFF_BAR), xbw, MYTID);
    if (coop == 2) cg::this_grid().sync();
#define PH(n, call) if (ph_lo <= n && n < ph_hi) { call; } if (coop && n + 1 < NPHASE) xcd_barrier(xb, MYTID);
    PH(0, phase0(p, lds, MYTID))
    PH(1, { run_gemm(L, MYTID, (const bf16_t*)(ws + OFF_XB), (const bf16_t*)(ws + OFF_WIN), T, 1536, DM, Epi1{ws, p.b_gate});
            run_gemm(L, MYTID, (const bf16_t*)(ws + OFF_XB), (const bf16_t*)(ws + OFF_WIN) + (size_t)1536 * DM, T, 2048, DM, EpiGate{ws, p.b_gate});
            run_gemm(L, MYTID, (const bf16_t*)(ws + OFF_WV), (const bf16_t*)(ws + OFF_XB), 512, T, DM, EpiVt<1>{(bf16_t*)(ws + OFF_VTB), T, (const float*)(ws + OFF_RSTD0)}); })
    PH(2, { run_gemm(L, MYTID, (const bf16_t*)(ws + OFF_CQ), (const bf16_t*)(ws + OFF_WUQ), T, 768, 256, Epi2q{ws});
            run_gemm(L, MYTID, (const bf16_t*)(ws + OFF_CKV), (const bf16_t*)(ws + OFF_WUK), T, 512, 256, EpiBf<2, true>{(bf16_t*)(ws + OFF_KA), 768, (const float*)(ws + OFF_SSQ_KV)});
            run_gemm(L, MYTID, (const bf16_t*)(ws + OFF_WUV), (const bf16_t*)(ws + OFF_CKV), 512, T, 256, EpiVt<2>{(bf16_t*)(ws + OFF_VTA), T, (const float*)(ws + OFF_SSQ_KV)});
            run_gemm_at(L, MYTID, 128, (const bf16_t*)(ws + OFF_MNB), (const bf16_t*)(ws + OFF_WXKV), MEMT, 512, DM, EpiBf<0, false>{(bf16_t*)(ws + OFF_XK), 512, nullptr});
            run_gemm_at(L, MYTID, 144, (const bf16_t*)(ws + OFF_WXKV) + (size_t)512 * DM, (const bf16_t*)(ws + OFF_MNB), 512, MEMT, DM, EpiVt<0>{(bf16_t*)(ws + OFF_XVT), MEMT, nullptr}); })
    PH(3, phase3(p, lds, MYTID))
    PH(4, run_gemm(L, MYTID, (const bf16_t*)(ws + OFF_OA), (const bf16_t*)(ws + OFF_WA), T, DM, DM, Epi4f{(const bf16_t*)(ws + OFF_SIGA), (const bf16_t*)(ws + OFF_SIGB), (bf16_t*)(ws + OFF_MERGED)}))
    PH(5, run_gemm(L, MYTID, (const bf16_t*)(ws + OFF_MERGED), (const bf16_t*)(ws + OFF_WO), T, DM, DM, EpiRes{p.x, p.out, (bf16_t*)(ws + OFF_X1B), (float*)(ws + OFF_SSQ1)}))
    PH(6, run_gemm(L, MYTID, (const bf16_t*)(ws + OFF_X1B), (const bf16_t*)(ws + OFF_WXQ), T, 512, DM, EpiBf<1, false>{(bf16_t*)(ws + OFF_XQ), 512, (const float*)(ws + OFF_SSQ1)}))
    PH(7, phase7(p, lds, MYTID))
    PH(8, run_gemm(L, MYTID, (const bf16_t*)(ws + OFF_XO), (const bf16_t*)(ws + OFF_WXO), T, DM, 512, EpiRes{p.out, p.out, (bf16_t*)(ws + OFF_X2B), (float*)(ws + OFF_SSQ2)}))
    PH(9, run_gemm(L, MYTID, (const bf16_t*)(ws + OFF_X2B), (const bf16_t*)(ws + OFF_WGU), T, 2 * DFF, DM, Epi9{(bf16_t*)(ws + OFF_HID), (const float*)(ws + OFF_SSQ2)}))
    PH(10, run_gemm(L, MYTID, (const bf16_t*)(ws + OFF_HID), (const bf16_t*)(ws + OFF_WD), T, DM, DFF, EpiRes{p.out, p.out, nullptr, (float*)(ws + OFF_SSQ3)}))
    PH(11, phase11(p, MYTID))
}

extern "C" void kernel_launch(void* const* d_in, const int* in_sizes, int n_in, void* d_out, int out_size, void* d_ws, size_t ws_size, hipStream_t stream) {
    static int grid_blocks = 0;
    if (!grid_blocks) {
        int dev = 0, cus = 0, per_cu = 0;
        (void)hipGetDevice(&dev);
        (void)hipDeviceGetAttribute(&cus, hipDeviceAttributeMultiprocessorCount, dev);
        (void)hipFuncSetAttribute((const void*)mega, hipFuncAttributeMaxDynamicSharedMemorySize, LDS_BYTES);
        (void)hipOccupancyMaxActiveBlocksPerMultiprocessor(&per_cu, mega, NTHR, LDS_BYTES);
        if (per_cu != 1) per_cu = 1;
        grid_blocks = cus * per_cu;
    }
    Params p{};
    p.x = (const float*)d_in[0]; p.mem = (const float*)d_in[1]; p.pos = (const int*)d_in[2];
    p.g_mix = (const float*)d_in[3]; p.w_in = (const float*)d_in[4]; p.b_gate = (const float*)d_in[5]; p.g_q_lat = (const float*)d_in[6]; p.w_uq = (const float*)d_in[7];
    p.g_kv_lat = (const float*)d_in[8]; p.w_ukv = (const float*)d_in[9]; p.w_a = (const float*)d_in[10]; p.w_b = (const float*)d_in[11]; p.w_o = (const float*)d_in[12];
    p.g_x = (const float*)d_in[13]; p.g_mem = (const float*)d_in[14]; p.w_xq = (const float*)d_in[15]; p.w_xkv = (const float*)d_in[16]; p.w_xo = (const float*)d_in[17];
    p.g_ffn = (const float*)d_in[18]; p.w_gate = (const float*)d_in[19]; p.w_up = (const float*)d_in[20]; p.w_down = (const float*)d_in[21]; p.g_final = (const float*)d_in[22];
    p.out = (float*)d_out; p.ws = (char*)d_ws;
#if ONE_LAUNCH
    int lo = 0, hi = NPHASE, coop = 1;
    (void)hipMemsetAsync((char*)d_ws + OFF_BAR, 0, XCD_BAR_WORDS * sizeof(unsigned), stream);
    void* args[] = {&p, &lo, &hi, &coop};
    hipError_t e = hipLaunchCooperativeKernel((void*)mega, dim3(grid_blocks), dim3(NTHR), args, LDS_BYTES, stream);
    if (e != hipSuccess) fprintf(stderr, "cooperative launch failed: %s (grid %d)\n", hipGetErrorString(e), grid_blocks);
#else
    for (int ph = 0; ph < NPHASE; ++ph) mega<<<dim3(grid_blocks), dim3(NTHR), LDS_BYTES, stream>>>(p, ph, ph + 1, 0);
#endif
}
```
